# Optimizing an MI355X kernel written in HIP

```python
import math
import jax, jax.numpy as jnp
from jax import lax
import numpy as np

D_MODEL = 1024
BATCH = 2
SEQ = 16384
DEPTH = 2

CHUNK = 128
A_GROUPS = 4
A_GROUP_DIM = 128
A_WIDTH = A_GROUPS * A_GROUP_DIM
B_HEADS = 4
B_HEAD_DIM = 128
B_WIDTH = B_HEADS * B_HEAD_DIM
B_ROT = B_HEAD_DIM // 4
IDX_HEADS = 4
IDX_DIM = 64
IDX_ROT = IDX_DIM // 4
TOPK_MAX = 256
Q_BLOCK = 128
C_WIDTH = 512
CONV_WIDTH = 3
N_BRANCH = 3
D_IN = 2 * A_WIDTH + 3 * B_WIDTH + IDX_HEADS * IDX_DIM + IDX_DIM + IDX_HEADS + 3 * C_WIDTH + N_BRANCH * D_MODEL
N_GROUPS = 4
EXP_PER_GROUP = 8
N_EXPERTS = N_GROUPS * EXP_PER_GROUP
TOP_K_EXP = 2
D_FF_EXPERT = 512
MOE_BLOCK = 128

ROPE_THETA = 500000.0
EPS = 1e-6
NEG = -1e30

kernel_name = "hybrid_gmlp_dsa_shortconv_hiermoe"


def rms_norm(x, g):
    xf = x.astype(jnp.float32)
    y = xf * lax.rsqrt(jnp.mean(xf * xf, axis=-1, keepdims=True) + EPS)
    return (y * g.astype(jnp.float32)).astype(x.dtype)


def layer_norm_noaffine(x):
    xf = x.astype(jnp.float32)
    mu = jnp.mean(xf, axis=-1, keepdims=True)
    var = jnp.mean(jnp.square(xf - mu), axis=-1, keepdims=True)
    return ((xf - mu) * lax.rsqrt(var + EPS)).astype(x.dtype)


def partial_rope(x, positions, rot_dim):
    half = rot_dim // 2
    inv_freq = jnp.float32(ROPE_THETA) ** (-jnp.arange(half, dtype=jnp.float32) * 2.0 / rot_dim)
    ang = positions.astype(jnp.float32)[..., None] * inv_freq
    cos = jnp.cos(ang)[:, :, None, :].astype(x.dtype)
    sin = jnp.sin(ang)[:, :, None, :].astype(x.dtype)
    x1 = x[..., :half]
    x2 = x[..., half:rot_dim]
    rest = x[..., rot_dim:]
    return jnp.concatenate([x1 * cos - x2 * sin, x1 * sin + x2 * cos, rest], axis=-1)


def gmlp_spatial(u, v, ws, bs):
    bsz, s, _ = u.shape
    n = s // CHUNK
    u = jax.nn.gelu(u)
    v = layer_norm_noaffine(jax.nn.gelu(v))
    vc = v.reshape(bsz, n, CHUNK, A_GROUPS, A_GROUP_DIM)
    causal = jnp.tril(jnp.ones((CHUNK, CHUNK), dtype=bool))
    wsm = jnp.where(causal[None], ws, jnp.zeros_like(ws))
    vm = jnp.einsum('gts,bnsgc->bntgc', wsm, vc) + bs.T[None, None, :, :, None]
    return u * vm.reshape(bsz, s, A_WIDTH)


def dsa_attention(q, k, v, qi, ki, wi, positions):
    bsz, s, _ = q.shape
    nblk = s // Q_BLOCK
    n_sel = min(TOPK_MAX, s // 4)
    q = partial_rope(q.reshape(bsz, s, B_HEADS, B_HEAD_DIM), positions, B_ROT)
    k = partial_rope(k.reshape(bsz, s, B_HEADS, B_HEAD_DIM), positions, B_ROT)
    v = v.reshape(bsz, s, B_HEADS, B_HEAD_DIM)
    qi = partial_rope(qi.reshape(bsz, s, IDX_HEADS, IDX_DIM), positions, IDX_ROT)
    ki = partial_rope(ki.reshape(bsz, s, 1, IDX_DIM), positions, IDX_ROT)[:, :, 0]
    wi = wi * (IDX_HEADS ** -0.5)
    key_pos = jnp.arange(s, dtype=jnp.int32)

    def to_blocks(a):
        return a.reshape(bsz, nblk, Q_BLOCK, *a.shape[2:]).swapaxes(0, 1)

    def block(args):
        qb, qib, wib, blk = args
        t = blk * Q_BLOCK + jnp.arange(Q_BLOCK, dtype=jnp.int32)
        rel = jax.nn.relu(jnp.einsum('bthd,bsd->bths', qib, ki).astype(jnp.float32) * (IDX_DIM ** -0.5))
        score = jnp.einsum('bths,bth->bts', rel, wib.astype(jnp.float32))
        causal = key_pos[None, :] <= t[:, None]
        score = jnp.where(causal[None], score, NEG)
        _, sel = lax.top_k(score, n_sel)
        valid = sel <= t[None, :, None]
        kg = jax.vmap(lambda a, i: a[i])(k, sel)
        vg = jax.vmap(lambda a, i: a[i])(v, sel)
        logit = jnp.einsum('bthd,btkhd->bhtk', qb, kg).astype(jnp.float32) * (B_HEAD_DIM ** -0.5)
        logit = jnp.where(valid[:, None], logit, NEG)
        p = jax.nn.softmax(logit, axis=-1).astype(vg.dtype)
        return jnp.einsum('bhtk,btkhd->bthd', p, vg)

    out = lax.map(block, (to_blocks(q), to_blocks(qi), to_blocks(wi), jnp.arange(nblk, dtype=jnp.int32)))
    return out.swapaxes(0, 1).reshape(bsz, s, B_WIDTH)


def short_gated_conv(cb, cc, cx, conv_w):
    z = cc * cx
    s = z.shape[1]
    zp = jnp.pad(z, ((0, 0), (CONV_WIDTH - 1, 0), (0, 0)))
    y = conv_w[0] * zp[:, 0:s]
    for i in range(1, CONV_WIDTH):
        y = y + conv_w[i] * zp[:, i:i + s]
    return cb * y


def token_mixers(h, positions, w_in, ws, bs, conv_w, w_proj_a, w_proj_b, w_proj_c, w_out):
    bsz, s, _ = h.shape
    proj = h @ w_in
    sizes = [A_WIDTH, A_WIDTH, B_WIDTH, B_WIDTH, B_WIDTH, IDX_HEADS * IDX_DIM, IDX_DIM, IDX_HEADS,
             C_WIDTH, C_WIDTH, C_WIDTH, N_BRANCH * D_MODEL]
    cuts = [int(c) for c in np.cumsum(sizes)[:-1]]
    u, va, q, k, vb, qi, ki, wi, cb, cc, cx, gates = jnp.split(proj, cuts, axis=-1)
    ya = gmlp_spatial(u, va, ws, bs)
    yb = dsa_attention(q, k, vb, qi, ki, wi, positions)
    yc = short_gated_conv(cb, cc, cx, conv_w)
    g = jax.nn.sigmoid(gates.astype(jnp.float32)).astype(h.dtype).reshape(bsz, s, N_BRANCH, D_MODEL)
    merged = g[:, :, 0] * (ya @ w_proj_a) + g[:, :, 1] * (yb @ w_proj_b) + g[:, :, 2] * (yc @ w_proj_c)
    return merged @ w_out


def hier_moe(h, rg_w, rg_b, re_w, re_b, w_gate, w_up, w_down):
    bsz, s, d = h.shape
    t_tok = bsz * s
    xt = h.reshape(t_tok, d)
    glog = (xt @ rg_w + rg_b).astype(jnp.float32)
    gprob = jax.nn.softmax(glog, axis=-1)
    grp = jnp.argmax(glog, axis=-1).astype(jnp.int32)
    gw = jnp.take_along_axis(gprob, grp[:, None], axis=1)[:, 0]
    elog = (xt @ re_w + re_b).astype(jnp.float32).reshape(t_tok, N_GROUPS, EXP_PER_GROUP)
    el = jnp.take_along_axis(elog, grp[:, None, None], axis=1)[:, 0]
    tv, ti = lax.top_k(el, TOP_K_EXP)
    tw = jax.nn.softmax(tv, axis=-1) * gw[:, None]
    n_assign = t_tok * TOP_K_EXP
    eid = (grp[:, None] * EXP_PER_GROUP + ti).reshape(n_assign)
    wts = tw.reshape(n_assign)
    tok = jnp.repeat(jnp.arange(t_tok, dtype=jnp.int32), TOP_K_EXP)
    order = jnp.argsort(eid)
    eid_s, wts_s, tok_s = eid[order], wts[order], tok[order]
    counts = jnp.bincount(eid, length=N_EXPERTS)
    start = jnp.cumsum(counts) - counts
    padded = ((counts + MOE_BLOCK - 1) // MOE_BLOCK) * MOE_BLOCK
    pend = jnp.cumsum(padded)
    pstart = pend - padded
    dest = pstart[eid_s] + (jnp.arange(n_assign, dtype=jnp.int32) - start[eid_s])
    n_blocks = -(-n_assign // MOE_BLOCK) + N_EXPERTS
    n_rows = n_blocks * MOE_BLOCK
    buf_tok = jnp.zeros((n_rows,), jnp.int32).at[dest].set(tok_s)
    buf_w = jnp.zeros((n_rows,), jnp.float32).at[dest].set(wts_s)
    block_exp = jnp.minimum(jnp.searchsorted(pend, jnp.arange(n_blocks, dtype=jnp.int32) * MOE_BLOCK, side='right'),
                            N_EXPERTS - 1).astype(jnp.int32)

    def expert_block(args):
        tok_b, e = args
        xb = xt[tok_b]
        hid = jax.nn.silu(xb @ w_gate[e]) * (xb @ w_up[e])
        return hid @ w_down[e]

    yb = lax.map(expert_block, (buf_tok.reshape(n_blocks, MOE_BLOCK), block_exp))
    yb = yb.reshape(n_rows, d) * buf_w[:, None].astype(xt.dtype)
    out = jnp.zeros((t_tok, d), xt.dtype).at[buf_tok].add(yb)
    return out.reshape(bsz, s, d)


def setup_inputs(seed: int = 0) -> dict:
    key = jax.random.key(seed)
    ks = jax.random.split(key, 20)
    f32 = jnp.float32
    nrm = lambda k, shape, scale: jax.random.normal(k, shape, f32) * scale
    return {
        "x": nrm(ks[0], (BATCH, SEQ, D_MODEL), 1.0),
        "positions": jnp.broadcast_to(jnp.arange(SEQ, dtype=jnp.int32), (BATCH, SEQ)),
        "norm_mix_g": 1.0 + nrm(ks[1], (DEPTH, D_MODEL), 0.02),
        "norm_ffn_g": 1.0 + nrm(ks[2], (DEPTH, D_MODEL), 0.02),
        "norm_final_g": 1.0 + nrm(ks[3], (D_MODEL,), 0.02),
        "w_in": nrm(ks[4], (DEPTH, D_MODEL, D_IN), D_MODEL ** -0.5),
        "gmlp_ws": nrm(ks[5], (DEPTH, A_GROUPS, CHUNK, CHUNK), CHUNK ** -0.5),
        "gmlp_b": 1.0 + nrm(ks[6], (DEPTH, A_GROUPS, CHUNK), 0.02),
        "conv_w": nrm(ks[7], (DEPTH, CONV_WIDTH, C_WIDTH), CONV_WIDTH ** -0.5),
        "w_proj_a": nrm(ks[8], (DEPTH, A_WIDTH, D_MODEL), A_WIDTH ** -0.5),
        "w_proj_b": nrm(ks[9], (DEPTH, B_WIDTH, D_MODEL), B_WIDTH ** -0.5),
        "w_proj_c": nrm(ks[10], (DEPTH, C_WIDTH, D_MODEL), C_WIDTH ** -0.5),
        "w_out": nrm(ks[11], (DEPTH, D_MODEL, D_MODEL), D_MODEL ** -0.5),
        "router_group_w": nrm(ks[12], (DEPTH, D_MODEL, N_GROUPS), D_MODEL ** -0.5),
        "router_group_b": nrm(ks[13], (DEPTH, N_GROUPS), 0.01),
        "router_expert_w": nrm(ks[14], (DEPTH, D_MODEL, N_EXPERTS), D_MODEL ** -0.5),
        "router_expert_b": nrm(ks[15], (DEPTH, N_EXPERTS), 0.01),
        "expert_w_gate": nrm(ks[16], (DEPTH, N_EXPERTS, D_MODEL, D_FF_EXPERT), D_MODEL ** -0.5),
        "expert_w_up": nrm(ks[17], (DEPTH, N_EXPERTS, D_MODEL, D_FF_EXPERT), D_MODEL ** -0.5),
        "expert_w_down": nrm(ks[18], (DEPTH, N_EXPERTS, D_FF_EXPERT, D_MODEL), D_FF_EXPERT ** -0.5),
    }


def reference(x, positions, norm_mix_g, norm_ffn_g, norm_final_g, w_in, gmlp_ws, gmlp_b, conv_w,
              w_proj_a, w_proj_b, w_proj_c, w_out, router_group_w, router_group_b,
              router_expert_w, router_expert_b, expert_w_gate, expert_w_up, expert_w_down):
    for l in range(DEPTH):
        h = rms_norm(x, norm_mix_g[l])
        x = x + token_mixers(h, positions, w_in[l], gmlp_ws[l], gmlp_b[l], conv_w[l],
                             w_proj_a[l], w_proj_b[l], w_proj_c[l], w_out[l])
        h = rms_norm(x, norm_ffn_g[l])
        x = x + hier_moe(h, router_group_w[l], router_group_b[l], router_expert_w[l], router_expert_b[l],
                         expert_w_gate[l], expert_w_up[l], expert_w_down[l])
    return rms_norm(x, norm_final_g)
```

```cpp
#include <hip/hip_runtime.h>
#include <cstdio>
#include <cstdint>
#include <cmath>

#define LAS __attribute__((address_space(3)))
#define GAS __attribute__((address_space(1)))
typedef unsigned short bf16_t;
typedef short bf16x8 __attribute__((ext_vector_type(8)));
typedef short s16x4 __attribute__((ext_vector_type(4)));
typedef float f32x4 __attribute__((ext_vector_type(4)));
typedef float f32x16 __attribute__((ext_vector_type(16)));
typedef unsigned u32x4 __attribute__((ext_vector_type(4)));
typedef unsigned u32x2 __attribute__((ext_vector_type(2)));

constexpr int DM = 1024, NB = 2, SEQ = 16384, T = NB * SEQ, DEPTH = 2;
constexpr int D_IN = 7492, NPROJ = 7680;
constexpr int NEXP = 32, DFF = 512;
constexpr int MAXROWS = 2 * T + NEXP * 256;
constexpr float EPS = 1e-6f;
constexpr int NWAVES = 8, NTHREADS = 512;

constexpr size_t MiB = 1u << 20;
constexpr size_t WS_CTL = 0, CTL_ZERO_BYTES = 1 * MiB;
constexpr size_t WS_COSQ = 1 * MiB, WS_SINQ = 3 * MiB, WS_COSI = 5 * MiB, WS_SINI = 6 * MiB;
constexpr size_t WS_WIN = 8 * MiB;
constexpr size_t WS_WP = 38 * MiB;
constexpr size_t WS_WO = 44 * MiB;
constexpr size_t WS_WR = 48 * MiB;
constexpr size_t WS_MISC = 49 * MiB;
constexpr size_t MS_CNT = 0;
constexpr size_t MS_TE = 64 * 1024;
constexpr size_t MS_TW = MS_TE + 256 * 1024;
constexpr size_t MS_SLOT = MS_TW + 256 * 1024;
constexpr size_t MS_WSLOT = MS_SLOT + 256 * 1024;
constexpr size_t MS_TILE = MS_WSLOT + 320 * 1024;
constexpr size_t WS_R = 52 * MiB;
constexpr size_t R_HB = 0, R_VA = 64 * MiB, R_CC = 96 * MiB, R_CX = 128 * MiB, R_SCR = 0  , R_UA = 160 * MiB, R_Q = 192 * MiB,
                 R_K = 224 * MiB, R_VB = 256 * MiB, R_CB = 288 * MiB, R_QI = 320 * MiB, R_KI = 336 * MiB, R_WI = 340 * MiB, R_G8 = 342 * MiB, R_MASK = 438 * MiB,
                 R_MERGED = 224 * MiB  , R_MIX_END = 502 * MiB;
constexpr size_t R_WGU = 0, R_WD = 64 * MiB, R_HB2 = 96 * MiB, R_LOG = 160 * MiB, R_XS = 168 * MiB, R_HID = 312 * MiB, R_MOE_END = 384 * MiB;
constexpr size_t WS_END = WS_R + R_MIX_END;
static_assert((size_t)MAXROWS * 2048 <= 144 * MiB && (size_t)MAXROWS * 1024 <= 72 * MiB, "moe buffers");
constexpr size_t SCR_PER_WG = 512 * 1024;

constexpr int CW_ERR = 0;
constexpr int CW_BAR = 4096;

constexpr int RING_BYTES = 131072;
constexpr int LDS_BYTES = 147456;
constexpr int MISC_OFF = LDS_BYTES - 256;

#define LDS_WAIT() asm volatile("s_waitcnt lgkmcnt(0)" ::: "memory")
#define VM_WAIT() asm volatile("s_waitcnt vmcnt(0)" ::: "memory")
#define SBAR() __builtin_amdgcn_sched_barrier(0)
__device__ __forceinline__ unsigned cvtpk(float lo, float hi) { unsigned r; asm volatile("v_cvt_pk_bf16_f32 %0, %1, %2" : "=v"(r) : "v"(lo), "v"(hi)); return r; }
__device__ __forceinline__ float bf_lo(unsigned w) { return __uint_as_float(w << 16); }
__device__ __forceinline__ float bf_hi(unsigned w) { return __uint_as_float(w & 0xffff0000u); }
__device__ __forceinline__ float wave_sum(float v) {
#pragma unroll
    for (int o = 1; o < 64; o <<= 1) v += __shfl_xor(v, o);
    return v;
}
__device__ __forceinline__ float fast_sigmoid(float x) { return __builtin_amdgcn_rcpf(1.0f + __builtin_amdgcn_exp2f(-1.4426950408889634f * x)); }
__device__ __forceinline__ float gelu_tanh(float x) { const float z = 0.7978845608028654f * (x + 0.044715f * x * x * x); return x * fast_sigmoid(2.0f * z); }

#define XB_TMO      128
#define XB_XCNT(j)  (256  + 64 * (j))
#define XB_XSUB(j)  (1280 + 64 * (j))
#define XB_XGEN(j)  (2304 + 64 * (j))
#define XB_TOP      3328
#define XB_TOPGEN   3392
#define XCD_BAR_WORDS 3456
#define XB_SPIN_CAP (1u << 18)

__device__ __forceinline__ unsigned xb_ld(unsigned* p)              { return __hip_atomic_load(p, __ATOMIC_RELAXED, __HIP_MEMORY_SCOPE_AGENT); }
__device__ __forceinline__ unsigned xb_add(unsigned* p, unsigned v) { return __hip_atomic_fetch_add(p, v, __ATOMIC_RELAXED, __HIP_MEMORY_SCOPE_AGENT); }
__device__ __forceinline__ unsigned xb_xcc_id() { return (unsigned)__builtin_amdgcn_s_getreg((3 << 11) | 20) & 0xFu; }
#define XB_SPIN(cond, bar) do { unsigned _sp = 0; while (cond) { __builtin_amdgcn_s_sleep(1); \
    if ((++_sp & 255u) == 0u) { if (xb_ld(&(bar)[XB_TMO])) break; if (_sp > XB_SPIN_CAP) { atomicAdd(&(bar)[XB_TMO], 1u); break; } } } } while (0)

struct XcdBarrier {
    unsigned* bar; unsigned x;
    volatile LAS unsigned* st;
};

__device__ __forceinline__ XcdBarrier xcd_barrier_post(unsigned* bar, volatile LAS unsigned* st) {
    XcdBarrier b; b.bar = bar; b.x = xb_xcc_id(); b.st = st;
    if (threadIdx.x == 0) (void)xb_add(&bar[XB_XCNT(b.x)], 1u);
    return b;
}
__device__ __forceinline__ void xcd_barrier_complete(unsigned* bar, unsigned x, unsigned& nloc, unsigned& nx) {
    const unsigned G = gridDim.x * gridDim.y * gridDim.z;
    unsigned sum, cnt, mine, sp = 0u;
    for (;;) {
        sum = 0u; cnt = 0u; mine = 0u;
#pragma unroll
        for (unsigned j = 0; j < 16; ++j) { const unsigned c = xb_ld(&bar[XB_XCNT(j)]); sum += c; cnt += (c > 0u) ? 1u : 0u; mine = (j == x) ? c : mine; }
        if (sum == G) break;
        __builtin_amdgcn_s_sleep(1);
        if ((++sp & 255u) == 0u) { if (xb_ld(&bar[XB_TMO])) break; if (sp > XB_SPIN_CAP) { atomicAdd(&bar[XB_TMO], 1u); break; } }
    }
    nloc = mine > 0u ? mine : 1u; nx = cnt > 0u ? cnt : 1u;
}

__device__ __forceinline__ void xcd_barrier(const XcdBarrier& b) {
    asm volatile("s_waitcnt vmcnt(0)" ::: "memory");
    __syncthreads();
    if (threadIdx.x == 0) {
        unsigned* bar = b.bar;
        __builtin_amdgcn_s_waitcnt(0);
        unsigned nloc = b.st[0], nx = b.st[1];
        if (nloc == 0u) { xcd_barrier_complete(bar, b.x, nloc, nx); b.st[0] = nloc; b.st[1] = nx; }
        const unsigned old = xb_add(&bar[XB_XSUB(b.x)], 1u);
        const unsigned gen = old / nloc;
        if (old + 1u == (gen + 1u) * nloc) {
            __builtin_amdgcn_fence(__ATOMIC_RELEASE, "agent");
            asm volatile("s_waitcnt vmcnt(0)" ::: "memory");
            const unsigned og = xb_add(&bar[XB_TOP], 1u);
            const unsigned tg = og / nx;
            if (og + 1u == (tg + 1u) * nx) xb_add(&bar[XB_TOPGEN], 1u);
            else XB_SPIN(xb_ld(&bar[XB_TOPGEN]) == tg, bar);
            __builtin_amdgcn_fence(__ATOMIC_ACQUIRE, "agent");
            xb_add(&bar[XB_XGEN(b.x)], 1u);
            asm volatile("s_waitcnt vmcnt(0)" ::: "memory");
        } else {
            XB_SPIN(xb_ld(&bar[XB_XGEN(b.x)]) == gen, bar);
            __builtin_amdgcn_fence(__ATOMIC_ACQUIRE, "agent");
            asm volatile("s_waitcnt vmcnt(0)" ::: "memory");
        }
    }
    __syncthreads();
}
namespace pg8 {
constexpr int BM = 256, BK = 64, HALF = 128, HTB = HALF * BK * 2, STAGE_BYTES = 8 * HTB, NXCD = 8, WGM = 8;
__host__ __device__ __forceinline__ int lds_byte(int r, int c) { const int st = (r >> 4) * 2 + (c >> 5), rr = r & 15, cc = c & 31, ob = rr * 64 + cc * 2; return st * 1024 + (ob ^ (((ob >> 9) & 1) << 5)); }
__host__ __device__ __forceinline__ void stage_rc(int b, int& R, int& C) { const int st = b / 1024, sb = b % 1024, swz = sb ^ (((sb >> 9) & 1) << 5); R = (st >> 1) * 16 + swz / 64; C = (st & 1) * 32 + (swz % 64) / 2; }
__host__ __device__ __forceinline__ int perm32(int rho) { const int n = rho >> 4, i = rho & 15; return 8 * (i >> 2) + 4 * n + (i & 3); }

struct Unit { const char* a; const char* b; int pm, pn, z; };

struct DenseOrder {
    const char* A; const char* Bt; int K; int nM, nN, nwg, G, c;
    __device__ void init(const void* A_, const void* Bt_, int M, int N, int K_, int G_, int c_) { A = (const char*)A_; Bt = (const char*)Bt_; K = K_; nM = M / BM; nN = N / BM; nwg = nM * nN; G = G_; c = c_; }
    __device__ bool next(int i, Unit& u) const {
        const long L = (long)i * G + c; if (L >= nwg) return false;
        int wgid = (int)L; { const int q = nwg / NXCD, r = nwg % NXCD, xcd = wgid % NXCD, off = wgid / NXCD; wgid = (xcd < r ? xcd * (q + 1) : r * (q + 1) + (xcd - r) * q) + off; }
        const int nig = WGM * nN, gid = wgid / nig, fm = gid * WGM, gsz = (nM - fm) < WGM ? (nM - fm) : WGM;
        u.pm = fm + ((wgid % nig) % gsz); u.pn = (wgid % nig) / gsz; u.z = 0;
        u.a = A + (size_t)u.pm * BM * K * 2; u.b = Bt + (size_t)u.pn * BM * K * 2; return true;
    }
};

template <class Epi, class Sched>
__device__ __forceinline__ void gemm_phase(LAS unsigned char* lds, const int K, const Sched& S, const Epi& E) {
    int tid_ = threadIdx.x; asm volatile("" : "+v"(tid_));
    const int tid = tid_, wid = __builtin_amdgcn_readfirstlane(tid >> 6), lane = tid & 63, wr = wid >> 2, wc = wid & 3, fr = lane & 15, fq = lane >> 4;
    const int nt = K / BK;
    unsigned voffA[2], voffB[2];
#pragma unroll
    for (int i = 0; i < 2; ++i) { int R, C; stage_rc(tid * 16 + i * 8192, R, C); const int Rb = Epi::PERM ? ((R & ~31) + perm32(R & 31)) : R;
        voffA[i] = (unsigned)(R * K + C) * 2u; voffB[i] = (unsigned)(Rb * K + C) * 2u; }
    const size_t kstep = (size_t)(BK * 2);
    const size_t hstep = (size_t)HALF * K * 2;
    const unsigned ldsw = (unsigned)wid * 1024u;
    const int aoff = lds_byte(wr * 64 + fr, fq * 8), boff = lds_byte(wc * 32 + fr, fq * 8);
#define PG8_SA(b, h) (((b) * 2 + (h)) * HTB)
#define PG8_SB(b, h) ((4 + (b) * 2 + (h)) * HTB)
#define PG8_STAGE(bufoff, gbase, voff) do { _Pragma("unroll") for (int _i = 0; _i < 2; ++_i) \
        __builtin_amdgcn_global_load_lds((const unsigned*)((const char*)(gbase) + (voff)[_i]), (LAS unsigned*)(lds + (bufoff) + ldsw + _i * 8192), 16, 0, 0); } while (0)
#define PG8_LDA(dst, b, h) do { _Pragma("unroll") for (int m = 0; m < 4; ++m) _Pragma("unroll") for (int k = 0; k < 2; ++k) dst[m][k] = *(const LAS bf16x8*)(lds + PG8_SA(b, h) + aoff + m * 2048 + k * 1024); } while (0)
#define PG8_LDB(dst, b, h) do { _Pragma("unroll") for (int n = 0; n < 2; ++n) _Pragma("unroll") for (int k = 0; k < 2; ++k) dst[n][k] = *(const LAS bf16x8*)(lds + PG8_SB(b, h) + boff + n * 2048 + k * 1024); } while (0)
#define PG8_MMA(ai, bj, At, Bt) do { __builtin_amdgcn_s_setprio(1); _Pragma("unroll") for (int m = 0; m < 4; ++m) _Pragma("unroll") for (int n = 0; n < 2; ++n) _Pragma("unroll") for (int k = 0; k < 2; ++k) \
        acc[ai][bj][m][n] = __builtin_amdgcn_mfma_f32_16x16x32_bf16(Bt[n][k], At[m][k], acc[ai][bj][m][n], 0, 0, 0); __builtin_amdgcn_s_setprio(0); } while (0)
#define PG8_WAIT_V(n) asm volatile("s_waitcnt vmcnt(" #n ")" ::: "memory")
#define PG8_WAIT_L(n) asm volatile("s_waitcnt lgkmcnt(" #n ")" ::: "memory")
#define PG8_BAR __builtin_amdgcn_s_barrier()
#define PG8_SCHED __builtin_amdgcn_sched_barrier(0)
    Unit cur, nxt; int ui = 0;
    if (!S.next(0, cur)) return;
    f32x4 acc[2][2][4][2];
#pragma unroll
    for (int a = 0; a < 2; ++a)
#pragma unroll
        for (int b = 0; b < 2; ++b)
#pragma unroll
            for (int m = 0; m < 4; ++m)
#pragma unroll
                for (int n = 0; n < 2; ++n) acc[a][b][m][n] = (f32x4){0.f, 0.f, 0.f, 0.f};
    bf16x8 At[4][2], B0[2][2], B1[2][2];
    const char* cA = cur.a; const char* cB = cur.b;
    PG8_STAGE(PG8_SB(0, 0), cB, voffB); PG8_STAGE(PG8_SA(0, 0), cA, voffA); PG8_STAGE(PG8_SB(0, 1), cB + hstep, voffB); PG8_STAGE(PG8_SA(0, 1), cA + hstep, voffA);
    if (wr == 1) PG8_BAR;
    PG8_WAIT_V(4); PG8_BAR;
    PG8_STAGE(PG8_SB(1, 0), cB + kstep, voffB); PG8_STAGE(PG8_SA(1, 0), cA + kstep, voffA); PG8_STAGE(PG8_SB(1, 1), cB + hstep + kstep, voffB);
    PG8_WAIT_V(6); PG8_BAR;
    for (;;) {
        const bool has_next = S.next(ui + 1, nxt);
        const char* nA = has_next ? nxt.a : cA; const char* nB = has_next ? nxt.b : cB;
        for (int t = 0; t < nt; t += 2) {
            const bool last = (t == nt - 2);
            const char* a1 = cA + (size_t)(t + 1) * kstep;
            const char* a2 = last ? nA : cA + (size_t)(t + 2) * kstep; const char* b2 = last ? nB : cB + (size_t)(t + 2) * kstep;
            const char* a3 = a2 + kstep; const char* b3 = b2 + kstep;
            PG8_LDB(B0, 0, 0); PG8_SCHED; PG8_LDA(At, 0, 0); PG8_STAGE(PG8_SA(1, 1), a1 + hstep, voffA);
            PG8_WAIT_L(8); PG8_BAR; PG8_WAIT_L(0); PG8_MMA(0, 0, At, B0); PG8_BAR; PG8_SCHED;
            PG8_LDB(B1, 0, 1); PG8_STAGE(PG8_SB(0, 0), b2, voffB);
            PG8_BAR; PG8_WAIT_L(0); PG8_MMA(0, 1, At, B1); PG8_BAR;
            PG8_LDA(At, 0, 1); PG8_STAGE(PG8_SA(0, 0), a2, voffA);
            PG8_BAR; PG8_WAIT_L(0); PG8_MMA(1, 0, At, B0); PG8_BAR; PG8_SCHED;
            PG8_STAGE(PG8_SB(0, 1), b2 + hstep, voffB);
            PG8_WAIT_V(6); PG8_BAR; PG8_MMA(1, 1, At, B1); PG8_BAR;
            PG8_LDB(B0, 1, 0); PG8_SCHED; PG8_LDA(At, 1, 0); PG8_STAGE(PG8_SA(0, 1), a2 + hstep, voffA);
            PG8_WAIT_L(8); PG8_BAR; PG8_WAIT_L(0); PG8_MMA(0, 0, At, B0); PG8_BAR; PG8_SCHED;
            PG8_LDB(B1, 1, 1); PG8_STAGE(PG8_SB(1, 0), b3, voffB);
            PG8_BAR; PG8_WAIT_L(0); PG8_MMA(0, 1, At, B1); PG8_BAR;
            PG8_LDA(At, 1, 1); PG8_STAGE(PG8_SA(1, 0), a3, voffA);
            PG8_BAR; PG8_WAIT_L(0); PG8_MMA(1, 0, At, B0); PG8_BAR; PG8_SCHED;
            PG8_STAGE(PG8_SB(1, 1), b3 + hstep, voffB);
            PG8_WAIT_V(6); PG8_BAR; PG8_MMA(1, 1, At, B1); PG8_BAR;
        }
        E(acc, cur, wr, wc, fr, fq);
        if (!has_next) break;
#pragma unroll
        for (int a = 0; a < 2; ++a)
#pragma unroll
            for (int b = 0; b < 2; ++b)
#pragma unroll
                for (int m = 0; m < 4; ++m)
#pragma unroll
                    for (int n = 0; n < 2; ++n) acc[a][b][m][n] = (f32x4){0.f, 0.f, 0.f, 0.f};
        cur = nxt; cA = nA; cB = nB; ++ui;
    }
    PG8_WAIT_V(0);
    if (wr == 0) PG8_BAR;
    PG8_BAR;
#undef PG8_SA
#undef PG8_SB
#undef PG8_STAGE
#undef PG8_LDA
#undef PG8_LDB
#undef PG8_MMA
#undef PG8_WAIT_V
#undef PG8_WAIT_L
#undef PG8_BAR
#undef PG8_SCHED
}
}
__host__ __device__ __forceinline__ int ropemap128(int o) { if (o >= 32) return o; const int a = o >> 3, b = o & 7; return b < 4 ? 4 * a + b : 16 + 4 * a + (b - 4); }
__host__ __device__ __forceinline__ int ropemap64(int o) { if (o >= 16) return o; const int a = o >> 3, b = o & 7; return b < 4 ? 4 * a + b : 8 + 4 * a + (b - 4); }
__host__ __device__ __forceinline__ int colmap_proj(int s) {
    if (s < 1024) return s;
    if (s < 2048) { const int base = s < 1536 ? 1024 : 1536, o = s - base; return base + (o & ~127) + ropemap128(o & 127); }
    if (s < 2560) return s;
    if (s < 2816) { const int o = s - 2560; return 2560 + (o & ~63) + ropemap64(o & 63); }
    if (s < 3072) { const int o = s - 2816; if (o < 64) return 2816 + ropemap64(o); if (o < 68) return 2880 + (o - 64); return -1; }
    if (s < 4608) return 2884 + (s - 3072);
    return 4420 + (s - 4608);
}

struct EpiProj {
    static constexpr bool PERM = true;
    bf16_t *UA, *VA, *Q, *Kk, *VB, *QI, *KI, *CB, *CC, *CX; float* WI; unsigned char* G8;
    const float *cosq, *sinq, *cosi, *sini;
    __device__ __forceinline__ void operator()(const f32x4 (&acc)[2][2][4][2], const pg8::Unit& u, int wr, int wc, int fr, int fq) const {
        const int pn = u.pn;
        const int row0 = u.pm * 256 + wr * 64 + fr;
        const int cw = wc * 32 + 8 * fq;
        if (pn < 4 || (pn >= 8 && pn < 10) || (pn >= 12 && pn < 18)) {
            bf16_t* base; int ld = 512, c0 = (pn & 1) * 256;
            if (pn < 2) base = UA; else if (pn < 4) base = VA; else if (pn < 10) base = VB; else if (pn < 14) base = CB; else if (pn < 16) base = CC; else base = CX;
            const bool act = pn < 4;
#pragma unroll
            for (int ai = 0; ai < 2; ++ai)
#pragma unroll
                for (int m = 0; m < 4; ++m) { bf16_t* rowp = base + (size_t)(row0 + ai * 128 + m * 16) * ld + c0 + cw;
#pragma unroll
                    for (int bj = 0; bj < 2; ++bj) { f32x4 v0 = acc[ai][bj][m][0], v1 = acc[ai][bj][m][1];
                        if (act) {
#pragma unroll
                            for (int j = 0; j < 4; ++j) { v0[j] = gelu_tanh(v0[j]); v1[j] = gelu_tanh(v1[j]); } }
                        u32x4 w; w.x = cvtpk(v0[0], v0[1]); w.y = cvtpk(v0[2], v0[3]); w.z = cvtpk(v1[0], v1[1]); w.w = cvtpk(v1[2], v1[3]);
                        *(u32x4*)(rowp + bj * 128) = w; } }
        } else if (pn < 8) {
            bf16_t* base = pn < 6 ? Q : Kk; const int c0 = (pn & 1) * 256;
#pragma unroll
            for (int ai = 0; ai < 2; ++ai)
#pragma unroll
                for (int m = 0; m < 4; ++m) { const int row = row0 + ai * 128 + m * 16; bf16_t* rowp = base + (size_t)row * 512 + c0 + cw;
                    f32x4 cs = {1.f, 1.f, 1.f, 1.f}, sn = {0.f, 0.f, 0.f, 0.f};
                    if (wc == 0) { cs = *(const f32x4*)(cosq + (size_t)row * 16 + 4 * fq); sn = *(const f32x4*)(sinq + (size_t)row * 16 + 4 * fq); }
#pragma unroll
                    for (int bj = 0; bj < 2; ++bj) { const f32x4 x1 = acc[ai][bj][m][0], x2 = acc[ai][bj][m][1];
                        f32x4 v0 = x1, v1 = x2;
                        if (wc == 0) { v0 = x1 * cs - x2 * sn; v1 = x1 * sn + x2 * cs; }
                        u32x4 w; w.x = cvtpk(v0[0], v0[1]); w.y = cvtpk(v0[2], v0[3]); w.z = cvtpk(v1[0], v1[1]); w.w = cvtpk(v1[2], v1[3]);
                        *(u32x4*)(rowp + bj * 128) = w; } }
        } else if (pn == 10) {
            const bool rot = ((wc & 1) == 0) && fq < 2;
#pragma unroll
            for (int ai = 0; ai < 2; ++ai)
#pragma unroll
                for (int m = 0; m < 4; ++m) { const int row = row0 + ai * 128 + m * 16; bf16_t* rowp = QI + (size_t)row * 256 + cw;
                    f32x4 cs = {1.f, 1.f, 1.f, 1.f}, sn = {0.f, 0.f, 0.f, 0.f};
                    if (rot) { cs = *(const f32x4*)(cosi + (size_t)row * 8 + 4 * fq); sn = *(const f32x4*)(sini + (size_t)row * 8 + 4 * fq); }
#pragma unroll
                    for (int bj = 0; bj < 2; ++bj) { const f32x4 x1 = acc[ai][bj][m][0], x2 = acc[ai][bj][m][1];
                        const f32x4 v0 = x1 * cs - x2 * sn, v1 = x1 * sn + x2 * cs;
                        u32x4 w; w.x = cvtpk(v0[0], v0[1]); w.y = cvtpk(v0[2], v0[3]); w.z = cvtpk(v1[0], v1[1]); w.w = cvtpk(v1[2], v1[3]);
                        *(u32x4*)(rowp + bj * 128) = w; } }
        } else if (pn == 11) {
            const bool rot = (wc == 0) && fq < 2;
#pragma unroll
            for (int ai = 0; ai < 2; ++ai)
#pragma unroll
                for (int m = 0; m < 4; ++m) { const int row = row0 + ai * 128 + m * 16;
                    if (wc < 2) {
                        f32x4 cs = {1.f, 1.f, 1.f, 1.f}, sn = {0.f, 0.f, 0.f, 0.f};
                        if (rot) { cs = *(const f32x4*)(cosi + (size_t)row * 8 + 4 * fq); sn = *(const f32x4*)(sini + (size_t)row * 8 + 4 * fq); }
                        const f32x4 x1 = acc[ai][0][m][0], x2 = acc[ai][0][m][1];
                        const f32x4 v0 = x1 * cs - x2 * sn, v1 = x1 * sn + x2 * cs;
                        u32x4 w; w.x = cvtpk(v0[0], v0[1]); w.y = cvtpk(v0[2], v0[3]); w.z = cvtpk(v1[0], v1[1]); w.w = cvtpk(v1[2], v1[3]);
                        *(u32x4*)(KI + (size_t)row * 64 + cw) = w;
                    } else if (wc == 2 && fq == 0) {
                        *(f32x4*)(WI + (size_t)row * 4) = acc[ai][0][m][0] * 0.0625f;
                    } }
        } else {
            unsigned char* base = G8 + (size_t)(pn - 18) * 256 + cw;
#pragma unroll
            for (int ai = 0; ai < 2; ++ai)
#pragma unroll
                for (int m = 0; m < 4; ++m) { unsigned char* rowp = base + (size_t)(row0 + ai * 128 + m * 16) * 3072;
#pragma unroll
                    for (int bj = 0; bj < 2; ++bj) { const f32x4 v0 = acc[ai][bj][m][0], v1 = acc[ai][bj][m][1];
                        unsigned q[8];
#pragma unroll
                        for (int j = 0; j < 4; ++j) { q[j] = (unsigned)(fast_sigmoid(v0[j]) * 255.0f + 0.5f); q[4 + j] = (unsigned)(fast_sigmoid(v1[j]) * 255.0f + 0.5f); }
                        u32x2 w; w.x = q[0] | (q[1] << 8) | (q[2] << 16) | (q[3] << 24); w.y = q[4] | (q[5] << 8) | (q[6] << 16) | (q[7] << 24);
                        *(u32x2*)(rowp + bj * 128) = w; } }
        }
    }
};

struct EpiMerge {
    static constexpr bool PERM = true;
    bf16_t* MG; const unsigned char* G8;
    __device__ __forceinline__ void operator()(const f32x4 (&acc)[2][2][4][2], const pg8::Unit& u, int wr, int wc, int fr, int fq) const {
        const int row0 = u.pm * 256 + wr * 64 + fr, col0 = u.pn * 256 + wc * 32 + 8 * fq, z = u.z;
#pragma unroll
        for (int ai = 0; ai < 2; ++ai)
#pragma unroll
            for (int m = 0; m < 4; ++m) { const int row = row0 + ai * 128 + m * 16;
#pragma unroll
                for (int bj = 0; bj < 2; ++bj) {
                    const u32x2 g = *(const u32x2*)(G8 + (size_t)row * 3072 + z * 1024 + col0 + bj * 128);
                    bf16_t* mp = MG + (size_t)row * 1024 + col0 + bj * 128;
                    u32x4 p = {0u, 0u, 0u, 0u};
                    if (z > 0) p = *(const u32x4*)mp;
                    const f32x4 a0 = acc[ai][bj][m][0], a1 = acc[ai][bj][m][1];
                    const float s = 1.0f / 255.0f;
                    u32x4 w;
                    w.x = cvtpk(bf_lo(p.x) + a0[0] * ((float)(g.x & 255u) * s), bf_hi(p.x) + a0[1] * ((float)((g.x >> 8) & 255u) * s));
                    w.y = cvtpk(bf_lo(p.y) + a0[2] * ((float)((g.x >> 16) & 255u) * s), bf_hi(p.y) + a0[3] * ((float)(g.x >> 24) * s));
                    w.z = cvtpk(bf_lo(p.z) + a1[0] * ((float)(g.y & 255u) * s), bf_hi(p.z) + a1[1] * ((float)((g.y >> 8) & 255u) * s));
                    w.w = cvtpk(bf_lo(p.w) + a1[2] * ((float)((g.y >> 16) & 255u) * s), bf_hi(p.w) + a1[3] * ((float)(g.y >> 24) * s));
                    *(u32x4*)mp = w; }
                asm volatile("" ::: "memory"); }
    }
};
struct MergeOrder {
    const char* Rb; const char* Wb; int G, c;
    __device__ bool next(int i, pg8::Unit& u) const {
        const int tile = (i / 3) * G + c; if (tile >= 512) return false;
        const int z = i % 3; u.pm = tile >> 2; u.pn = tile & 3; u.z = z;
        const char* a = Rb + R_UA + (size_t)(z >= 1) * (R_Q - R_UA) + (size_t)(z >= 2) * (R_CB - R_Q); const char* b = Wb + (size_t)z * DM * 512 * 2;
        u.a = a + (size_t)u.pm * 256 * 512 * 2; u.b = b + (size_t)u.pn * 256 * 512 * 2; return true;
    }
};

struct EpiWout {
    static constexpr bool PERM = false;
    const float* xin; float* xout;
    __device__ __forceinline__ void operator()(const f32x4 (&acc)[2][2][4][2], const pg8::Unit& u, int wr, int wc, int fr, int fq) const {
        const int row0 = u.pm * 256 + wr * 64 + fr, col0 = u.pn * 256 + wc * 32 + 4 * fq;
#pragma unroll
        for (int ai = 0; ai < 2; ++ai)
#pragma unroll
            for (int m = 0; m < 4; ++m) { const size_t off = (size_t)(row0 + ai * 128 + m * 16) * 1024 + col0;
#pragma unroll
                for (int bj = 0; bj < 2; ++bj)
#pragma unroll
                    for (int n = 0; n < 2; ++n) { const f32x4 b = *(const f32x4*)(xin + off + bj * 128 + n * 16); *(f32x4*)(xout + off + bj * 128 + n * 16) = b + acc[ai][bj][m][n]; }
                asm volatile("" ::: "memory"); }
    }
};
struct EpiRouter {
    static constexpr bool PERM = false;
    float* LOG;
    __device__ __forceinline__ void operator()(const f32x4 (&acc)[2][2][4][2], const pg8::Unit& u, int wr, int wc, int fr, int fq) const {
        if (wc >= 2) return;
        const int row0 = u.pm * 256 + wr * 64 + fr, col0 = wc * 32 + 4 * fq;
#pragma unroll
        for (int ai = 0; ai < 2; ++ai)
#pragma unroll
            for (int m = 0; m < 4; ++m)
#pragma unroll
                for (int n = 0; n < 2; ++n) *(f32x4*)(LOG + (size_t)(row0 + ai * 128 + m * 16) * 64 + col0 + n * 16) = acc[ai][0][m][n];
    }
};
struct EpiGateUp {
    static constexpr bool PERM = true;
    bf16_t* HID;
    __device__ __forceinline__ void operator()(const f32x4 (&acc)[2][2][4][2], const pg8::Unit& u, int wr, int wc, int fr, int fq) const {
        const int row0 = u.pm * 256 + wr * 64 + fr, col0 = u.pn * 128 + wc * 16 + 4 * fq;
#pragma unroll
        for (int ai = 0; ai < 2; ++ai)
#pragma unroll
            for (int m = 0; m < 4; ++m) { bf16_t* rowp = HID + (size_t)(row0 + ai * 128 + m * 16) * 512 + col0;
#pragma unroll
                for (int bj = 0; bj < 2; ++bj) { const f32x4 g = acc[ai][bj][m][0], up = acc[ai][bj][m][1]; float h[4];
#pragma unroll
                    for (int j = 0; j < 4; ++j) h[j] = g[j] * fast_sigmoid(g[j]) * up[j];
                    u32x2 w; w.x = cvtpk(h[0], h[1]); w.y = cvtpk(h[2], h[3]); *(u32x2*)(rowp + bj * 64) = w; } }
    }
};
struct EpiDown {
    static constexpr bool PERM = true;
    bf16_t* CT; const float* wslot;
    __device__ __forceinline__ void operator()(const f32x4 (&acc)[2][2][4][2], const pg8::Unit& u, int wr, int wc, int fr, int fq) const {
        const int row0 = u.pm * 256 + wr * 64 + fr, col0 = u.pn * 256 + wc * 32 + 8 * fq;
#pragma unroll
        for (int ai = 0; ai < 2; ++ai)
#pragma unroll
            for (int m = 0; m < 4; ++m) { const int row = row0 + ai * 128 + m * 16; const float ws = wslot[row]; bf16_t* rowp = CT + (size_t)row * 1024 + col0;
#pragma unroll
                for (int bj = 0; bj < 2; ++bj) { const f32x4 v0 = acc[ai][bj][m][0] * ws, v1 = acc[ai][bj][m][1] * ws;
                    u32x4 w; w.x = cvtpk(v0[0], v0[1]); w.y = cvtpk(v0[2], v0[3]); w.z = cvtpk(v1[0], v1[1]); w.w = cvtpk(v1[2], v1[3]);
                    *(u32x4*)(rowp + bj * 128) = w; } }
    }
};
struct MoeOrder {
    const char* A; const char* Bt; const int* tiletab; size_t a_tile_bytes, b_exp_bytes, b_tile_bytes; int G, c;
    __device__ bool next(int i, pg8::Unit& u) const {
        const int L = i * G + c; const int ntile = tiletab[0]; if (L >= ntile * 4) return false;
        const int rt = L >> 2, pn = L & 3, e = tiletab[1 + rt];
        u.pm = rt; u.pn = pn; u.z = e; u.a = A + (size_t)rt * a_tile_bytes; u.b = Bt + (size_t)e * b_exp_bytes + (size_t)pn * b_tile_bytes; return true;
    }
};
struct SrcCol { const float* p; int ld; };
template <class SrcFn>
__device__ __forceinline__ void cvt_item(const SrcFn& src, bf16_t* dst, int K, int k0, int n0, LAS float* scr, int lane) {
    const SrcCol sc = src(n0 + (lane & 31));
#pragma unroll 8
    for (int i = 0; i < 32; ++i) { const int kk = 2 * i + (lane >> 5); scr[kk * 33 + (lane & 31)] = sc.p ? sc.p[(size_t)(k0 + kk) * sc.ld] : 0.f; }
    LDS_WAIT(); asm volatile("" ::: "memory");
    const int c = lane & 7;
#pragma unroll
    for (int j = 0; j < 4; ++j) { const int n = (lane >> 3) + 8 * j; const LAS float* s = scr + (8 * c) * 33 + n;
        u32x4 o; o.x = cvtpk(s[0 * 33], s[1 * 33]); o.y = cvtpk(s[2 * 33], s[3 * 33]); o.z = cvtpk(s[4 * 33], s[5 * 33]); o.w = cvtpk(s[6 * 33], s[7 * 33]);
        *(u32x4*)(dst + (size_t)(n0 + n) * K + k0 + 8 * c) = o; }
    LDS_WAIT(); asm volatile("" ::: "memory");
}
struct SrcWin { const float* w; __device__ SrcCol operator()(int n) const { const int c = colmap_proj(n); return SrcCol{c >= 0 ? w + c : nullptr, D_IN}; } };
struct SrcPlain { const float* w; int ld; __device__ SrcCol operator()(int n) const { return SrcCol{w + n, ld}; } };
struct SrcRouter { const float* wg; const float* we; __device__ SrcCol operator()(int n) const { if (n < 4) return SrcCol{wg + n, 4}; if (n < 36) return SrcCol{we + (n - 4), 32}; return SrcCol{nullptr, 1}; } };
struct SrcGateUp { const float* g; const float* u; __device__ SrcCol operator()(int n) const { const int a = n >> 3, b = n & 7; return b < 4 ? SrcCol{g + 4 * a + b, DFF} : SrcCol{u + 4 * a + (b - 4), DFF}; } };

__device__ __forceinline__ void sincos_f32(float xf, float& s, float& c) {
    const double x = (double)xf;
    const double kd = __builtin_rint(x * 0.63661977236758134308);
    double r = __builtin_fma(-kd, 1.57079632679489655800e+00, x); r = __builtin_fma(-kd, 6.12323399573676603587e-17, r);
    const double r2 = r * r;
    double sp = -2.5052108385441718775e-08; sp = sp * r2 + 2.7557319223985890653e-06; sp = sp * r2 - 1.9841269841269841270e-04; sp = sp * r2 + 8.3333333333333332177e-03; sp = sp * r2 - 1.6666666666666665741e-01;
    const double sr = r + r * r2 * sp;
    double cp = 2.0876756987868098979e-09; cp = cp * r2 - 2.7557319223985888e-07; cp = cp * r2 + 2.4801587301587301566e-05; cp = cp * r2 - 1.3888888888888889419e-03; cp = cp * r2 + 4.1666666666666664354e-02; cp = cp * r2 - 0.5;
    const double cr = 1.0 + r2 * cp;
    const int q = ((int)kd) & 3;
    const double ss = (q & 1) ? cr : sr, cc = (q & 1) ? sr : cr;
    s = (float)((q & 2) ? -ss : ss); c = (float)(((q + 1) & 2) ? -cc : cc);
}

__device__ __forceinline__ void rms_row(const float* xrow, const bf16_t* c0, const bf16_t* c1, const float* g, float* xsum_out, bf16_t* hb_out, float* f_out, int lane) {
    const f32x4* xr = (const f32x4*)xrow + lane;
    f32x4 v[4]; float s = 0.f;
#pragma unroll
    for (int j = 0; j < 4; ++j) v[j] = xr[64 * j];
    if (c0) {
#pragma unroll
        for (int j = 0; j < 4; ++j) { const u32x2 a = *((const u32x2*)c0 + lane + 64 * j), b = *((const u32x2*)c1 + lane + 64 * j);
            v[j][0] += bf_lo(a.x) + bf_lo(b.x); v[j][1] += bf_hi(a.x) + bf_hi(b.x); v[j][2] += bf_lo(a.y) + bf_lo(b.y); v[j][3] += bf_hi(a.y) + bf_hi(b.y); } }
#pragma unroll
    for (int j = 0; j < 4; ++j) s += (v[j][0] * v[j][0] + v[j][1] * v[j][1]) + (v[j][2] * v[j][2] + v[j][3] * v[j][3]);
    const float rstd = 1.0f / sqrtf(wave_sum(s) * (1.0f / DM) + EPS);
    if (xsum_out) {
#pragma unroll
        for (int j = 0; j < 4; ++j) *((f32x4*)xsum_out + lane + 64 * j) = v[j]; }
#pragma unroll
    for (int j = 0; j < 4; ++j) { const f32x4 gg = *((const f32x4*)g + lane + 64 * j); const f32x4 o = v[j] * rstd * gg;
        if (hb_out) { u32x2 w; w.x = cvtpk(o[0], o[1]); w.y = cvtpk(o[2], o[3]); *((u32x2*)hb_out + lane + 64 * j) = w; }
        if (f_out) *((f32x4*)f_out + lane + 64 * j) = o; }
}

constexpr int VN_PITCH = 1040;
#define TRRD(dst, addr, off) asm volatile("ds_read_b64_tr_b16 %0, %1 offset:%2" : "=&v"(dst) : "v"(addr), "i"(off) : "memory")
__device__ __forceinline__ void gmlp_conv_item(LAS unsigned char* lds, int item, bf16_t* UA, const bf16_t* VA, bf16_t* CB, const bf16_t* CC, const bf16_t* CX,
                                               const float* ws  , const float* bs  , const float* cw  , int wid, int lane) {
    const int t0 = item * 128;
#pragma unroll 4
    for (int pp = 0; pp < 16; ++pp) { const int p = wid * 16 + pp;
        const u32x4 raw = *((const u32x4*)(VA + (size_t)(t0 + p) * 512) + lane);
        float x[8] = {bf_lo(raw.x), bf_hi(raw.x), bf_lo(raw.y), bf_hi(raw.y), bf_lo(raw.z), bf_hi(raw.z), bf_lo(raw.w), bf_hi(raw.w)};
        float s = 0.f;
#pragma unroll
        for (int j = 0; j < 8; ++j) s += x[j];
        const float mean = wave_sum(s) * (1.0f / 512.0f); float q = 0.f;
#pragma unroll
        for (int j = 0; j < 8; ++j) { x[j] -= mean; q += x[j] * x[j]; }
        const float rstd = 1.0f / sqrtf(wave_sum(q) * (1.0f / 512.0f) + EPS);
        u32x4 o; o.x = cvtpk(x[0] * rstd, x[1] * rstd); o.y = cvtpk(x[2] * rstd, x[3] * rstd); o.z = cvtpk(x[4] * rstd, x[5] * rstd); o.w = cvtpk(x[6] * rstd, x[7] * rstd);
        *(LAS u32x4*)(lds + p * VN_PITCH + lane * 16) = o; }
    LDS_WAIT(); __syncthreads();
    {
        const int g = wid >> 1, i16 = lane & 15, g4 = lane >> 4;
        const float* Wg = ws + (size_t)g * 128 * 128;
        const unsigned trbase = (unsigned)(uintptr_t)lds + (unsigned)((8 * g4 + ((lane >> 2) & 3)) * VN_PITCH + (64 * wid + 4 * (lane & 3)) * 2);
#pragma unroll
        for (int th = 0; th < 2; ++th) {
            f32x4 acc[4][4];
#pragma unroll
            for (int ct = 0; ct < 4; ++ct)
#pragma unroll
                for (int tt = 0; tt < 4; ++tt) acc[ct][tt] = (f32x4){0.f, 0.f, 0.f, 0.f};
#pragma unroll
            for (int ks = 0; ks < 4; ++ks) {
                if (32 * ks > 16 * (4 * th + 3) + 15) continue;
                bf16x8 vf[4];
                const unsigned trk = trbase + (unsigned)(ks * 32 * VN_PITCH);
#pragma unroll
                for (int ct = 0; ct < 4; ++ct) { s16x4 lo, hi;
                    TRRD(lo, trk, ct * 32); TRRD(hi, trk, 4 * VN_PITCH + ct * 32);
                    asm volatile("s_waitcnt lgkmcnt(0)" ::: "memory");
                    vf[ct] = (bf16x8){lo[0], lo[1], lo[2], lo[3], hi[0], hi[1], hi[2], hi[3]}; }
                SBAR();
#pragma unroll
                for (int t4 = 0; t4 < 4; ++t4) { const int tt = 4 * th + t4;
                    if (32 * ks > 16 * tt + 15) continue;
                    const int tl = 16 * tt + i16, s0 = 32 * ks + 8 * g4;
                    const f32x4 w0 = *(const f32x4*)(Wg + (size_t)tl * 128 + s0), w1 = *(const f32x4*)(Wg + (size_t)tl * 128 + s0 + 4);
                    float wv[8] = {w0[0], w0[1], w0[2], w0[3], w1[0], w1[1], w1[2], w1[3]};
#pragma unroll
                    for (int j = 0; j < 8; ++j) wv[j] = (s0 + j <= tl) ? wv[j] : 0.f;
                    u32x4 wp; wp.x = cvtpk(wv[0], wv[1]); wp.y = cvtpk(wv[2], wv[3]); wp.z = cvtpk(wv[4], wv[5]); wp.w = cvtpk(wv[6], wv[7]);
                    const bf16x8 wf = *reinterpret_cast<const bf16x8*>(&wp);
#pragma unroll
                    for (int ct = 0; ct < 4; ++ct) acc[ct][t4] = __builtin_amdgcn_mfma_f32_16x16x32_bf16(vf[ct], wf, acc[ct][t4], 0, 0, 0);
                }
            }
#pragma unroll
            for (int t4 = 0; t4 < 4; ++t4) { const int tl = 16 * (4 * th + t4) + i16; const float b = bs[g * 128 + tl];
#pragma unroll
                for (int ct = 0; ct < 4; ++ct) { bf16_t* up = UA + (size_t)(t0 + tl) * 512 + 64 * wid + 16 * ct + 4 * g4;
                    const u32x2 uu = *(const u32x2*)up; const f32x4 a = acc[ct][t4];
                    u32x2 o; o.x = cvtpk(bf_lo(uu.x) * (a[0] + b), bf_hi(uu.x) * (a[1] + b)); o.y = cvtpk(bf_lo(uu.y) * (a[2] + b), bf_hi(uu.y) * (a[3] + b));
                    *(u32x2*)up = o; } }
        }
    }
    {
        const int c8 = lane * 8;
        float w0[8], w1[8], w2[8], z1[8], z2[8];
#pragma unroll
        for (int j = 0; j < 8; ++j) { w0[j] = cw[c8 + j]; w1[j] = cw[512 + c8 + j]; w2[j] = cw[1024 + c8 + j]; z1[j] = 0.f; z2[j] = 0.f; }
        const int r0 = t0 + wid * 16, sq0 = r0 & (SEQ - 1);
#pragma unroll
        for (int back = 2; back >= 1; --back) {
            if (sq0 - back >= 0) { const u32x4 a = *((const u32x4*)(CC + (size_t)(r0 - back) * 512) + lane), b = *((const u32x4*)(CX + (size_t)(r0 - back) * 512) + lane);
                float z[8] = {bf_lo(a.x) * bf_lo(b.x), bf_hi(a.x) * bf_hi(b.x), bf_lo(a.y) * bf_lo(b.y), bf_hi(a.y) * bf_hi(b.y), bf_lo(a.z) * bf_lo(b.z), bf_hi(a.z) * bf_hi(b.z), bf_lo(a.w) * bf_lo(b.w), bf_hi(a.w) * bf_hi(b.w)};
#pragma unroll
                for (int j = 0; j < 8; ++j) { if (back == 2) z2[j] = z[j]; else z1[j] = z[j]; } } }
#pragma unroll 4
        for (int rr = 0; rr < 16; ++rr) { const size_t ro = (size_t)(r0 + rr) * 512;
            const u32x4 a = *((const u32x4*)(CC + ro) + lane), b = *((const u32x4*)(CX + ro) + lane), cbv = *((const u32x4*)(CB + ro) + lane);
            float z[8] = {bf_lo(a.x) * bf_lo(b.x), bf_hi(a.x) * bf_hi(b.x), bf_lo(a.y) * bf_lo(b.y), bf_hi(a.y) * bf_hi(b.y), bf_lo(a.z) * bf_lo(b.z), bf_hi(a.z) * bf_hi(b.z), bf_lo(a.w) * bf_lo(b.w), bf_hi(a.w) * bf_hi(b.w)};
            const float cbf[8] = {bf_lo(cbv.x), bf_hi(cbv.x), bf_lo(cbv.y), bf_hi(cbv.y), bf_lo(cbv.z), bf_hi(cbv.z), bf_lo(cbv.w), bf_hi(cbv.w)};
            float y[8];
#pragma unroll
            for (int j = 0; j < 8; ++j) { y[j] = cbf[j] * (w0[j] * z2[j] + w1[j] * z1[j] + w2[j] * z[j]); z2[j] = z1[j]; z1[j] = z[j]; }
            u32x4 o; o.x = cvtpk(y[0], y[1]); o.y = cvtpk(y[2], y[3]); o.z = cvtpk(y[4], y[5]); o.w = cvtpk(y[6], y[7]);
            *((u32x4*)(CB + ro) + lane) = o; }
    }
    __syncthreads();
}
typedef unsigned short u16x2 __attribute__((ext_vector_type(2)));
__device__ __forceinline__ unsigned key15(float sc) { float f = (sc + 8.0f) * 1024.0f + 0.5f; f = fminf(fmaxf(f, 1.0f), 32767.0f); return (unsigned)f; }
__device__ __forceinline__ unsigned wave_sum_u(unsigned v) {
#pragma unroll
    for (int o = 1; o < 64; o <<= 1) v += (unsigned)__shfl_xor((int)v, o);
    return v;
}
__device__ __forceinline__ unsigned long long lowest_k_bits(unsigned long long e, unsigned k) {
    unsigned long long r = 0ull;
    for (unsigned i = 0; i < k; ++i) { const unsigned long long bb = e & (0ull - e); r |= bb; e ^= bb; }
    return r;
}

__device__ __forceinline__ void select_row(const unsigned char* rowp, int ntile128, int t_seq, unsigned long long* mrow, int ntile_out, int lane, LAS unsigned long long* wl  ) {
    const int n = t_seq + 1;
    if (n <= 256) {
        const int T = lane;
        if (T < ntile_out) { const int lo = 64 * T; unsigned long long w;
            if (lo + 63 <= t_seq) w = ~0ull; else if (lo > t_seq) w = 0ull; else w = (1ull << (t_seq - lo + 1)) - 1ull;
            mrow[(size_t)T * 256] = w; }
        for (int T2 = 64 + lane; T2 < ntile_out; T2 += 64) mrow[(size_t)T2 * 256] = 0ull;
        return;
    }
    unsigned kq[4][32];
    const unsigned* rp = (const unsigned*)rowp + lane;
    const int nq = (ntile128 + 31) >> 5;
#pragma unroll
    for (int q = 0; q < 4; ++q) {
        if (q < nq) {
            const unsigned* rq = rp + 64 * (32 * q + 16); asm volatile("" : "+v"(rq));
#pragma unroll
            for (int m = 0; m < 32; ++m) kq[q][m] = rq[64 * (m - 16)];
        } else {
#pragma unroll
            for (int m = 0; m < 32; ++m) kq[q][m] = 0u;
        }
    }
#define COUNT_GE(cand, out) do { const unsigned Kc_ = (0x8000u - (cand)) * 0x10001u; const u16x2 Kv_ = __builtin_bit_cast(u16x2, Kc_); u16x2 a_ = (u16x2){0, 0}; \
        _Pragma("unroll") for (int q = 0; q < 4; ++q) { if (q < nq) { _Pragma("unroll") for (int m = 0; m < 32; ++m) { u16x2 t_ = __builtin_bit_cast(u16x2, kq[q][m]) + Kv_; t_ = t_ >> 15; a_ += t_; } } } \
        out = wave_sum_u((unsigned)a_.x + (unsigned)a_.y); } while (0)
    unsigned prefix = 0u;
    for (int bit = 14; bit >= 0; --bit) { const unsigned cand = prefix | (1u << bit); unsigned c; COUNT_GE(cand, c); if (c >= 256u) prefix = cand; }
    const unsigned tau = prefix;
    unsigned c_ge, c_gt; COUNT_GE(tau, c_ge); COUNT_GE(tau + 1u, c_gt);
#undef COUNT_GE
    unsigned rem = 256u - c_gt;
#pragma unroll
    for (int q = 0; q < 4; ++q) {
        if (q < nq) {
#pragma unroll
            for (int m = 0; m < 32; ++m) {
#pragma unroll
                for (int h = 0; h < 2; ++h) { const unsigned kv = h ? (kq[q][m] >> 16) : (kq[q][m] & 0xffffu);
                    const unsigned long long gt = __ballot(kv > tau); unsigned long long e = __ballot(kv == tau);
                    const unsigned pe = (unsigned)__popcll(e);
                    if (pe <= rem) rem -= pe; else { e = lowest_k_bits(e, rem); rem = 0u; }
                    const unsigned long long w = gt | e;
                    wl[64 * q + 2 * m + h] = w; SBAR(); }
            }
        } else {
            wl[64 * q + lane] = 0ull;
        }
    }
    LDS_WAIT();
#pragma unroll
    for (int g = 0; g < 4; ++g) { const int T = 64 * g + lane; if (T < ntile_out) mrow[(size_t)T * 256] = wl[T]; }
    LDS_WAIT();
}

__device__ __forceinline__ void indexer_item(LAS unsigned char* lds, unsigned char* scr, int b, int qt, const bf16_t* QI, const bf16_t* KI, const float* WI, unsigned long long* MASK, int wid, int lane) {
    const int s0 = qt * 16, t0 = b * SEQ + s0, i16 = lane & 15, g4 = lane >> 4;
    const int nk128 = (s0 + 16 + 127) & ~127, nsteps = nk128 >> 7;
    {
        bf16x8 bq[4][2];
#pragma unroll
        for (int hh = 0; hh < 4; ++hh)
#pragma unroll
            for (int kk = 0; kk < 2; ++kk) bq[hh][kk] = *(const bf16x8*)(QI + (size_t)(t0 + i16) * 256 + hh * 64 + kk * 32 + 8 * g4);
        const f32x4 w = *(const f32x4*)(WI + (size_t)(t0 + i16) * 4);
        const int qpos = s0 + i16;
        const int nsteps_pad = (nsteps + 31) & ~31;
        for (int st = wid; st < nsteps_pad; st += 8) {
            if (st >= nsteps) {
#pragma unroll
                for (int jp = 0; jp < 4; ++jp) *(u32x4*)(scr + (size_t)i16 * 32768 + (size_t)(64 * st + 16 * jp + 4 * g4) * 4) = (u32x4){0u, 0u, 0u, 0u};
                continue; }
#pragma unroll
            for (int jp = 0; jp < 4; ++jp) {
                unsigned kk2[2][4];
#pragma unroll
                for (int par = 0; par < 2; ++par) { const int keybase = 128 * st + 64 * par + 16 * jp;
                    const bf16_t* kp = KI + (size_t)(b * SEQ + keybase + i16) * 64 + 8 * g4;
                    const bf16x8 a0 = *(const bf16x8*)kp, a1 = *(const bf16x8*)(kp + 32);
                    float sc[4] = {0.f, 0.f, 0.f, 0.f};
#pragma unroll
                    for (int hh = 0; hh < 4; ++hh) { f32x4 d = {0.f, 0.f, 0.f, 0.f};
                        d = __builtin_amdgcn_mfma_f32_16x16x32_bf16(a0, bq[hh][0], d, 0, 0, 0); d = __builtin_amdgcn_mfma_f32_16x16x32_bf16(a1, bq[hh][1], d, 0, 0, 0);
#pragma unroll
                        for (int r = 0; r < 4; ++r) sc[r] += fmaxf(d[r], 0.f) * w[hh]; }
#pragma unroll
                    for (int r = 0; r < 4; ++r) { const int kidx = keybase + 4 * g4 + r; kk2[par][r] = (kidx <= qpos) ? key15(sc[r]) : 0u; } }
                u32x4 o; o.x = kk2[0][0] | (kk2[1][0] << 16); o.y = kk2[0][1] | (kk2[1][1] << 16); o.z = kk2[0][2] | (kk2[1][2] << 16); o.w = kk2[0][3] | (kk2[1][3] << 16);
                *(u32x4*)(scr + (size_t)i16 * 32768 + (size_t)(64 * st + 16 * jp + 4 * g4) * 4) = o;
            }
        }
    }
    VM_WAIT(); __syncthreads();
    __builtin_amdgcn_fence(__ATOMIC_ACQUIRE, "agent");
    VM_WAIT();
    const int qblk = s0 >> 8, ntile_out = ((s0 & ~255) + 256) >> 6;
#pragma unroll 1
    for (int rr = 0; rr < 2; ++rr) { const int i = wid * 2 + rr, tq = s0 + i;
        unsigned long long* mrow = MASK + ((size_t)(b * 64 + qblk) * 256 * 256 + (size_t)(tq & 255));
        select_row(scr + (size_t)i * 32768, nk128 >> 7, tq, mrow, ntile_out, lane, (LAS unsigned long long*)(lds + wid * 2048)); }
    VM_WAIT(); __syncthreads();
}
namespace att {
constexpr int QBLK = 32, KVBLK = 64, QB = 256, HD = 128, LDQ = 512;
constexpr int SHM_V = KVBLK * HD * 2, SHM_K = KVBLK * HD * 2;
constexpr int LDS_NEED = 2 * SHM_V + 2 * SHM_K + NWAVES * 64 * 4;
constexpr float SCALE = 0.08838834764831845f;
constexpr float THR = 8.f;
#define KSWZ(row, colB) ((row) * 256 + ((colB) ^ (((row) & 7) << 4)))
__device__ __forceinline__ int v_st(int k, int c) { const int kk = (k & ~0xC) | ((k & 4) << 1) | ((k & 8) >> 1); return ((kk >> 3) * 4 + (c >> 5)) * 512 + ((kk & 7) * 32 + (c & 31)) * 2; }
__device__ __forceinline__ int v_rd_base(int lane) { return ((lane & 3) << 3) | (((lane >> 2) & 3) << 6) | (((lane >> 4) & 1) << 5) | (((lane >> 5) & 1) << 8); }
constexpr int v_rd_off(int d0, int ks, int half) { return d0 * 512 + ks * 4096 + half * 2048; }
__device__ __forceinline__ int crow(int r, int hi) { return (r & 3) + 8 * (r >> 2) + 4 * hi; }

__device__ __forceinline__ void partialSM(f32x16& p0, f32x16& p1, float& m_reg, float& mn, float& alpha) {
    float pmax = p0[0];
#pragma unroll
    for (int r = 1; r < 16; ++r) pmax = fmaxf(pmax, p0[r]);
#pragma unroll
    for (int r = 0; r < 16; ++r) pmax = fmaxf(pmax, p1[r]);
    { auto rr = __builtin_amdgcn_permlane32_swap(__float_as_uint(pmax), __float_as_uint(pmax), false, false);
      pmax = fmaxf(__uint_as_float(rr[0]), __uint_as_float(rr[1])); }
    constexpr float C2 = 1.4426950408889634f * SCALE;
    if (__builtin_expect(__all((pmax - m_reg) * SCALE <= THR), 1)) { mn = m_reg; alpha = 1.f; }
    else { mn = fmaxf(m_reg, pmax); alpha = __builtin_amdgcn_exp2f((m_reg - mn) * C2); m_reg = mn; }
    const float mnL = -mn * C2;
#pragma unroll
    for (int r = 0; r < 16; ++r) p0[r] = fmaf(p0[r], C2, mnL);
#pragma unroll
    for (int r = 0; r < 16; ++r) p1[r] = fmaf(p1[r], C2, mnL);
#pragma unroll
    for (int r = 0; r < 16; ++r) p0[r] = __builtin_amdgcn_exp2f(p0[r]);
}
__device__ __forceinline__ void finishSM(f32x16& p0, f32x16& p1, float alpha, float& l_reg, bf16x8& pa0, bf16x8& pa1, bf16x8& pa2, bf16x8& pa3) {
#pragma unroll
    for (int r = 0; r < 16; ++r) p1[r] = __builtin_amdgcn_exp2f(p1[r]);
    float ps = 0;
#pragma unroll
    for (int r = 0; r < 16; ++r) ps += p0[r];
#pragma unroll
    for (int r = 0; r < 16; ++r) ps += p1[r];
    { auto rr = __builtin_amdgcn_permlane32_swap(__float_as_uint(ps), __float_as_uint(ps), false, false);
      ps = __uint_as_float(rr[0]) + __uint_as_float(rr[1]); }
    l_reg = l_reg * alpha + ps;
#define PK4(P, B_, OUT) do { unsigned a0 = cvtpk(P[B_+0], P[B_+1]), a1 = cvtpk(P[B_+2], P[B_+3]);                          \
        unsigned b0 = cvtpk(P[B_+4], P[B_+5]), b1 = cvtpk(P[B_+6], P[B_+7]);                                             \
        auto r0 = __builtin_amdgcn_permlane32_swap(a0, b0, false, false); auto r1 = __builtin_amdgcn_permlane32_swap(a1, b1, false, false); \
        u32x4 w = {r0[0], r1[0], r0[1], r1[1]}; OUT = *reinterpret_cast<bf16x8*>(&w); } while (0)
    PK4(p0, 0, pa0); PK4(p0, 8, pa1); PK4(p1, 0, pa2); PK4(p1, 8, pa3);
#undef PK4
}
template <int KB>
__device__ __forceinline__ void qkt(f32x16& p0, f32x16& p1, const LAS char* K_lds, int r32, int hi, const bf16x8* qr) {
    const LAS char* kb[4];
#pragma unroll
    for (int dd = 0; dd < 4; ++dd) kb[dd] = K_lds + KB * SHM_K + KSWZ(r32, (dd * 16 + hi * 8) * 2);
#pragma unroll
    for (int d0 = 0; d0 < 8; ++d0) { const LAS char* a = kb[d0 & 3] + (d0 >> 2) * 128;
        bf16x8 b0 = *reinterpret_cast<const LAS bf16x8*>(a);
        bf16x8 b1 = *reinterpret_cast<const LAS bf16x8*>(a + 32 * 256);
        p0 = __builtin_amdgcn_mfma_f32_32x32x16_bf16(b0, qr[d0], p0, 0, 0, 0);
        p1 = __builtin_amdgcn_mfma_f32_32x32x16_bf16(b1, qr[d0], p1, 0, 0, 0); }
}
template <int VB>
__device__ __forceinline__ void pv_tile(f32x16* o, int vb0, bf16x8 pa0, bf16x8 pa1, bf16x8 pa2, bf16x8 pa3) {
#define TRRD2(dst, off) asm volatile("ds_read_b64_tr_b16 %0, %1 offset:%2" : "=&v"(dst) : "v"(vb0), "i"(off) : "memory")
#define PV_D0(d0) do { s16x4 l0, l1, l2, l3, h0, h1, h2, h3; constexpr int b_ = VB * SHM_V + v_rd_off(d0, 0, 0); \
        TRRD2(l0, b_); TRRD2(h0, b_ + 2048); TRRD2(l1, b_ + 4096); TRRD2(h1, b_ + 6144); TRRD2(l2, b_ + 8192); TRRD2(h2, b_ + 10240); TRRD2(l3, b_ + 12288); TRRD2(h3, b_ + 14336); \
        asm volatile("s_waitcnt lgkmcnt(0)" ::: "memory"); SBAR();   \
        o[d0] = __builtin_amdgcn_mfma_f32_32x32x16_bf16(pa0, (bf16x8){l0[0], l0[1], l0[2], l0[3], h0[0], h0[1], h0[2], h0[3]}, o[d0], 0, 0, 0);   \
        o[d0] = __builtin_amdgcn_mfma_f32_32x32x16_bf16(pa1, (bf16x8){l1[0], l1[1], l1[2], l1[3], h1[0], h1[1], h1[2], h1[3]}, o[d0], 0, 0, 0);   \
        o[d0] = __builtin_amdgcn_mfma_f32_32x32x16_bf16(pa2, (bf16x8){l2[0], l2[1], l2[2], l2[3], h2[0], h2[1], h2[2], h2[3]}, o[d0], 0, 0, 0);   \
        o[d0] = __builtin_amdgcn_mfma_f32_32x32x16_bf16(pa3, (bf16x8){l3[0], l3[1], l3[2], l3[3], h3[0], h3[1], h3[2], h3[3]}, o[d0], 0, 0, 0); } while (0)
    PV_D0(0); PV_D0(1); PV_D0(2); PV_D0(3);
#undef PV_D0
#undef TRRD2
}
__device__ __forceinline__ void mask_init(f32x16& p0, f32x16& p1, unsigned long long mw, int hi) {
    const int lo = ~(int)((unsigned)mw >> (4 * hi)), hw = ~(int)((unsigned)(mw >> 32) >> (4 * hi));
#pragma unroll
    for (int r = 0; r < 16; ++r) { const int c = (r & 3) + 8 * (r >> 2);
        p0[r] = __int_as_float(((lo << (31 - c)) >> 31) & (int)0xFF800000);
        p1[r] = __int_as_float(((hw << (31 - c)) >> 31) & (int)0xFF800000); }
}
__device__ __forceinline__ void attn_block(LAS char* lds, const bf16_t* Qb  , const bf16_t* Kh  , const bf16_t* Vh, bf16_t* Ob, const unsigned long long* mblk  , int P0) {
    int tid_ = threadIdx.x; asm volatile("" : "+v"(tid_));
    const int tid = tid_, wid = __builtin_amdgcn_readfirstlane(tid >> 6), lane = tid & 63, r32 = lane & 31, hi = lane >> 5;
    const int NT = (P0 + QB) / KVBLK;
    LAS char* V_lds = lds; LAS char* K_lds = lds + 2 * SHM_V;
    LAS float* ws = (LAS float*)(lds + 2 * SHM_V + 2 * SHM_K) + wid * 64; LAS float* li_l = ws; LAS float* al_l = ws + 32;
    float m_reg = -1e30f, l_reg = 0; f32x16 o[4] = {};
    const int sr = tid >> 4, sc = (tid & 15) * 8, vst0 = v_st(sr, sc), vst1 = v_st(32 + sr, sc), kws = KSWZ(sr, sc * 2);
    const int vb0 = (int)(uintptr_t)V_lds + v_rd_base(lane);
    bf16x8 qr[8];
#pragma unroll
    for (int d0 = 0; d0 < 8; ++d0) qr[d0] = *(const bf16x8*)(Qb + (size_t)(wid * QBLK + r32) * LDQ + d0 * 16 + hi * 8);
    const unsigned long long* mrow = mblk + (wid * QBLK + r32);
    bf16x8 st_v0, st_v1, st_k0, st_k1;
#define SLOAD(k0) do { st_v0 = *(const bf16x8*)(Vh + (size_t)((k0) + sr) * LDQ + sc); st_v1 = *(const bf16x8*)(Vh + (size_t)((k0) + 32 + sr) * LDQ + sc); \
                       st_k0 = *(const bf16x8*)(Kh + (size_t)((k0) + sr) * LDQ + sc); st_k1 = *(const bf16x8*)(Kh + (size_t)((k0) + 32 + sr) * LDQ + sc); } while (0)
#define SWRITE(bf) do { *(LAS bf16x8*)(V_lds + (bf) * SHM_V + vst0) = st_v0; *(LAS bf16x8*)(V_lds + (bf) * SHM_V + vst1) = st_v1; \
                        *(LAS bf16x8*)(K_lds + (bf) * SHM_K + kws) = st_k0; *(LAS bf16x8*)(K_lds + (bf) * SHM_K + kws + 32 * 256) = st_k1; } while (0)
#define RESC(a) do { if (__any((a) < 1.f)) { if (hi == 0) al_l[r32] = (a); asm volatile("s_waitcnt lgkmcnt(0)" ::: "memory");              \
                     _Pragma("unroll") for (int d_ = 0; d_ < 4; ++d_) _Pragma("unroll") for (int r = 0; r < 16; ++r) o[d_][r] *= al_l[crow(r, hi)]; } } while (0)
#define STEP(BUF, t) do { \
        SWRITE(BUF); LDS_WAIT(); __syncthreads();                                          \
        const unsigned long long mw_ = mnext;                                               \
        if ((t) + 1 < NT) { SLOAD(((t) + 1) * KVBLK); mnext = mrow[(size_t)((t) + 1) * 256]; } \
        f32x16 p0, p1; float mn, alpha; bf16x8 pa0, pa1, pa2, pa3;                          \
        mask_init(p0, p1, mw_, hi);                                                         \
        qkt<BUF>(p0, p1, K_lds, r32, hi, qr);                                               \
        partialSM(p0, p1, m_reg, mn, alpha); RESC(alpha);                                   \
        finishSM(p0, p1, alpha, l_reg, pa0, pa1, pa2, pa3); SBAR();                         \
        pv_tile<BUF>(o, vb0, pa0, pa1, pa2, pa3); } while (0)
    SLOAD(0); unsigned long long mnext = mrow[0];
    for (int t = 0; t < NT; t += 2) {
        VM_WAIT(); STEP(0, t);
        VM_WAIT(); STEP(1, t + 1);
    }
    if (hi == 0) li_l[r32] = l_reg; asm volatile("s_waitcnt lgkmcnt(0)" ::: "memory");
    float rli[16];
#pragma unroll
    for (int r = 0; r < 16; ++r) rli[r] = __builtin_amdgcn_rcpf(li_l[crow(r, hi)]);
    bf16_t* Ow = Ob + (size_t)(wid * QBLK) * LDQ;
#pragma unroll
    for (int r = 0; r < 16; ++r) { const int orow = crow(r, hi);
#pragma unroll
        for (int d0 = 0; d0 < 4; ++d0) { const float v = o[d0][r] * rli[r]; const float vn = __shfl_xor(v, 1);
            if ((r32 & 1) == 0) *(unsigned*)(Ow + (size_t)orow * LDQ + d0 * 32 + r32) = cvtpk(v, vn); } }
    __syncthreads();
#undef SLOAD
#undef SWRITE
#undef RESC
#undef STEP
}
}
__device__ __forceinline__ void route_a(LAS unsigned char* lds, int blk, const float* LOG, const float* rgb, const float* reb, int* TE, float* TW, unsigned* CNT, const int tid) {
    LAS unsigned* cnt = (LAS unsigned*)lds;
    if (tid < 32) cnt[tid] = 0u;
    __syncthreads();
    if (tid < 128) { const int t = blk * 128 + tid; const float* lg = LOG + (size_t)t * 64;
        float g[4]; int grp = 0;
#pragma unroll
        for (int j = 0; j < 4; ++j) g[j] = lg[j] + rgb[j];
#pragma unroll
        for (int j = 1; j < 4; ++j) if (g[j] > g[grp]) grp = j;
        float den = 0.f;
#pragma unroll
        for (int j = 0; j < 4; ++j) den += expf(g[j] - g[grp]);
        const float gw = 1.0f / den;
        float el[8]; int i0 = 0;
#pragma unroll
        for (int j = 0; j < 8; ++j) el[j] = lg[4 + grp * 8 + j] + reb[grp * 8 + j];
#pragma unroll
        for (int j = 1; j < 8; ++j) if (el[j] > el[i0]) i0 = j;
        int i1 = (i0 == 0) ? 1 : 0;
#pragma unroll
        for (int j = 0; j < 8; ++j) if (j != i0 && j != i1 && el[j] > el[i1]) i1 = j;
        const float e1 = expf(el[i1] - el[i0]); const float w0 = gw / (1.0f + e1), w1 = gw * e1 / (1.0f + e1);
        const int x0 = grp * 8 + i0, x1 = grp * 8 + i1;
        TE[2 * t] = x0; TE[2 * t + 1] = x1; TW[2 * t] = w0; TW[2 * t + 1] = w1;
        __hip_atomic_fetch_add(&cnt[x0], 1u, __ATOMIC_RELAXED, __HIP_MEMORY_SCOPE_WORKGROUP); __hip_atomic_fetch_add(&cnt[x1], 1u, __ATOMIC_RELAXED, __HIP_MEMORY_SCOPE_WORKGROUP); }
    __syncthreads();
    if (tid < 32) CNT[blk * 32 + tid] = cnt[tid];
    __syncthreads();
}
__device__ __forceinline__ void route_b(LAS unsigned char* lds, int blk, const unsigned* CNT, const int* TE, const float* TW, const bf16_t* HB2, bf16_t* XS, float* WSLOT, int* SLOT, int* TILETAB, int wid, int lane, const int tid) {
    LAS unsigned* ptot = (LAS unsigned*)lds;
    LAS unsigned* pbef = ptot + 512;
    LAS unsigned* tot = pbef + 512;
    LAS unsigned* base = tot + 32;
    LAS unsigned* estart = base + 32;
    LAS int* pos = (LAS int*)(estart + 64);
    LAS int* lte = pos + 256;
    { const int e = tid & 31, part = tid >> 5; unsigned s = 0u, bsum = 0u;
        for (int b2 = part * 16; b2 < part * 16 + 16; ++b2) { const unsigned c = CNT[b2 * 32 + e]; s += c; if (b2 < blk) bsum += c; }
        ptot[part * 32 + e] = s; pbef[part * 32 + e] = bsum; }
    if (tid < 256) lte[tid] = TE[blk * 256 + tid];
    __syncthreads();
    if (tid < 32) { unsigned s = 0u, bsum = 0u;
        for (int p = 0; p < 16; ++p) { s += ptot[p * 32 + tid]; bsum += pbef[p * 32 + tid]; }
        tot[tid] = s; base[tid] = bsum; }
    __syncthreads();
    if (tid == 0) { unsigned run = 0u; for (int e = 0; e < 32; ++e) { estart[e] = run; run += (tot[e] + 255u) & ~255u; } estart[32] = run; }
    __syncthreads();
    if (tid < 32) { int k = (int)(estart[tid] + base[tid]);
        for (int a = 0; a < 256; ++a) if (lte[a] == tid) pos[a] = k++; }
    __syncthreads();
    for (int a = wid * 32; a < wid * 32 + 32; ++a) { const int t = blk * 128 + (a >> 1), p = pos[a];
        const u32x4* src = (const u32x4*)(HB2 + (size_t)t * 1024); u32x4* dst = (u32x4*)(XS + (size_t)p * 1024);
        dst[lane] = src[lane]; dst[64 + lane] = src[64 + lane];
        if (lane == 0) { WSLOT[p] = TW[blk * 256 + a]; SLOT[blk * 256 + a] = p; } }
    if (blk < 32) {
        const int r0 = (int)(estart[blk] + tot[blk]), r1 = (int)estart[blk + 1];
        for (int r = r0 + wid; r < r1; r += NWAVES) { u32x4* dst = (u32x4*)(XS + (size_t)r * 1024); dst[lane] = (u32x4){0u, 0u, 0u, 0u}; dst[64 + lane] = (u32x4){0u, 0u, 0u, 0u}; if (lane == 0) WSLOT[r] = 0.f; }
    }
    if (blk == 0) { if (tid == 0) TILETAB[0] = (int)(estart[32] >> 8);
        if (tid < 32) for (unsigned rt = estart[tid] >> 8; rt < (estart[tid + 1] >> 8); ++rt) TILETAB[1 + rt] = tid; }
    __syncthreads();
}

#ifndef PHASE_MASK
#define PHASE_MASK 0x3FFF
#endif
#define PK(i) ((PHASE_MASK >> (i)) & 1)
constexpr int NPH_LAYER = 13, NPHASES = 1 + DEPTH * NPH_LAYER;
struct Args {
    const float* in[20]; float* out; unsigned char* ws;
    float invq[16]; float invi[8];
    int ph_lo, ph_hi, li, pad;
};

__global__ void __launch_bounds__(NTHREADS, 2) fwd_kernel(Args args) {
    extern __shared__ __attribute__((aligned(16))) unsigned char lds_raw[];
    LAS unsigned char* lds = (LAS unsigned char*)lds_raw;
    volatile LAS unsigned* MISC = (volatile LAS unsigned*)(lds + MISC_OFF);
    const int tid = threadIdx.x;
    const int G = gridDim.x, bid = blockIdx.x;
    unsigned* ctl = (unsigned*)(args.ws + WS_CTL);
    if (tid < 64) ((LAS unsigned*)(lds + MISC_OFF))[tid] = 0u;
    __syncthreads();
    XcdBarrier bar = xcd_barrier_post(ctl + CW_BAR + args.li * XCD_BAR_WORDS, MISC + 8);
    const int lo = args.ph_lo, hi = args.ph_hi;
#define IN(k) (lo <= (k) && (k) < hi)
#define SEAM(k) do { if (IN(k) && IN((k) + 1)) xcd_barrier(bar); } while (0)
    const int NGW = G * NWAVES;
#define CAS __attribute__((address_space(4)))
#define OPQ() const CAS Args* ap = (const CAS Args*)__builtin_amdgcn_kernarg_segment_ptr(); asm volatile("" : "+s"(ap)); unsigned char* const ws = ap->ws; (void)ws; int tid_o = threadIdx.x; asm volatile("" : "+v"(tid_o)); const int lane = tid_o & 63, wid = __builtin_amdgcn_readfirstlane(tid_o >> 6), gw = bid * NWAVES + wid; (void)lane; (void)gw;

#define x_in (ap->in[0])
#define positions ((const int*)ap->in[1])
#define g_mix (ap->in[2])
#define g_ffn (ap->in[3])
#define g_fin (ap->in[4])
#define XA (ap->out)
#define cosq ((float*)(ws + WS_COSQ))
#define sinq ((float*)(ws + WS_SINQ))
#define cosi ((float*)(ws + WS_COSI))
#define sini ((float*)(ws + WS_SINI))
#define WIN ((bf16_t*)(ws + WS_WIN))
#define WP ((bf16_t*)(ws + WS_WP))
#define WO ((bf16_t*)(ws + WS_WO))
#define WR ((bf16_t*)(ws + WS_WR))
#define R (ws + WS_R)
#define HB ((bf16_t*)(R + R_HB))
#define VA ((bf16_t*)(R + R_VA))
#define CC ((bf16_t*)(R + R_CC))
#define CX ((bf16_t*)(R + R_CX))
#define UA ((bf16_t*)(R + R_UA))
#define Qm ((bf16_t*)(R + R_Q))
#define Km ((bf16_t*)(R + R_K))
#define VB ((bf16_t*)(R + R_VB))
#define CB ((bf16_t*)(R + R_CB))
#define QI ((bf16_t*)(R + R_QI))
#define KI ((bf16_t*)(R + R_KI))
#define WI ((float*)(R + R_WI))
#define G8 (R + R_G8)
#define MASK ((unsigned long long*)(R + R_MASK))
#define MG ((bf16_t*)(R + R_MERGED))
#define WGU ((bf16_t*)(R + R_WGU))
#define WD ((bf16_t*)(R + R_WD))
#define HB2 ((bf16_t*)(R + R_HB2))
#define LOG ((float*)(R + R_LOG))
#define XS ((bf16_t*)(R + R_XS))
#define HID ((bf16_t*)(R + R_HID))
#define CNT ((unsigned*)(ws + WS_MISC + MS_CNT))
#define TE ((int*)(ws + WS_MISC + MS_TE))
#define TW ((float*)(ws + WS_MISC + MS_TW))
#define SLOT ((int*)(ws + WS_MISC + MS_SLOT))
#define WSLOT ((float*)(ws + WS_MISC + MS_WSLOT))
#define TILETAB ((int*)(ws + WS_MISC + MS_TILE))

    if (PK(0) && IN(0)) { asm volatile("; PHASE_MARK 0"); OPQ();
        for (int t = bid * NTHREADS + tid_o; t < T; t += G * NTHREADS) { const float p = (float)positions[t];
#pragma unroll 4
            for (int j = 0; j < 16; ++j) { float s, c; sincos_f32(p * ap->invq[j], s, c); cosq[(size_t)t * 16 + j] = c; sinq[(size_t)t * 16 + j] = s; }
#pragma unroll 4
            for (int j = 0; j < 8; ++j) { float s, c; sincos_f32(p * ap->invi[j], s, c); cosi[(size_t)t * 8 + j] = c; sini[(size_t)t * 8 + j] = s; } }
        LAS float* scr = (LAS float*)(lds + wid * 16384);
        constexpr int I_WIN = 16 * 240, I_WP = 8 * 32, I_WO = 16 * 32, I_WR = 16 * 8, I_LAYER = I_WIN + 3 * I_WP + I_WO + I_WR;
        for (int it = gw; it < DEPTH * I_LAYER; it += NGW) { const int l = it / I_LAYER; int r = it % I_LAYER;
            if (r < I_WIN) { cvt_item(SrcWin{ap->in[5] + (size_t)l * DM * D_IN}, WIN + (size_t)l * NPROJ * DM, DM, 64 * (r / 240), 32 * (r % 240), scr, lane); continue; } r -= I_WIN;
            if (r < 3 * I_WP) { const int br = r / I_WP, q = r % I_WP; cvt_item(SrcPlain{ap->in[9 + br] + (size_t)l * 512 * DM, DM}, WP + ((size_t)l * 3 + br) * DM * 512, 512, 64 * (q / 32), 32 * (q % 32), scr, lane); continue; } r -= 3 * I_WP;
            if (r < I_WO) { cvt_item(SrcPlain{ap->in[12] + (size_t)l * DM * DM, DM}, WO + (size_t)l * DM * DM, DM, 64 * (r / 32), 32 * (r % 32), scr, lane); continue; } r -= I_WO;
            cvt_item(SrcRouter{ap->in[13] + (size_t)l * DM * 4, ap->in[15] + (size_t)l * DM * 32}, WR + (size_t)l * 256 * DM, DM, 64 * (r / 8), 32 * (r % 8), scr, lane);
        }
        for (int m = gw; m < T; m += NGW) rms_row(x_in + (size_t)m * DM, nullptr, nullptr, g_mix, nullptr, HB + (size_t)m * DM, nullptr, lane);
    }
    SEAM(0);

#pragma unroll 1
    for (int l = 0; l < DEPTH; ++l) {
        const int pb = 1 + l * NPH_LAYER;
        if (PK(1) && IN(pb + 0)) { asm volatile("; PHASE_MARK 1"); OPQ();
            pg8::DenseOrder S; S.init(HB, WIN + (size_t)l * NPROJ * DM, T, NPROJ, DM, G, bid);
            EpiProj E{UA, VA, Qm, Km, VB, QI, KI, CB, CC, CX, WI, G8, cosq, sinq, cosi, sini};
            pg8::gemm_phase(lds, DM, S, E);
        }
        SEAM(pb + 0);
        if (PK(2) && IN(pb + 1)) { asm volatile("; PHASE_MARK 2"); OPQ();
            for (int item = bid; item < T / 128; item += G)
                gmlp_conv_item(lds, item, UA, VA, CB, CC, CX, ap->in[6] + (size_t)l * 4 * 128 * 128, ap->in[7] + (size_t)l * 4 * 128, ap->in[8] + (size_t)l * 3 * 512, wid, lane);
        }
        SEAM(pb + 1);
        if (PK(3) && IN(pb + 2)) { asm volatile("; PHASE_MARK 3"); OPQ();
            unsigned char* scr = (unsigned char*)(R + R_SCR + (size_t)bid * SCR_PER_WG);
            for (int i = 0; i * G < 2048; ++i) { const int idx = i * G + ((i & 1) ? (G - 1 - bid) : bid); if (idx >= 2048) continue;
                indexer_item(lds, scr, idx >> 10, idx & 1023, QI, KI, WI, MASK, wid, lane); }
        }
        SEAM(pb + 2);
        if (PK(4) && IN(pb + 3)) { asm volatile("; PHASE_MARK 4"); OPQ();
            for (int it = bid; it < 256; it += G) { const int bh = it & 7, y = it >> 3, b = bh >> 2, h = bh & 3;
#pragma unroll 1
                for (int half = 0; half < 2; ++half) { const int qb = half ? 63 - y : y, P0 = qb * 256;
                    const size_t hoff = (size_t)b * SEQ * 512 + h * 128;
                    att::attn_block((LAS char*)lds, Qm + hoff + (size_t)P0 * 512, Km + hoff, VB + hoff, Qm + hoff + (size_t)P0 * 512, MASK + (size_t)(b * 64 + qb) * 256 * 256, P0); } }
        }
        SEAM(pb + 3);
        if (PK(5) && IN(pb + 4)) { asm volatile("; PHASE_MARK 5"); OPQ();
            MergeOrder S{(const char*)R, (const char*)(WP + (size_t)l * 3 * DM * 512), G, bid};
            EpiMerge E{MG, G8};
            pg8::gemm_phase(lds, 512, S, E);
        }
        SEAM(pb + 4);
        if (PK(6) && IN(pb + 5)) { asm volatile("; PHASE_MARK 6"); OPQ();
            pg8::DenseOrder S; S.init(MG, WO + (size_t)l * DM * DM, T, DM, DM, G, bid);
            EpiWout E{l == 0 ? x_in : (const float*)XA, XA};
            pg8::gemm_phase(lds, DM, S, E);
        }
        SEAM(pb + 5);
        if (PK(7) && IN(pb + 6)) { asm volatile("; PHASE_MARK 7"); OPQ();
            for (int m = gw; m < T; m += NGW) rms_row(XA + (size_t)m * DM, nullptr, nullptr, g_ffn + (size_t)l * DM, nullptr, HB2 + (size_t)m * DM, nullptr, lane);
            LAS float* scr = (LAS float*)(lds + wid * 16384);
            constexpr int I_GU = 16 * 32, I_D = 8 * 32, I_E = I_GU + I_D;
            for (int it = gw; it < NEXP * I_E; it += NGW) { const int e = it / I_E, r = it % I_E; const size_t eo = ((size_t)l * NEXP + e) * DM * DFF;
                if (r < I_GU) cvt_item(SrcGateUp{ap->in[17] + eo, ap->in[18] + eo}, WGU + (size_t)e * DM * DM, DM, 64 * (r / 32), 32 * (r % 32), scr, lane);
                else { const int q = r - I_GU; cvt_item(SrcPlain{ap->in[19] + eo, DM}, WD + (size_t)e * DM * DFF, DFF, 64 * (q / 32), 32 * (q % 32), scr, lane); } }
        }
        SEAM(pb + 6);
        if (PK(8) && IN(pb + 7)) { asm volatile("; PHASE_MARK 8"); OPQ();
            pg8::DenseOrder S; S.init(HB2, WR + (size_t)l * 256 * DM, T, 256, DM, G, bid);
            EpiRouter E{LOG};
            pg8::gemm_phase(lds, DM, S, E);
        }
        SEAM(pb + 7);
        if (PK(9) && IN(pb + 8)) { asm volatile("; PHASE_MARK 9"); OPQ(); for (int blk = bid; blk < 256; blk += G) route_a(lds, blk, LOG, ap->in[14] + l * 4, ap->in[16] + l * 32, TE, TW, CNT, tid_o); }
        SEAM(pb + 8);
        if (PK(10) && IN(pb + 9)) { asm volatile("; PHASE_MARK 10"); OPQ(); for (int blk = bid; blk < 256; blk += G) route_b(lds, blk, CNT, TE, TW, HB2, XS, WSLOT, SLOT, TILETAB, wid, lane, tid_o); }
        SEAM(pb + 9);
        if (PK(11) && IN(pb + 10)) { asm volatile("; PHASE_MARK 11"); OPQ();
            MoeOrder S{(const char*)XS, (const char*)WGU, TILETAB, (size_t)256 * DM * 2, (size_t)DM * DM * 2, (size_t)256 * DM * 2, G, bid};
            EpiGateUp E{HID};
            pg8::gemm_phase(lds, DM, S, E);
        }
        SEAM(pb + 10);
        if (PK(12) && IN(pb + 11)) { asm volatile("; PHASE_MARK 12"); OPQ();
            MoeOrder S{(const char*)HID, (const char*)WD, TILETAB, (size_t)256 * DFF * 2, (size_t)DM * DFF * 2, (size_t)256 * DFF * 2, G, bid};
            EpiDown E{XS, WSLOT};
            pg8::gemm_phase(lds, DFF, S, E);
        }
        SEAM(pb + 11);
        if (PK(13) && IN(pb + 12)) { asm volatile("; PHASE_MARK 13"); OPQ();
            const bool lastl = (l == DEPTH - 1);
            for (int m = gw; m < T; m += NGW) { const int s0 = SLOT[2 * m], s1 = SLOT[2 * m + 1];
                rms_row(XA + (size_t)m * DM, XS + (size_t)s0 * DM, XS + (size_t)s1 * DM, lastl ? g_fin : g_mix + (size_t)(l + 1) * DM,
                        lastl ? nullptr : XA + (size_t)m * DM, lastl ? nullptr : HB + (size_t)m * DM, lastl ? XA + (size_t)m * DM : nullptr, lane); }
        }
        SEAM(pb + 12);
    }
#undef IN
#undef SEAM
#undef x_in
#undef positions
#undef g_mix
#undef g_ffn
#undef g_fin
#undef XA
#undef cosq
#undef sinq
#undef cosi
#undef sini
#undef WIN
#undef WP
#undef WO
#undef WR
#undef R
#undef HB
#undef VA
#undef CC
#undef CX
#undef UA
#undef Qm
#undef Km
#undef VB
#undef CB
#undef QI
#undef KI
#undef WI
#undef G8
#undef MASK
#undef MG
#undef WGU
#undef WD
#undef HB2
#undef LOG
#undef XS
#undef HID
#undef CNT
#undef TE
#undef TW
#undef SLOT
#undef WSLOT
#undef TILETAB
}

#ifndef N_LAUNCH_MODE
#define N_LAUNCH_MODE 0
#endif
extern "C" void kernel_launch(void* const* d_in, const int* in_sizes, int n_in, void* d_out, int out_size, void* d_ws, size_t ws_size, hipStream_t stream) {
    static int grid = 0;
    if (grid == 0) {
        if (n_in != 20 || in_sizes[0] != T * DM || out_size != T * DM || ws_size < WS_END) { fprintf(stderr, "kernel_launch: unexpected shapes (n_in %d, in0 %d, out %d, ws %zu < %zu)\n", n_in, n_in > 0 ? in_sizes[0] : -1, out_size, ws_size, (size_t)WS_END); grid = -1; return; }
        int dev = 0, cus = 0, per_cu = 0;
        if (hipGetDevice(&dev) != hipSuccess || hipDeviceGetAttribute(&cus, hipDeviceAttributeMultiprocessorCount, dev) != hipSuccess) { grid = -1; return; }
        if (hipFuncSetAttribute((const void*)fwd_kernel, hipFuncAttributeMaxDynamicSharedMemorySize, LDS_BYTES) != hipSuccess) { fprintf(stderr, "kernel_launch: hipFuncSetAttribute failed\n"); grid = -1; return; }
        if (hipOccupancyMaxActiveBlocksPerMultiprocessor(&per_cu, (const void*)fwd_kernel, NTHREADS, LDS_BYTES) != hipSuccess || per_cu < 1) { fprintf(stderr, "kernel_launch: occupancy query says %d\n", per_cu); }
        (void)hipGetLastError();
        grid = cus;
    }
    if (grid < 0) return;
    if (hipMemsetAsync((char*)d_ws + WS_CTL, 0, CTL_ZERO_BYTES, stream) != hipSuccess) return;
    Args a{};
    for (int i = 0; i < 20; ++i) a.in[i] = (const float*)d_in[i];
    a.out = (float*)d_out; a.ws = (unsigned char*)d_ws;
    for (int j = 0; j < 16; ++j) a.invq[j] = powf(500000.0f, -(float)j * 2.0f / 32.0f);
    for (int j = 0; j < 8; ++j) a.invi[j] = powf(500000.0f, -(float)j * 2.0f / 16.0f);
#if N_LAUNCH_MODE == 1
    a.ph_lo = 0; a.ph_hi = NPHASES; a.li = 0;
    hipLaunchKernelGGL(fwd_kernel, dim3(grid), dim3(NTHREADS), LDS_BYTES, stream, a);
#else
    for (int p = 0; p < NPHASES; ++p) { a.ph_lo = p; a.ph_hi = p + 1; a.li = p; hipLaunchKernelGGL(fwd_kernel, dim3(grid), dim3(NTHREADS), LDS_BYTES, stream, a); }
#endif
}
```

```cpp
#include <hip/hip_runtime.h>
#include <cstdio>
#include <cstdint>
#include <cmath>

#define LAS __attribute__((address_space(3)))
#define GAS __attribute__((address_space(1)))
typedef unsigned short bf16_t;
typedef short bf16x8 __attribute__((ext_vector_type(8)));
typedef short s16x4 __attribute__((ext_vector_type(4)));
typedef float f32x4 __attribute__((ext_vector_type(4)));
typedef float f32x16 __attribute__((ext_vector_type(16)));
typedef unsigned u32x4 __attribute__((ext_vector_type(4)));
typedef unsigned u32x2 __attribute__((ext_vector_type(2)));

constexpr int DM = 1024, NB = 2, SEQ = 16384, T = NB * SEQ, DEPTH = 2;
constexpr int D_IN = 7492, NPROJ = 7680;
constexpr int NEXP = 32, DFF = 512;
constexpr int MAXROWS = 2 * T + NEXP * 256;
constexpr float EPS = 1e-6f;
constexpr int NWAVES = 8, NTHREADS = 512;

constexpr size_t MiB = 1u << 20;
constexpr size_t WS_CTL = 0, CTL_ZERO_BYTES = 1 * MiB;
constexpr size_t WS_COSQ = 1 * MiB, WS_SINQ = 3 * MiB, WS_COSI = 5 * MiB, WS_SINI = 6 * MiB;
constexpr size_t WS_WIN = 8 * MiB;
constexpr size_t WS_WP = 38 * MiB;
constexpr size_t WS_WO = 44 * MiB;
constexpr size_t WS_WR = 48 * MiB;
constexpr size_t WS_MISC = 49 * MiB;
constexpr size_t MS_CNT = 0;
constexpr size_t MS_TE = 64 * 1024;
constexpr size_t MS_TW = MS_TE + 256 * 1024;
constexpr size_t MS_SLOT = MS_TW + 256 * 1024;
constexpr size_t MS_WSLOT = MS_SLOT + 256 * 1024;
constexpr size_t MS_TILE = MS_WSLOT + 320 * 1024;
constexpr size_t WS_R = 52 * MiB;
constexpr size_t R_HB = 0, R_VA = 64 * MiB, R_CC = 96 * MiB, R_CX = 128 * MiB, R_SCR = 0  , R_YB = 128 * MiB  , R_UA = 160 * MiB, R_Q = 192 * MiB,
                 R_K = 224 * MiB, R_VB = 256 * MiB, R_CB = 288 * MiB, R_QI = 320 * MiB, R_KI = 336 * MiB, R_WI = 340 * MiB, R_G8 = 342 * MiB, R_MASK = 438 * MiB,
                 R_MERGED = 224 * MiB  , R_MIX_END = 502 * MiB;
constexpr size_t R_WGU = 0, R_WD = 64 * MiB, R_HB2 = 96 * MiB, R_LOG = 160 * MiB, R_XS = 168 * MiB, R_HID = 312 * MiB, R_MOE_END = 384 * MiB;
constexpr size_t WS_END = WS_R + R_MIX_END;
static_assert((size_t)MAXROWS * 2048 <= 144 * MiB && (size_t)MAXROWS * 1024 <= 72 * MiB, "moe buffers");
constexpr size_t SCR_PER_WG = 512 * 1024;

constexpr int CW_ERR = 0;
constexpr int CW_BAR = 4096;

constexpr int RING_BYTES = 131072;
constexpr int LDS_BYTES = 147456;
constexpr int MISC_OFF = LDS_BYTES - 256;

#define LDS_WAIT() asm volatile("s_waitcnt lgkmcnt(0)" ::: "memory")
#define VM_WAIT() asm volatile("s_waitcnt vmcnt(0)" ::: "memory")
#define SBAR() __builtin_amdgcn_sched_barrier(0)
__device__ __forceinline__ unsigned cvtpk(float lo, float hi) { unsigned r; asm volatile("v_cvt_pk_bf16_f32 %0, %1, %2" : "=v"(r) : "v"(lo), "v"(hi)); return r; }
__device__ __forceinline__ float bf_lo(unsigned w) { return __uint_as_float(w << 16); }
__device__ __forceinline__ float bf_hi(unsigned w) { return __uint_as_float(w & 0xffff0000u); }
__device__ __forceinline__ float wave_sum(float v) {
#pragma unroll
    for (int o = 1; o < 64; o <<= 1) v += __shfl_xor(v, o);
    return v;
}
__device__ __forceinline__ float fast_sigmoid(float x) { return __builtin_amdgcn_rcpf(1.0f + __builtin_amdgcn_exp2f(-1.4426950408889634f * x)); }
__device__ __forceinline__ float gelu_tanh(float x) { const float z = 0.7978845608028654f * (x + 0.044715f * x * x * x); return x * fast_sigmoid(2.0f * z); }

#define XB_TMO      128
#define XB_XCNT(j)  (256  + 64 * (j))
#define XB_XSUB(j)  (1280 + 64 * (j))
#define XB_XGEN(j)  (2304 + 64 * (j))
#define XB_TOP      3328
#define XB_TOPGEN   3392
#define XCD_BAR_WORDS 3456
#define XB_SPIN_CAP (1u << 18)

__device__ __forceinline__ unsigned xb_ld(unsigned* p)              { return __hip_atomic_load(p, __ATOMIC_RELAXED, __HIP_MEMORY_SCOPE_AGENT); }
__device__ __forceinline__ unsigned xb_add(unsigned* p, unsigned v) { return __hip_atomic_fetch_add(p, v, __ATOMIC_RELAXED, __HIP_MEMORY_SCOPE_AGENT); }
__device__ __forceinline__ unsigned xb_xcc_id() { return (unsigned)__builtin_amdgcn_s_getreg((3 << 11) | 20) & 0xFu; }
#define XB_SPIN(cond, bar) do { unsigned _sp = 0; while (cond) { __builtin_amdgcn_s_sleep(1); \
    if ((++_sp & 255u) == 0u) { if (xb_ld(&(bar)[XB_TMO])) break; if (_sp > XB_SPIN_CAP) { atomicAdd(&(bar)[XB_TMO], 1u); break; } } } } while (0)

struct XcdBarrier {
    unsigned* bar; unsigned x;
    volatile LAS unsigned* st;
};

__device__ __forceinline__ XcdBarrier xcd_barrier_post(unsigned* bar, volatile LAS unsigned* st) {
    XcdBarrier b; b.bar = bar; b.x = xb_xcc_id(); b.st = st;
    if (threadIdx.x == 0) (void)xb_add(&bar[XB_XCNT(b.x)], 1u);
    return b;
}
__device__ __forceinline__ void xcd_barrier_complete(unsigned* bar, unsigned x, unsigned& nloc, unsigned& nx) {
    const unsigned G = gridDim.x * gridDim.y * gridDim.z;
    unsigned sum, cnt, mine, sp = 0u;
    for (;;) {
        sum = 0u; cnt = 0u; mine = 0u;
#pragma unroll
        for (unsigned j = 0; j < 16; ++j) { const unsigned c = xb_ld(&bar[XB_XCNT(j)]); sum += c; cnt += (c > 0u) ? 1u : 0u; mine = (j == x) ? c : mine; }
        if (sum == G) break;
        __builtin_amdgcn_s_sleep(1);
        if ((++sp & 255u) == 0u) { if (xb_ld(&bar[XB_TMO])) break; if (sp > XB_SPIN_CAP) { atomicAdd(&bar[XB_TMO], 1u); break; } }
    }
    nloc = mine > 0u ? mine : 1u; nx = cnt > 0u ? cnt : 1u;
}

__device__ __forceinline__ void xcd_barrier(const XcdBarrier& b) {
    asm volatile("s_waitcnt vmcnt(0)" ::: "memory");
    __syncthreads();
    unsigned xb_t = threadIdx.x; asm volatile("" : "+v"(xb_t));
    if (xb_t == 0) {
        unsigned* bar = b.bar;
        __builtin_amdgcn_s_waitcnt(0);
        unsigned nloc = b.st[0], nx = b.st[1];
        if (nloc == 0u) { xcd_barrier_complete(bar, b.x, nloc, nx); b.st[0] = nloc; b.st[1] = nx; }
        const unsigned old = xb_add(&bar[XB_XSUB(b.x)], 1u);
        const unsigned gen = old / nloc;
        if (old + 1u == (gen + 1u) * nloc) {
            __builtin_amdgcn_fence(__ATOMIC_RELEASE, "agent");
            asm volatile("s_waitcnt vmcnt(0)" ::: "memory");
            const unsigned og = xb_add(&bar[XB_TOP], 1u);
            const unsigned tg = og / nx;
            if (og + 1u == (tg + 1u) * nx) xb_add(&bar[XB_TOPGEN], 1u);
            else XB_SPIN(xb_ld(&bar[XB_TOPGEN]) == tg, bar);
            __builtin_amdgcn_fence(__ATOMIC_ACQUIRE, "agent");
            xb_add(&bar[XB_XGEN(b.x)], 1u);
            asm volatile("s_waitcnt vmcnt(0)" ::: "memory");
        } else {
            XB_SPIN(xb_ld(&bar[XB_XGEN(b.x)]) == gen, bar);
            __builtin_amdgcn_fence(__ATOMIC_ACQUIRE, "agent");
            asm volatile("s_waitcnt vmcnt(0)" ::: "memory");
        }
    }
    __syncthreads();
}
namespace pg8 {
constexpr int BM = 256, BK = 64, HALF = 128, HTB = HALF * BK * 2, STAGE_BYTES = 8 * HTB, NXCD = 8, WGM = 8;
__host__ __device__ __forceinline__ int lds_byte(int r, int c) { const int st = (r >> 4) * 2 + (c >> 5), rr = r & 15, cc = c & 31, ob = rr * 64 + cc * 2; return st * 1024 + (ob ^ (((ob >> 9) & 1) << 5)); }
__host__ __device__ __forceinline__ void stage_rc(int b, int& R, int& C) { const int st = b / 1024, sb = b % 1024, swz = sb ^ (((sb >> 9) & 1) << 5); R = (st >> 1) * 16 + swz / 64; C = (st & 1) * 32 + (swz % 64) / 2; }
__host__ __device__ __forceinline__ int perm32(int rho) { const int n = rho >> 4, i = rho & 15; return 8 * (i >> 2) + 4 * n + (i & 3); }

struct Unit { const char* a; const char* b; int pm, pn, z; };

struct DenseOrder {
    const char* A; const char* Bt; int K; int nM, nN, nwg, G, c;
    __device__ void init(const void* A_, const void* Bt_, int M, int N, int K_, int G_, int c_) { A = (const char*)A_; Bt = (const char*)Bt_; K = K_; nM = M / BM; nN = N / BM; nwg = nM * nN; G = G_; c = c_; }
    __device__ bool next(int i, Unit& u) const {
        const long L = (long)i * G + c; if (L >= nwg) return false;
        int wgid = (int)L; { const int q = nwg / NXCD, r = nwg % NXCD, xcd = wgid % NXCD, off = wgid / NXCD; wgid = (xcd < r ? xcd * (q + 1) : r * (q + 1) + (xcd - r) * q) + off; }
        const int nig = WGM * nN, gid = wgid / nig, fm = gid * WGM, gsz = (nM - fm) < WGM ? (nM - fm) : WGM;
        u.pm = fm + ((wgid % nig) % gsz); u.pn = (wgid % nig) / gsz; u.z = 0;
        u.a = A + (size_t)u.pm * BM * K * 2; u.b = Bt + (size_t)u.pn * BM * K * 2; return true;
    }
};

template <class Epi, class Sched>
__device__ __forceinline__ void gemm_phase(LAS unsigned char* lds, const int K, const Sched& S, const Epi& E) {
    int tid_ = threadIdx.x; asm volatile("" : "+v"(tid_));
    const int tid = tid_, wid = __builtin_amdgcn_readfirstlane(tid >> 6), lane = tid & 63, wr = wid >> 2, wc = wid & 3, fr = lane & 15, fq = lane >> 4;
    const int nt = K / BK;
    unsigned voffA[2], voffB[2];
#pragma unroll
    for (int i = 0; i < 2; ++i) { int R, C; stage_rc(tid * 16 + i * 8192, R, C); const int Rb = Epi::PERM ? ((R & ~31) + perm32(R & 31)) : R;
        voffA[i] = (unsigned)(R * K + C) * 2u; voffB[i] = (unsigned)(Rb * K + C) * 2u; }
    const size_t kstep = (size_t)(BK * 2);
    const size_t hstep = (size_t)HALF * K * 2;
    const unsigned ldsw = (unsigned)wid * 1024u;
    const int aoff = lds_byte(wr * 64 + fr, fq * 8), boff = lds_byte(wc * 32 + fr, fq * 8);
#define PG8_SA(b, h) (((b) * 2 + (h)) * HTB)
#define PG8_SB(b, h) ((4 + (b) * 2 + (h)) * HTB)
#define PG8_STAGE(bufoff, gbase, voff) do { _Pragma("unroll") for (int _i = 0; _i < 2; ++_i) \
        __builtin_amdgcn_global_load_lds((const unsigned*)((const char*)(gbase) + (voff)[_i]), (LAS unsigned*)(lds + (bufoff) + ldsw + _i * 8192), 16, 0, 0); } while (0)
#define PG8_LDA(dst, b, h) do { _Pragma("unroll") for (int m = 0; m < 4; ++m) _Pragma("unroll") for (int k = 0; k < 2; ++k) dst[m][k] = *(const LAS bf16x8*)(lds + PG8_SA(b, h) + aoff + m * 2048 + k * 1024); } while (0)
#define PG8_LDB(dst, b, h) do { _Pragma("unroll") for (int n = 0; n < 2; ++n) _Pragma("unroll") for (int k = 0; k < 2; ++k) dst[n][k] = *(const LAS bf16x8*)(lds + PG8_SB(b, h) + boff + n * 2048 + k * 1024); } while (0)
#define PG8_MMA(ai, bj, At, Bt) do { __builtin_amdgcn_s_setprio(1); _Pragma("unroll") for (int m = 0; m < 4; ++m) _Pragma("unroll") for (int n = 0; n < 2; ++n) _Pragma("unroll") for (int k = 0; k < 2; ++k) \
        acc[ai][bj][m][n] = __builtin_amdgcn_mfma_f32_16x16x32_bf16(Bt[n][k], At[m][k], acc[ai][bj][m][n], 0, 0, 0); __builtin_amdgcn_s_setprio(0); } while (0)
#define PG8_WAIT_V(n) asm volatile("s_waitcnt vmcnt(" #n ")" ::: "memory")
#define PG8_WAIT_L(n) asm volatile("s_waitcnt lgkmcnt(" #n ")" ::: "memory")
#define PG8_BAR __builtin_amdgcn_s_barrier()
#define PG8_SCHED __builtin_amdgcn_sched_barrier(0)
    Unit cur, nxt; int ui = 0;
    if (!S.next(0, cur)) return;
    f32x4 acc[2][2][4][2];
#pragma unroll
    for (int a = 0; a < 2; ++a)
#pragma unroll
        for (int b = 0; b < 2; ++b)
#pragma unroll
            for (int m = 0; m < 4; ++m)
#pragma unroll
                for (int n = 0; n < 2; ++n) acc[a][b][m][n] = (f32x4){0.f, 0.f, 0.f, 0.f};
    bf16x8 At[4][2], B0[2][2], B1[2][2];
    const char* cA = cur.a; const char* cB = cur.b;
    PG8_STAGE(PG8_SB(0, 0), cB, voffB); PG8_STAGE(PG8_SA(0, 0), cA, voffA); PG8_STAGE(PG8_SB(0, 1), cB + hstep, voffB); PG8_STAGE(PG8_SA(0, 1), cA + hstep, voffA);
    if (wr == 1) PG8_BAR;
    PG8_WAIT_V(4); PG8_BAR;
    PG8_STAGE(PG8_SB(1, 0), cB + kstep, voffB); PG8_STAGE(PG8_SA(1, 0), cA + kstep, voffA); PG8_STAGE(PG8_SB(1, 1), cB + hstep + kstep, voffB);
    PG8_WAIT_V(6); PG8_BAR;
    for (;;) {
        const bool has_next = S.next(ui + 1, nxt);
        const char* nA = has_next ? nxt.a : cA; const char* nB = has_next ? nxt.b : cB;
        for (int t = 0; t < nt; t += 2) {
            const bool last = (t == nt - 2);
            const char* a1 = cA + (size_t)(t + 1) * kstep;
            const char* a2 = last ? nA : cA + (size_t)(t + 2) * kstep; const char* b2 = last ? nB : cB + (size_t)(t + 2) * kstep;
            const char* a3 = a2 + kstep; const char* b3 = b2 + kstep;
            PG8_LDB(B0, 0, 0); PG8_SCHED; PG8_LDA(At, 0, 0); PG8_STAGE(PG8_SA(1, 1), a1 + hstep, voffA);
            PG8_WAIT_L(8); PG8_BAR; PG8_WAIT_L(0); PG8_MMA(0, 0, At, B0); PG8_BAR; PG8_SCHED;
            PG8_LDB(B1, 0, 1); PG8_STAGE(PG8_SB(0, 0), b2, voffB);
            PG8_BAR; PG8_WAIT_L(0); PG8_MMA(0, 1, At, B1); PG8_BAR;
            PG8_LDA(At, 0, 1); PG8_STAGE(PG8_SA(0, 0), a2, voffA);
            PG8_BAR; PG8_WAIT_L(0); PG8_MMA(1, 0, At, B0); PG8_BAR; PG8_SCHED;
            PG8_STAGE(PG8_SB(0, 1), b2 + hstep, voffB);
            PG8_WAIT_V(6); PG8_BAR; PG8_MMA(1, 1, At, B1); PG8_BAR;
            PG8_LDB(B0, 1, 0); PG8_SCHED; PG8_LDA(At, 1, 0); PG8_STAGE(PG8_SA(0, 1), a2 + hstep, voffA);
            PG8_WAIT_L(8); PG8_BAR; PG8_WAIT_L(0); PG8_MMA(0, 0, At, B0); PG8_BAR; PG8_SCHED;
            PG8_LDB(B1, 1, 1); PG8_STAGE(PG8_SB(1, 0), b3, voffB);
            PG8_BAR; PG8_WAIT_L(0); PG8_MMA(0, 1, At, B1); PG8_BAR;
            PG8_LDA(At, 1, 1); PG8_STAGE(PG8_SA(1, 0), a3, voffA);
            PG8_BAR; PG8_WAIT_L(0); PG8_MMA(1, 0, At, B0); PG8_BAR; PG8_SCHED;
            PG8_STAGE(PG8_SB(1, 1), b3 + hstep, voffB);
            PG8_WAIT_V(6); PG8_BAR; PG8_MMA(1, 1, At, B1); PG8_BAR;
        }
        E(acc, cur, wr, wc, fr, fq);
        if (!has_next) break;
#pragma unroll
        for (int a = 0; a < 2; ++a)
#pragma unroll
            for (int b = 0; b < 2; ++b)
#pragma unroll
                for (int m = 0; m < 4; ++m)
#pragma unroll
                    for (int n = 0; n < 2; ++n) acc[a][b][m][n] = (f32x4){0.f, 0.f, 0.f, 0.f};
        cur = nxt; cA = nA; cB = nB; ++ui;
    }
    PG8_WAIT_V(0);
    if (wr == 0) PG8_BAR;
    PG8_BAR;
#undef PG8_SA
#undef PG8_SB
#undef PG8_STAGE
#undef PG8_LDA
#undef PG8_LDB
#undef PG8_MMA
#undef PG8_WAIT_V
#undef PG8_WAIT_L
#undef PG8_BAR
#undef PG8_SCHED
}
}
__host__ __device__ __forceinline__ int ropemap128(int o) { if (o >= 32) return o; const int a = o >> 3, b = o & 7; return b < 4 ? 4 * a + b : 16 + 4 * a + (b - 4); }
__host__ __device__ __forceinline__ int ropemap64(int o) { if (o >= 16) return o; const int a = o >> 3, b = o & 7; return b < 4 ? 4 * a + b : 8 + 4 * a + (b - 4); }
__host__ __device__ __forceinline__ int colmap_proj(int s) {
    if (s < 1024) return s;
    if (s < 2048) { const int base = s < 1536 ? 1024 : 1536, o = s - base; return base + (o & ~127) + ropemap128(o & 127); }
    if (s < 2560) return s;
    if (s < 2816) { const int o = s - 2560; return 2560 + (o & ~63) + ropemap64(o & 63); }
    if (s < 3072) { const int o = s - 2816; if (o < 64) return 2816 + ropemap64(o); if (o < 68) return 2880 + (o - 64); return -1; }
    if (s < 4608) return 2884 + (s - 3072);
    return 4420 + (s - 4608);
}

struct EpiProj {
    static constexpr bool PERM = true;
    unsigned char* wsb;
    __device__ __forceinline__ void operator()(const f32x4 (&acc)[2][2][4][2], const pg8::Unit& u, int wr, int wc, int fr, int fq) const {
        asm volatile("" : "+v"(fr), "+v"(fq));
        unsigned char* const Rr = wsb + WS_R;
        bf16_t* const UA = (bf16_t*)(Rr + R_UA); bf16_t* const VA = (bf16_t*)(Rr + R_VA); bf16_t* const Q = (bf16_t*)(Rr + R_Q); bf16_t* const Kk = (bf16_t*)(Rr + R_K); bf16_t* const VB = (bf16_t*)(Rr + R_VB);
        bf16_t* const QI = (bf16_t*)(Rr + R_QI); bf16_t* const KI = (bf16_t*)(Rr + R_KI); bf16_t* const CB = (bf16_t*)(Rr + R_CB); bf16_t* const CC = (bf16_t*)(Rr + R_CC); bf16_t* const CX = (bf16_t*)(Rr + R_CX);
        float* const WI = (float*)(Rr + R_WI); unsigned char* const G8 = Rr + R_G8;
        const float* const cosq = (const float*)(wsb + WS_COSQ); const float* const sinq = (const float*)(wsb + WS_SINQ); const float* const cosi = (const float*)(wsb + WS_COSI); const float* const sini = (const float*)(wsb + WS_SINI);
        const int pn = u.pn;
        const int row0 = u.pm * 256 + wr * 64 + fr;
        const int cw = wc * 32 + 8 * fq;
        if (pn < 4 || (pn >= 8 && pn < 10) || (pn >= 12 && pn < 18)) {
            bf16_t* base; int ld = 512, c0 = (pn & 1) * 256;
            if (pn < 2) base = UA; else if (pn < 4) base = VA; else if (pn < 10) base = VB; else if (pn < 14) base = CB; else if (pn < 16) base = CC; else base = CX;
            const bool act = pn < 4;
#pragma unroll
            for (int ai = 0; ai < 2; ++ai)
#pragma unroll
                for (int m = 0; m < 4; ++m) { bf16_t* rowp = base + (size_t)(row0 + ai * 128 + m * 16) * ld + c0 + cw;
#pragma unroll
                    for (int bj = 0; bj < 2; ++bj) { f32x4 v0 = acc[ai][bj][m][0], v1 = acc[ai][bj][m][1];
                        if (act) {
#pragma unroll
                            for (int j = 0; j < 4; ++j) { v0[j] = gelu_tanh(v0[j]); v1[j] = gelu_tanh(v1[j]); } }
                        u32x4 w; w.x = cvtpk(v0[0], v0[1]); w.y = cvtpk(v0[2], v0[3]); w.z = cvtpk(v1[0], v1[1]); w.w = cvtpk(v1[2], v1[3]);
                        *(u32x4*)(rowp + bj * 128) = w; } }
        } else if (pn < 8) {
            bf16_t* base = pn < 6 ? Q : Kk; const int c0 = (pn & 1) * 256;
#pragma unroll
            for (int ai = 0; ai < 2; ++ai)
#pragma unroll
                for (int m = 0; m < 4; ++m) { const int row = row0 + ai * 128 + m * 16; bf16_t* rowp = base + (size_t)row * 512 + c0 + cw;
                    f32x4 cs = {1.f, 1.f, 1.f, 1.f}, sn = {0.f, 0.f, 0.f, 0.f};
                    if (wc == 0) { cs = *(const f32x4*)(cosq + (size_t)row * 16 + 4 * fq); sn = *(const f32x4*)(sinq + (size_t)row * 16 + 4 * fq); }
#pragma unroll
                    for (int bj = 0; bj < 2; ++bj) { const f32x4 x1 = acc[ai][bj][m][0], x2 = acc[ai][bj][m][1];
                        f32x4 v0 = x1, v1 = x2;
                        if (wc == 0) { v0 = x1 * cs - x2 * sn; v1 = x1 * sn + x2 * cs; }
                        u32x4 w; w.x = cvtpk(v0[0], v0[1]); w.y = cvtpk(v0[2], v0[3]); w.z = cvtpk(v1[0], v1[1]); w.w = cvtpk(v1[2], v1[3]);
                        *(u32x4*)(rowp + bj * 128) = w; } }
        } else if (pn == 10) {
            const bool rot = ((wc & 1) == 0) && fq < 2;
#pragma unroll
            for (int ai = 0; ai < 2; ++ai)
#pragma unroll
                for (int m = 0; m < 4; ++m) { const int row = row0 + ai * 128 + m * 16; bf16_t* rowp = QI + (size_t)row * 256 + cw;
                    f32x4 cs = {1.f, 1.f, 1.f, 1.f}, sn = {0.f, 0.f, 0.f, 0.f};
                    if (rot) { cs = *(const f32x4*)(cosi + (size_t)row * 8 + 4 * fq); sn = *(const f32x4*)(sini + (size_t)row * 8 + 4 * fq); }
#pragma unroll
                    for (int bj = 0; bj < 2; ++bj) { const f32x4 x1 = acc[ai][bj][m][0], x2 = acc[ai][bj][m][1];
                        const f32x4 v0 = x1 * cs - x2 * sn, v1 = x1 * sn + x2 * cs;
                        u32x4 w; w.x = cvtpk(v0[0], v0[1]); w.y = cvtpk(v0[2], v0[3]); w.z = cvtpk(v1[0], v1[1]); w.w = cvtpk(v1[2], v1[3]);
                        *(u32x4*)(rowp + bj * 128) = w; } }
        } else if (pn == 11) {
            const bool rot = (wc == 0) && fq < 2;
#pragma unroll
            for (int ai = 0; ai < 2; ++ai)
#pragma unroll
                for (int m = 0; m < 4; ++m) { const int row = row0 + ai * 128 + m * 16;
                    if (wc < 2) {
                        f32x4 cs = {1.f, 1.f, 1.f, 1.f}, sn = {0.f, 0.f, 0.f, 0.f};
                        if (rot) { cs = *(const f32x4*)(cosi + (size_t)row * 8 + 4 * fq); sn = *(const f32x4*)(sini + (size_t)row * 8 + 4 * fq); }
                        const f32x4 x1 = acc[ai][0][m][0], x2 = acc[ai][0][m][1];
                        const f32x4 v0 = x1 * cs - x2 * sn, v1 = x1 * sn + x2 * cs;
                        u32x4 w; w.x = cvtpk(v0[0], v0[1]); w.y = cvtpk(v0[2], v0[3]); w.z = cvtpk(v1[0], v1[1]); w.w = cvtpk(v1[2], v1[3]);
                        *(u32x4*)(KI + (size_t)row * 64 + cw) = w;
                    } else if (wc == 2 && fq == 0) {
                        *(f32x4*)(WI + (size_t)row * 4) = acc[ai][0][m][0] * 0.0625f;
                    } }
        } else {
            unsigned char* base = G8 + (size_t)(pn - 18) * 256 + cw;
#pragma unroll
            for (int ai = 0; ai < 2; ++ai)
#pragma unroll
                for (int m = 0; m < 4; ++m) { unsigned char* rowp = base + (size_t)(row0 + ai * 128 + m * 16) * 3072;
#pragma unroll
                    for (int bj = 0; bj < 2; ++bj) { const f32x4 v0 = acc[ai][bj][m][0], v1 = acc[ai][bj][m][1];
                        unsigned q[8];
#pragma unroll
                        for (int j = 0; j < 4; ++j) { q[j] = (unsigned)(fast_sigmoid(v0[j]) * 255.0f + 0.5f); q[4 + j] = (unsigned)(fast_sigmoid(v1[j]) * 255.0f + 0.5f); }
                        u32x2 w; w.x = q[0] | (q[1] << 8) | (q[2] << 16) | (q[3] << 24); w.y = q[4] | (q[5] << 8) | (q[6] << 16) | (q[7] << 24);
                        *(u32x2*)(rowp + bj * 128) = w; } }
        }
    }
};

struct EpiMerge {
    static constexpr bool PERM = true;
    bf16_t* MG; const unsigned char* G8;
    __device__ __forceinline__ void operator()(const f32x4 (&acc)[2][2][4][2], const pg8::Unit& u, int wr, int wc, int fr, int fq) const {
        asm volatile("" : "+v"(fr), "+v"(fq));
        const int row0 = u.pm * 256 + wr * 64 + fr, col0 = u.pn * 256 + wc * 32 + 8 * fq, z = u.z;
#pragma unroll
        for (int ai = 0; ai < 2; ++ai)
#pragma unroll
            for (int m = 0; m < 4; ++m) { const int row = row0 + ai * 128 + m * 16;
#pragma unroll
                for (int bj = 0; bj < 2; ++bj) {
                    const u32x2 g = *(const u32x2*)(G8 + (size_t)row * 3072 + z * 1024 + col0 + bj * 128);
                    bf16_t* mp = MG + (size_t)row * 1024 + col0 + bj * 128;
                    u32x4 p = {0u, 0u, 0u, 0u};
                    if (z > 0) p = *(const u32x4*)mp;
                    const f32x4 a0 = acc[ai][bj][m][0], a1 = acc[ai][bj][m][1];
                    const float s = 1.0f / 255.0f;
                    u32x4 w;
                    w.x = cvtpk(bf_lo(p.x) + a0[0] * ((float)(g.x & 255u) * s), bf_hi(p.x) + a0[1] * ((float)((g.x >> 8) & 255u) * s));
                    w.y = cvtpk(bf_lo(p.y) + a0[2] * ((float)((g.x >> 16) & 255u) * s), bf_hi(p.y) + a0[3] * ((float)(g.x >> 24) * s));
                    w.z = cvtpk(bf_lo(p.z) + a1[0] * ((float)(g.y & 255u) * s), bf_hi(p.z) + a1[1] * ((float)((g.y >> 8) & 255u) * s));
                    w.w = cvtpk(bf_lo(p.w) + a1[2] * ((float)((g.y >> 16) & 255u) * s), bf_hi(p.w) + a1[3] * ((float)(g.y >> 24) * s));
                    *(u32x4*)mp = w; }
                asm volatile("" ::: "memory"); }
    }
};
struct MergeOrder {
    const char* Rb; const char* Wb; int G, c;
    __device__ bool next(int i, pg8::Unit& u) const {
        const int tile = (i / 3) * G + c; if (tile >= 512) return false;
        const int z = i % 3; u.pm = tile >> 2; u.pn = tile & 3; u.z = z;
        const char* a = Rb + (z == 0 ? R_UA : (z == 1 ? R_YB : R_CB)); const char* b = Wb + (size_t)z * DM * 512 * 2;
        u.a = a + (size_t)u.pm * 256 * 512 * 2; u.b = b + (size_t)u.pn * 256 * 512 * 2; return true;
    }
};

struct EpiWout {
    static constexpr bool PERM = false;
    const float* xin; float* xout;
    __device__ __forceinline__ void operator()(const f32x4 (&acc)[2][2][4][2], const pg8::Unit& u, int wr, int wc, int fr, int fq) const {
        asm volatile("" : "+v"(fr), "+v"(fq));
        const int row0 = u.pm * 256 + wr * 64 + fr, col0 = u.pn * 256 + wc * 32 + 4 * fq;
#pragma unroll
        for (int ai = 0; ai < 2; ++ai)
#pragma unroll
            for (int m = 0; m < 4; ++m) { const size_t off = (size_t)(row0 + ai * 128 + m * 16) * 1024 + col0;
#pragma unroll
                for (int bj = 0; bj < 2; ++bj)
#pragma unroll
                    for (int n = 0; n < 2; ++n) { const f32x4 b = *(const f32x4*)(xin + off + bj * 128 + n * 16); *(f32x4*)(xout + off + bj * 128 + n * 16) = b + acc[ai][bj][m][n]; }
                asm volatile("" ::: "memory"); }
    }
};
struct EpiRouter {
    static constexpr bool PERM = false;
    float* LOG;
    __device__ __forceinline__ void operator()(const f32x4 (&acc)[2][2][4][2], const pg8::Unit& u, int wr, int wc, int fr, int fq) const {
        asm volatile("" : "+v"(fr), "+v"(fq));
        if (wc >= 2) return;
        const int row0 = u.pm * 256 + wr * 64 + fr, col0 = wc * 32 + 4 * fq;
#pragma unroll
        for (int ai = 0; ai < 2; ++ai)
#pragma unroll
            for (int m = 0; m < 4; ++m)
#pragma unroll
                for (int n = 0; n < 2; ++n) *(f32x4*)(LOG + (size_t)(row0 + ai * 128 + m * 16) * 64 + col0 + n * 16) = acc[ai][0][m][n];
    }
};
struct EpiGateUp {
    static constexpr bool PERM = true;
    bf16_t* HID;
    __device__ __forceinline__ void operator()(const f32x4 (&acc)[2][2][4][2], const pg8::Unit& u, int wr, int wc, int fr, int fq) const {
        asm volatile("" : "+v"(fr), "+v"(fq));
        const int row0 = u.pm * 256 + wr * 64 + fr, col0 = u.pn * 128 + wc * 16 + 4 * fq;
#pragma unroll
        for (int ai = 0; ai < 2; ++ai)
#pragma unroll
            for (int m = 0; m < 4; ++m) { bf16_t* rowp = HID + (size_t)(row0 + ai * 128 + m * 16) * 512 + col0;
#pragma unroll
                for (int bj = 0; bj < 2; ++bj) { const f32x4 g = acc[ai][bj][m][0], up = acc[ai][bj][m][1]; float h[4];
#pragma unroll
                    for (int j = 0; j < 4; ++j) h[j] = g[j] * fast_sigmoid(g[j]) * up[j];
                    u32x2 w; w.x = cvtpk(h[0], h[1]); w.y = cvtpk(h[2], h[3]); *(u32x2*)(rowp + bj * 64) = w; } }
    }
};
struct EpiDown {
    static constexpr bool PERM = true;
    bf16_t* CT; const float* wslot;
    __device__ __forceinline__ void operator()(const f32x4 (&acc)[2][2][4][2], const pg8::Unit& u, int wr, int wc, int fr, int fq) const {
        asm volatile("" : "+v"(fr), "+v"(fq));
        const int row0 = u.pm * 256 + wr * 64 + fr, col0 = u.pn * 256 + wc * 32 + 8 * fq;
#pragma unroll
        for (int ai = 0; ai < 2; ++ai)
#pragma unroll
            for (int m = 0; m < 4; ++m) { const int row = row0 + ai * 128 + m * 16; const float ws = wslot[row]; bf16_t* rowp = CT + (size_t)row * 1024 + col0;
#pragma unroll
                for (int bj = 0; bj < 2; ++bj) { const f32x4 v0 = acc[ai][bj][m][0] * ws, v1 = acc[ai][bj][m][1] * ws;
                    u32x4 w; w.x = cvtpk(v0[0], v0[1]); w.y = cvtpk(v0[2], v0[3]); w.z = cvtpk(v1[0], v1[1]); w.w = cvtpk(v1[2], v1[3]);
                    *(u32x4*)(rowp + bj * 128) = w; } }
    }
};
struct MoeOrder {
    const char* A; const char* Bt; const int* tiletab; size_t a_tile_bytes, b_exp_bytes, b_tile_bytes; int G, c;
    __device__ bool next(int i, pg8::Unit& u) const {
        const int L = i * G + c; const int ntile = tiletab[0]; if (L >= ntile * 4) return false;
        const int rt = L >> 2, pn = L & 3, e = tiletab[1 + rt];
        u.pm = rt; u.pn = pn; u.z = e; u.a = A + (size_t)rt * a_tile_bytes; u.b = Bt + (size_t)e * b_exp_bytes + (size_t)pn * b_tile_bytes; return true;
    }
};
struct SrcCol { const float* p; int ld; };
template <class SrcFn>
__device__ __forceinline__ void cvt_item(const SrcFn& src, bf16_t* dst, int K, int k0, int n0, LAS float* scr, int lane) {
    const SrcCol sc = src(n0 + (lane & 31));
#pragma unroll 8
    for (int i = 0; i < 32; ++i) { const int kk = 2 * i + (lane >> 5); scr[kk * 33 + (lane & 31)] = sc.p ? sc.p[(size_t)(k0 + kk) * sc.ld] : 0.f; }
    LDS_WAIT(); asm volatile("" ::: "memory");
    const int c = lane & 7;
#pragma unroll
    for (int j = 0; j < 4; ++j) { const int n = (lane >> 3) + 8 * j; const LAS float* s = scr + (8 * c) * 33 + n;
        u32x4 o; o.x = cvtpk(s[0 * 33], s[1 * 33]); o.y = cvtpk(s[2 * 33], s[3 * 33]); o.z = cvtpk(s[4 * 33], s[5 * 33]); o.w = cvtpk(s[6 * 33], s[7 * 33]);
        *(u32x4*)(dst + (size_t)(n0 + n) * K + k0 + 8 * c) = o; }
    LDS_WAIT(); asm volatile("" ::: "memory");
}
struct SrcWin { const float* w; __device__ SrcCol operator()(int n) const { const int c = colmap_proj(n); return SrcCol{c >= 0 ? w + c : nullptr, D_IN}; } };
struct SrcPlain { const float* w; int ld; __device__ SrcCol operator()(int n) const { return SrcCol{w + n, ld}; } };
struct SrcRouter { const float* wg; const float* we; __device__ SrcCol operator()(int n) const { if (n < 4) return SrcCol{wg + n, 4}; if (n < 36) return SrcCol{we + (n - 4), 32}; return SrcCol{nullptr, 1}; } };
struct SrcGateUp { const float* g; const float* u; __device__ SrcCol operator()(int n) const { const int a = n >> 3, b = n & 7; return b < 4 ? SrcCol{g + 4 * a + b, DFF} : SrcCol{u + 4 * a + (b - 4), DFF}; } };

__device__ __forceinline__ void sincos_f32(float xf, float& s, float& c) {
    const double x = (double)xf;
    const double kd = __builtin_rint(x * 0.63661977236758134308);
    double r = __builtin_fma(-kd, 1.57079632679489655800e+00, x); r = __builtin_fma(-kd, 6.12323399573676603587e-17, r);
    const double r2 = r * r;
    double sp = -2.5052108385441718775e-08; sp = sp * r2 + 2.7557319223985890653e-06; sp = sp * r2 - 1.9841269841269841270e-04; sp = sp * r2 + 8.3333333333333332177e-03; sp = sp * r2 - 1.6666666666666665741e-01;
    const double sr = r + r * r2 * sp;
    double cp = 2.0876756987868098979e-09; cp = cp * r2 - 2.7557319223985888e-07; cp = cp * r2 + 2.4801587301587301566e-05; cp = cp * r2 - 1.3888888888888889419e-03; cp = cp * r2 + 4.1666666666666664354e-02; cp = cp * r2 - 0.5;
    const double cr = 1.0 + r2 * cp;
    const int q = ((int)kd) & 3;
    const double ss = (q & 1) ? cr : sr, cc = (q & 1) ? sr : cr;
    s = (float)((q & 2) ? -ss : ss); c = (float)(((q + 1) & 2) ? -cc : cc);
}

__device__ __forceinline__ void rms_row(const float* xrow, const bf16_t* c0, const bf16_t* c1, const float* g, float* xsum_out, bf16_t* hb_out, float* f_out, int lane) {
    const f32x4* xr = (const f32x4*)xrow + lane;
    f32x4 v[4]; float s = 0.f;
#pragma unroll
    for (int j = 0; j < 4; ++j) v[j] = xr[64 * j];
    if (c0) {
#pragma unroll
        for (int j = 0; j < 4; ++j) { const u32x2 a = *((const u32x2*)c0 + lane + 64 * j), b = *((const u32x2*)c1 + lane + 64 * j);
            v[j][0] += bf_lo(a.x) + bf_lo(b.x); v[j][1] += bf_hi(a.x) + bf_hi(b.x); v[j][2] += bf_lo(a.y) + bf_lo(b.y); v[j][3] += bf_hi(a.y) + bf_hi(b.y); } }
#pragma unroll
    for (int j = 0; j < 4; ++j) s += (v[j][0] * v[j][0] + v[j][1] * v[j][1]) + (v[j][2] * v[j][2] + v[j][3] * v[j][3]);
    const float rstd = 1.0f / sqrtf(wave_sum(s) * (1.0f / DM) + EPS);
    if (xsum_out) {
#pragma unroll
        for (int j = 0; j < 4; ++j) *((f32x4*)xsum_out + lane + 64 * j) = v[j]; }
#pragma unroll
    for (int j = 0; j < 4; ++j) { const f32x4 gg = *((const f32x4*)g + lane + 64 * j); const f32x4 o = v[j] * rstd * gg;
        if (hb_out) { u32x2 w; w.x = cvtpk(o[0], o[1]); w.y = cvtpk(o[2], o[3]); *((u32x2*)hb_out + lane + 64 * j) = w; }
        if (f_out) *((f32x4*)f_out + lane + 64 * j) = o; }
}

constexpr int VN_PITCH = 1040;
#define TRRD(dst, addr, off) asm volatile("ds_read_b64_tr_b16 %0, %1 offset:%2" : "=&v"(dst) : "v"(addr), "i"(off) : "memory")
__device__ __forceinline__ void gmlp_conv_item(LAS unsigned char* lds, int item, bf16_t* UA, const bf16_t* VA, bf16_t* CB, const bf16_t* CC, const bf16_t* CX,
                                               const float* ws  , const float* bs  , const float* cw  , int wid, int lane) {
    const int t0 = item * 128;
#pragma unroll 4
    for (int pp = 0; pp < 16; ++pp) { const int p = wid * 16 + pp;
        const u32x4 raw = *((const u32x4*)(VA + (size_t)(t0 + p) * 512) + lane);
        float x[8] = {bf_lo(raw.x), bf_hi(raw.x), bf_lo(raw.y), bf_hi(raw.y), bf_lo(raw.z), bf_hi(raw.z), bf_lo(raw.w), bf_hi(raw.w)};
        float s = 0.f;
#pragma unroll
        for (int j = 0; j < 8; ++j) s += x[j];
        const float mean = wave_sum(s) * (1.0f / 512.0f); float q = 0.f;
#pragma unroll
        for (int j = 0; j < 8; ++j) { x[j] -= mean; q += x[j] * x[j]; }
        const float rstd = 1.0f / sqrtf(wave_sum(q) * (1.0f / 512.0f) + EPS);
        u32x4 o; o.x = cvtpk(x[0] * rstd, x[1] * rstd); o.y = cvtpk(x[2] * rstd, x[3] * rstd); o.z = cvtpk(x[4] * rstd, x[5] * rstd); o.w = cvtpk(x[6] * rstd, x[7] * rstd);
        *(LAS u32x4*)(lds + p * VN_PITCH + lane * 16) = o; }
    LDS_WAIT(); __syncthreads();
    {
        const int g = wid >> 1, i16 = lane & 15, g4 = lane >> 4;
        const float* Wg = ws + (size_t)g * 128 * 128;
        const unsigned trbase = (unsigned)(uintptr_t)lds + (unsigned)((8 * g4 + ((lane >> 2) & 3)) * VN_PITCH + (64 * wid + 4 * (lane & 3)) * 2);
#pragma unroll
        for (int th = 0; th < 2; ++th) {
            f32x4 acc[4][4];
#pragma unroll
            for (int ct = 0; ct < 4; ++ct)
#pragma unroll
                for (int tt = 0; tt < 4; ++tt) acc[ct][tt] = (f32x4){0.f, 0.f, 0.f, 0.f};
#pragma unroll
            for (int ks = 0; ks < 4; ++ks) {
                if (32 * ks > 16 * (4 * th + 3) + 15) continue;
                bf16x8 vf[4];
                const unsigned trk = trbase + (unsigned)(ks * 32 * VN_PITCH);
#pragma unroll
                for (int ct = 0; ct < 4; ++ct) { s16x4 lo, hi;
                    TRRD(lo, trk, ct * 32); TRRD(hi, trk, 4 * VN_PITCH + ct * 32);
                    asm volatile("s_waitcnt lgkmcnt(0)" ::: "memory");
                    vf[ct] = (bf16x8){lo[0], lo[1], lo[2], lo[3], hi[0], hi[1], hi[2], hi[3]}; }
                SBAR();
#pragma unroll
                for (int t4 = 0; t4 < 4; ++t4) { const int tt = 4 * th + t4;
                    if (32 * ks > 16 * tt + 15) continue;
                    const int tl = 16 * tt + i16, s0 = 32 * ks + 8 * g4;
                    const f32x4 w0 = *(const f32x4*)(Wg + (size_t)tl * 128 + s0), w1 = *(const f32x4*)(Wg + (size_t)tl * 128 + s0 + 4);
                    float wv[8] = {w0[0], w0[1], w0[2], w0[3], w1[0], w1[1], w1[2], w1[3]};
#pragma unroll
                    for (int j = 0; j < 8; ++j) wv[j] = (s0 + j <= tl) ? wv[j] : 0.f;
                    u32x4 wp; wp.x = cvtpk(wv[0], wv[1]); wp.y = cvtpk(wv[2], wv[3]); wp.z = cvtpk(wv[4], wv[5]); wp.w = cvtpk(wv[6], wv[7]);
                    const bf16x8 wf = *reinterpret_cast<const bf16x8*>(&wp);
#pragma unroll
                    for (int ct = 0; ct < 4; ++ct) acc[ct][t4] = __builtin_amdgcn_mfma_f32_16x16x32_bf16(vf[ct], wf, acc[ct][t4], 0, 0, 0);
                }
            }
#pragma unroll
            for (int t4 = 0; t4 < 4; ++t4) { const int tl = 16 * (4 * th + t4) + i16; const float b = bs[g * 128 + tl];
#pragma unroll
                for (int ct = 0; ct < 4; ++ct) { bf16_t* up = UA + (size_t)(t0 + tl) * 512 + 64 * wid + 16 * ct + 4 * g4;
                    const u32x2 uu = *(const u32x2*)up; const f32x4 a = acc[ct][t4];
                    u32x2 o; o.x = cvtpk(bf_lo(uu.x) * (a[0] + b), bf_hi(uu.x) * (a[1] + b)); o.y = cvtpk(bf_lo(uu.y) * (a[2] + b), bf_hi(uu.y) * (a[3] + b));
                    *(u32x2*)up = o; } }
        }
    }
    {
        const int c8 = lane * 8;
        float w0[8], w1[8], w2[8], z1[8], z2[8];
#pragma unroll
        for (int j = 0; j < 8; ++j) { w0[j] = cw[c8 + j]; w1[j] = cw[512 + c8 + j]; w2[j] = cw[1024 + c8 + j]; z1[j] = 0.f; z2[j] = 0.f; }
        const int r0 = t0 + wid * 16, sq0 = r0 & (SEQ - 1);
#pragma unroll
        for (int back = 2; back >= 1; --back) {
            if (sq0 - back >= 0) { const u32x4 a = *((const u32x4*)(CC + (size_t)(r0 - back) * 512) + lane), b = *((const u32x4*)(CX + (size_t)(r0 - back) * 512) + lane);
                float z[8] = {bf_lo(a.x) * bf_lo(b.x), bf_hi(a.x) * bf_hi(b.x), bf_lo(a.y) * bf_lo(b.y), bf_hi(a.y) * bf_hi(b.y), bf_lo(a.z) * bf_lo(b.z), bf_hi(a.z) * bf_hi(b.z), bf_lo(a.w) * bf_lo(b.w), bf_hi(a.w) * bf_hi(b.w)};
#pragma unroll
                for (int j = 0; j < 8; ++j) { if (back == 2) z2[j] = z[j]; else z1[j] = z[j]; } } }
#pragma unroll 4
        for (int rr = 0; rr < 16; ++rr) { const size_t ro = (size_t)(r0 + rr) * 512;
            const u32x4 a = *((const u32x4*)(CC + ro) + lane), b = *((const u32x4*)(CX + ro) + lane), cbv = *((const u32x4*)(CB + ro) + lane);
            float z[8] = {bf_lo(a.x) * bf_lo(b.x), bf_hi(a.x) * bf_hi(b.x), bf_lo(a.y) * bf_lo(b.y), bf_hi(a.y) * bf_hi(b.y), bf_lo(a.z) * bf_lo(b.z), bf_hi(a.z) * bf_hi(b.z), bf_lo(a.w) * bf_lo(b.w), bf_hi(a.w) * bf_hi(b.w)};
            const float cbf[8] = {bf_lo(cbv.x), bf_hi(cbv.x), bf_lo(cbv.y), bf_hi(cbv.y), bf_lo(cbv.z), bf_hi(cbv.z), bf_lo(cbv.w), bf_hi(cbv.w)};
            float y[8];
#pragma unroll
            for (int j = 0; j < 8; ++j) { y[j] = cbf[j] * (w0[j] * z2[j] + w1[j] * z1[j] + w2[j] * z[j]); z2[j] = z1[j]; z1[j] = z[j]; }
            u32x4 o; o.x = cvtpk(y[0], y[1]); o.y = cvtpk(y[2], y[3]); o.z = cvtpk(y[4], y[5]); o.w = cvtpk(y[6], y[7]);
            *((u32x4*)(CB + ro) + lane) = o; }
    }
    __syncthreads();
}
typedef unsigned short u16x2 __attribute__((ext_vector_type(2)));
__device__ __forceinline__ unsigned key15(float sc) { float f = (sc + 8.0f) * 1024.0f + 0.5f; f = fminf(fmaxf(f, 1.0f), 32767.0f); return (unsigned)f; }
__device__ __forceinline__ unsigned wave_sum_u(unsigned v) {
#pragma unroll
    for (int o = 1; o < 64; o <<= 1) v += (unsigned)__shfl_xor((int)v, o);
    return v;
}
__device__ __forceinline__ unsigned long long lowest_k_bits(unsigned long long e, unsigned k) {
    unsigned long long r = 0ull;
    for (unsigned i = 0; i < k; ++i) { const unsigned long long bb = e & (0ull - e); r |= bb; e ^= bb; }
    return r;
}

__device__ __forceinline__ void select_row(const unsigned char* rowp, int ntile128, int t_seq, unsigned long long* mrow, int ntile_out, int lane, LAS unsigned long long* wl  ) {
    const int n = t_seq + 1;
    if (n <= 256) {
        const int T = lane;
        if (T < ntile_out) { const int lo = 64 * T; unsigned long long w;
            if (lo + 63 <= t_seq) w = ~0ull; else if (lo > t_seq) w = 0ull; else w = (1ull << (t_seq - lo + 1)) - 1ull;
            mrow[(size_t)T * 256] = w; }
        for (int T2 = 64 + lane; T2 < ntile_out; T2 += 64) mrow[(size_t)T2 * 256] = 0ull;
        return;
    }
    unsigned kq[4][32];
    const unsigned* rp = (const unsigned*)rowp + lane;
    const int nq = (ntile128 + 31) >> 5;
#pragma unroll
    for (int q = 0; q < 4; ++q) {
        if (q < nq) {
            const unsigned* rq = rp + 64 * (32 * q + 16); asm volatile("" : "+v"(rq));
#pragma unroll
            for (int m = 0; m < 32; ++m) kq[q][m] = rq[64 * (m - 16)];
        } else {
#pragma unroll
            for (int m = 0; m < 32; ++m) kq[q][m] = 0u;
        }
    }
#define COUNT_GE(cand, out) do { const unsigned Kc_ = (0x8000u - (cand)) * 0x10001u; const u16x2 Kv_ = __builtin_bit_cast(u16x2, Kc_); u16x2 a_ = (u16x2){0, 0}; \
        _Pragma("unroll") for (int q = 0; q < 4; ++q) { if (q < nq) { _Pragma("unroll") for (int m = 0; m < 32; ++m) { u16x2 t_ = __builtin_bit_cast(u16x2, kq[q][m]) + Kv_; t_ = t_ >> 15; a_ += t_; } } } \
        out = wave_sum_u((unsigned)a_.x + (unsigned)a_.y); } while (0)
    unsigned prefix = 0u;
    for (int bit = 14; bit >= 0; --bit) { const unsigned cand = prefix | (1u << bit); unsigned c; COUNT_GE(cand, c); if (c >= 256u) prefix = cand; }
    const unsigned tau = prefix;
    unsigned c_ge, c_gt; COUNT_GE(tau, c_ge); COUNT_GE(tau + 1u, c_gt);
#undef COUNT_GE
    unsigned rem = 256u - c_gt;
#pragma unroll
    for (int q = 0; q < 4; ++q) {
        if (q < nq) {
#pragma unroll
            for (int m = 0; m < 32; ++m) {
#pragma unroll
                for (int h = 0; h < 2; ++h) { const unsigned kv = h ? (kq[q][m] >> 16) : (kq[q][m] & 0xffffu);
                    const unsigned long long gt = __ballot(kv > tau); unsigned long long e = __ballot(kv == tau);
                    const unsigned pe = (unsigned)__popcll(e);
                    if (pe <= rem) rem -= pe; else { e = lowest_k_bits(e, rem); rem = 0u; }
                    const unsigned long long w = gt | e;
                    wl[64 * q + 2 * m + h] = w; SBAR(); }
            }
        } else {
            wl[64 * q + lane] = 0ull;
        }
    }
    LDS_WAIT();
#pragma unroll
    for (int g = 0; g < 4; ++g) { const int T = 64 * g + lane; if (T < ntile_out) mrow[(size_t)T * 256] = wl[T]; }
    LDS_WAIT();
}

__device__ __forceinline__ void indexer_item(LAS unsigned char* lds, unsigned char* scr, int b, int qt, const bf16_t* QI, const bf16_t* KI, const float* WI, unsigned long long* MASK, int wid, int lane) {
    asm volatile("" : "+v"(lane));
    const int s0 = qt * 16, t0 = b * SEQ + s0, i16 = lane & 15, g4 = lane >> 4;
    const int nk128 = (s0 + 16 + 127) & ~127, nsteps = nk128 >> 7;
    {
        bf16x8 bq[4][2];
#pragma unroll
        for (int hh = 0; hh < 4; ++hh)
#pragma unroll
            for (int kk = 0; kk < 2; ++kk) bq[hh][kk] = *(const bf16x8*)(QI + (size_t)(t0 + i16) * 256 + hh * 64 + kk * 32 + 8 * g4);
        const f32x4 w = *(const f32x4*)(WI + (size_t)(t0 + i16) * 4);
        const int qpos = s0 + i16;
        const int nsteps_pad = (nsteps + 31) & ~31;
        for (int st = wid; st < nsteps_pad; st += 8) {
            if (st >= nsteps) {
#pragma unroll
                for (int jp = 0; jp < 4; ++jp) *(u32x4*)(scr + (size_t)i16 * 32768 + (size_t)(64 * st + 16 * jp + 4 * g4) * 4) = (u32x4){0u, 0u, 0u, 0u};
                continue; }
#pragma unroll
            for (int jp = 0; jp < 4; ++jp) {
                unsigned kk2[2][4];
#pragma unroll
                for (int par = 0; par < 2; ++par) { const int keybase = 128 * st + 64 * par + 16 * jp;
                    const bf16_t* kp = KI + (size_t)(b * SEQ + keybase + i16) * 64 + 8 * g4;
                    const bf16x8 a0 = *(const bf16x8*)kp, a1 = *(const bf16x8*)(kp + 32);
                    float sc[4] = {0.f, 0.f, 0.f, 0.f};
#pragma unroll
                    for (int hh = 0; hh < 4; ++hh) { f32x4 d = {0.f, 0.f, 0.f, 0.f};
                        d = __builtin_amdgcn_mfma_f32_16x16x32_bf16(a0, bq[hh][0], d, 0, 0, 0); d = __builtin_amdgcn_mfma_f32_16x16x32_bf16(a1, bq[hh][1], d, 0, 0, 0);
#pragma unroll
                        for (int r = 0; r < 4; ++r) sc[r] += fmaxf(d[r], 0.f) * w[hh]; }
#pragma unroll
                    for (int r = 0; r < 4; ++r) { const int kidx = keybase + 4 * g4 + r; kk2[par][r] = (kidx <= qpos) ? key15(sc[r]) : 0u; } }
                u32x4 o; o.x = kk2[0][0] | (kk2[1][0] << 16); o.y = kk2[0][1] | (kk2[1][1] << 16); o.z = kk2[0][2] | (kk2[1][2] << 16); o.w = kk2[0][3] | (kk2[1][3] << 16);
                *(u32x4*)(scr + (size_t)i16 * 32768 + (size_t)(64 * st + 16 * jp + 4 * g4) * 4) = o;
            }
        }
    }
    VM_WAIT(); __syncthreads();
    __builtin_amdgcn_fence(__ATOMIC_ACQUIRE, "agent");
    VM_WAIT();
    const int qblk = s0 >> 8, ntile_out = ((s0 & ~255) + 256) >> 6;
#pragma unroll 1
    for (int rr = 0; rr < 2; ++rr) { const int i = wid * 2 + rr, tq = s0 + i;
        unsigned long long* mrow = MASK + ((size_t)(b * 64 + qblk) * 256 * 256 + (size_t)(tq & 255));
        select_row(scr + (size_t)i * 32768, nk128 >> 7, tq, mrow, ntile_out, lane, (LAS unsigned long long*)(lds + wid * 2048)); }
    VM_WAIT(); __syncthreads();
}
constexpr int IX_CAP = 1024, IX_A = 5, IX_B = 59;
constexpr int IXL_SK = 0, IXL_MI = 65536, IXL_ROW = 98304;
__device__ __forceinline__ float key15f(float sc) { return __builtin_amdgcn_fmed3f(fmaf(sc, 1024.0f, 8192.5f), 1.0f, 32767.0f); }

template <int NR>
__device__ __forceinline__ unsigned kth_largest15(const unsigned (&kr)[NR], unsigned rank) {
    unsigned prefix = 0u;
    for (int bit = 14; bit >= 0; --bit) { const unsigned cand = prefix | (1u << bit);
        const unsigned Kc = (0x8000u - cand) * 0x10001u; const u16x2 Kv = __builtin_bit_cast(u16x2, Kc); u16x2 a = (u16x2){0, 0};
#pragma unroll
        for (int r = 0; r < NR; ++r) { u16x2 t = __builtin_bit_cast(u16x2, kr[r]) + Kv; t = t >> 15; a += t; }
        const unsigned c = wave_sum_u((unsigned)a.x + (unsigned)a.y);
        if (c >= rank) prefix = cand; }
    return prefix;
}

__device__ __forceinline__ bool indexer_item_fast(LAS unsigned char* lds, int b, int qt, const bf16_t* QI, const bf16_t* KI, const float* WI, unsigned long long* MASK, int wid, int lane_, int tid) {
    asm volatile("" : "+v"(tid));
    const int lane = tid & 63; (void)lane_;
    const int s0 = qt * 16, t0 = b * SEQ + s0, i16 = lane & 15, g4 = lane >> 4;
    const int nk128 = (s0 + 16 + 127) & ~127, nsteps = nk128 >> 7;
    LAS unsigned short* SK = (LAS unsigned short*)(lds + IXL_SK); LAS unsigned* CL = (LAS unsigned*)(lds + IXL_SK);
    LAS unsigned* MI = (LAS unsigned*)(lds + IXL_MI);
    LAS float* U1F = (LAS float*)(lds + IXL_ROW); LAS float* LF = U1F + 16; LAS unsigned* NCAND = (LAS unsigned*)(LF + 16); LAS unsigned* CABOVE = NCAND + 16; LAS unsigned* FAIL = CABOVE + 16;
#pragma unroll
    for (int k = 0; k < 4; ++k) *(LAS u32x4*)(lds + IXL_MI + (tid + 512 * k) * 16) = (u32x4){0u, 0u, 0u, 0u};
    if (tid < 80) ((LAS unsigned*)(lds + IXL_ROW))[tid] = 0u;
    bf16x8 bq[4][2];
#pragma unroll
    for (int hh = 0; hh < 4; ++hh)
#pragma unroll
        for (int kk = 0; kk < 2; ++kk) bq[hh][kk] = *(const bf16x8*)(QI + (size_t)(t0 + i16) * 256 + hh * 64 + kk * 32 + 8 * g4);
    const f32x4 w = *(const f32x4*)(WI + (size_t)(t0 + i16) * 4);
    const int qpos = s0 + i16;
    const int m = nk128 >> 3;
    for (int tau = wid; tau < (m >> 4); tau += 8) {
        const bf16_t* kp = KI + (size_t)(b * SEQ + 8 * (16 * tau + i16)) * 64 + 8 * g4;
        const bf16x8 a0 = *(const bf16x8*)kp, a1 = *(const bf16x8*)(kp + 32);
        float sc[4] = {0.f, 0.f, 0.f, 0.f};
#pragma unroll
        for (int hh = 0; hh < 4; ++hh) { f32x4 d = {0.f, 0.f, 0.f, 0.f};
            d = __builtin_amdgcn_mfma_f32_16x16x32_bf16(a0, bq[hh][0], d, 0, 0, 0); d = __builtin_amdgcn_mfma_f32_16x16x32_bf16(a1, bq[hh][1], d, 0, 0, 0);
#pragma unroll
            for (int r = 0; r < 4; ++r) sc[r] += fmaxf(d[r], 0.f) * w[hh]; }
        unsigned k4[4];
#pragma unroll
        for (int r = 0; r < 4; ++r) { const int ks = 8 * (16 * tau + 4 * g4 + r); k4[r] = (ks <= qpos) ? (unsigned)key15f(sc[r]) : 0u; }
        u32x2 o; o.x = k4[0] | (k4[1] << 16); o.y = k4[2] | (k4[3] << 16);
        *(LAS u32x2*)(lds + IXL_SK + ((size_t)i16 * 2048 + 16 * tau + 4 * g4) * 2) = o;
    }
    LDS_WAIT(); __syncthreads();
#pragma unroll 1
    for (int rr = 0; rr < 2; ++rr) { const int row = wid * 2 + rr;
        unsigned kr[16]; const LAS unsigned* sp = (const LAS unsigned*)(lds + IXL_SK + (size_t)row * 4096) + lane; const int nd = m >> 1;
#pragma unroll
        for (int r = 0; r < 16; ++r) { const unsigned v = sp[64 * r]; kr[r] = (64 * r + lane < nd) ? v : 0u; }
        const unsigned U = kth_largest15<16>(kr, (unsigned)IX_A), L = kth_largest15<16>(kr, (unsigned)IX_B);
        if (lane == 0) { U1F[row] = (float)(U + 1u); LF[row] = (float)(L > 0u ? L : 1u); } }
    LDS_WAIT(); __syncthreads();
    {
        const float u1 = U1F[i16], lf = LF[i16];
        unsigned nabove = 0u;
        for (int st = wid; st < nsteps; st += 8) {
            const bool diag = (128 * st + 127 > s0);
            float fv[32]; unsigned bdef = 0u, bge = 0u;
#pragma unroll
            for (int j = 0; j < 8; ++j) {
                if (j == 4) SBAR();
                const bf16_t* kp = KI + (size_t)(b * SEQ + 128 * st + 32 * (i16 >> 2) + 4 * j + (i16 & 3)) * 64 + 8 * g4;
                const bf16x8 a0 = *(const bf16x8*)kp, a1 = *(const bf16x8*)(kp + 32);
                float sc[4] = {0.f, 0.f, 0.f, 0.f};
#pragma unroll
                for (int hh = 0; hh < 4; ++hh) { f32x4 d = {0.f, 0.f, 0.f, 0.f};
                    d = __builtin_amdgcn_mfma_f32_16x16x32_bf16(a0, bq[hh][0], d, 0, 0, 0); d = __builtin_amdgcn_mfma_f32_16x16x32_bf16(a1, bq[hh][1], d, 0, 0, 0);
#pragma unroll
                    for (int r = 0; r < 4; ++r) sc[r] += fmaxf(d[r], 0.f) * w[hh]; }
#pragma unroll
                for (int r = 0; r < 4; ++r) { float f = key15f(sc[r]);
                    if (diag) f = (128 * st + 32 * g4 + 4 * j + r <= qpos) ? f : 0.f;
                    fv[4 * j + r] = f; bdef |= (f >= u1 ? 1u : 0u) << (4 * j + r); bge |= (f >= lf ? 1u : 0u) << (4 * j + r); }
            }
            MI[i16 * 512 + 4 * st + g4] = bdef;
            nabove += (unsigned)__popc(bdef);
            const unsigned cm = bge & ~bdef;
            if (cm) { const unsigned nc = (unsigned)__popc(cm);
                unsigned pos = __hip_atomic_fetch_add(&NCAND[i16], nc, __ATOMIC_RELAXED, __HIP_MEMORY_SCOPE_WORKGROUP);
                const unsigned idx0 = (unsigned)(128 * st + 32 * g4);
#pragma unroll
                for (int p = 0; p < 32; ++p) { if ((cm >> p) & 1u) { if (pos < (unsigned)IX_CAP) CL[i16 * IX_CAP + pos] = ((unsigned)fv[p] << 14) | (16383u - (idx0 + p)); ++pos; } } }
        }
        if (nabove) __hip_atomic_fetch_add(&CABOVE[i16], nabove, __ATOMIC_RELAXED, __HIP_MEMORY_SCOPE_WORKGROUP);
    }
    LDS_WAIT(); __syncthreads();
#pragma unroll 1
    for (int rr = 0; rr < 2; ++rr) { const int row = wid * 2 + rr;
        const unsigned nc = NCAND[row], ca = CABOVE[row];
        const bool ok = (nc <= (unsigned)IX_CAP) && (ca <= 256u) && (ca + nc >= 256u);
        if (!ok) { if (lane == 0) FAIL[0] = 1u; continue; }
        const unsigned need = 256u - ca;
        if (need == 0u) continue;
        unsigned cr[16]; const LAS unsigned* cp = CL + row * IX_CAP + lane;
#pragma unroll
        for (int r = 0; r < 16; ++r) { const unsigned v = cp[64 * r]; cr[r] = (64 * r + lane < (int)nc) ? v : 0u; }
        unsigned prefix = 0u;
        for (int bit = 28; bit >= 0; --bit) { const unsigned cand = prefix | (1u << bit); unsigned c = 0u;
#pragma unroll
            for (int r = 0; r < 16; ++r) c += (cr[r] >= cand) ? 1u : 0u;
            c = wave_sum_u(c); if (c >= need) prefix = cand; }
#pragma unroll
        for (int r = 0; r < 16; ++r) { if (cr[r] >= prefix && cr[r] != 0u) { const unsigned idx = 16383u - (cr[r] & 16383u);
                __hip_atomic_fetch_or(&MI[row * 512 + (idx >> 5)], 1u << (idx & 31u), __ATOMIC_RELAXED, __HIP_MEMORY_SCOPE_WORKGROUP); } }
    }
    LDS_WAIT(); __syncthreads();
    const bool good = (FAIL[0] == 0u);
    if (good) { const int qblk = s0 >> 8, ntile_out = ((s0 & ~255) + 256) >> 6;
        unsigned long long* mb = MASK + ((size_t)(b * 64 + qblk) * 256 * 256 + (size_t)(s0 & 255));
        for (int idx = tid; idx < 16 * ntile_out; idx += NTHREADS) { const int row = idx & 15, Tt = idx >> 4;
            const u32x2 wv = *(const LAS u32x2*)(MI + row * 512 + 2 * Tt);
            mb[(size_t)Tt * 256 + row] = ((unsigned long long)wv.y << 32) | wv.x; } }
    __syncthreads();
    return good;
}
namespace att {
constexpr int QBLK = 32, KVBLK = 64, QB = 256, HD = 128, LDQ = 512;
constexpr int SHM_V = KVBLK * HD * 2, SHM_K = KVBLK * HD * 2;
constexpr int LDS_NEED = 2 * SHM_V + 2 * SHM_K + NWAVES * 64 * 4;
constexpr float SCALE = 0.08838834764831845f;
constexpr float THR = 8.f;
#define KSWZ(row, colB) ((row) * 256 + ((colB) ^ (((row) & 7) << 4)))
__device__ __forceinline__ int v_st(int k, int c) { const int kk = (k & ~0xC) | ((k & 4) << 1) | ((k & 8) >> 1); return ((kk >> 3) * 4 + (c >> 5)) * 512 + ((kk & 7) * 32 + (c & 31)) * 2; }
__device__ __forceinline__ int v_rd_base(int lane) { return ((lane & 3) << 3) | (((lane >> 2) & 3) << 6) | (((lane >> 4) & 1) << 5) | (((lane >> 5) & 1) << 8); }
constexpr int v_rd_off(int d0, int ks, int half) { return d0 * 512 + ks * 4096 + half * 2048; }
__device__ __forceinline__ int crow(int r, int hi) { return (r & 3) + 8 * (r >> 2) + 4 * hi; }

__device__ __forceinline__ void partialSM(f32x16& p0, f32x16& p1, float& m_reg, float& mn, float& alpha) {
    float pmax = p0[0];
#pragma unroll
    for (int r = 1; r < 16; ++r) pmax = fmaxf(pmax, p0[r]);
#pragma unroll
    for (int r = 0; r < 16; ++r) pmax = fmaxf(pmax, p1[r]);
    { auto rr = __builtin_amdgcn_permlane32_swap(__float_as_uint(pmax), __float_as_uint(pmax), false, false);
      pmax = fmaxf(__uint_as_float(rr[0]), __uint_as_float(rr[1])); }
    constexpr float C2 = 1.4426950408889634f * SCALE;
    if (__builtin_expect(__all((pmax - m_reg) * SCALE <= THR), 1)) { mn = m_reg; alpha = 1.f; }
    else { mn = fmaxf(m_reg, pmax); alpha = __builtin_amdgcn_exp2f((m_reg - mn) * C2); m_reg = mn; }
    const float mnL = -mn * C2;
#pragma unroll
    for (int r = 0; r < 16; ++r) p0[r] = fmaf(p0[r], C2, mnL);
#pragma unroll
    for (int r = 0; r < 16; ++r) p1[r] = fmaf(p1[r], C2, mnL);
#pragma unroll
    for (int r = 0; r < 16; ++r) p0[r] = __builtin_amdgcn_exp2f(p0[r]);
}
__device__ __forceinline__ void finishSM(f32x16& p0, f32x16& p1, float alpha, float& l_reg, bf16x8& pa0, bf16x8& pa1, bf16x8& pa2, bf16x8& pa3) {
#pragma unroll
    for (int r = 0; r < 16; ++r) p1[r] = __builtin_amdgcn_exp2f(p1[r]);
    float ps = 0;
#pragma unroll
    for (int r = 0; r < 16; ++r) ps += p0[r];
#pragma unroll
    for (int r = 0; r < 16; ++r) ps += p1[r];
    { auto rr = __builtin_amdgcn_permlane32_swap(__float_as_uint(ps), __float_as_uint(ps), false, false);
      ps = __uint_as_float(rr[0]) + __uint_as_float(rr[1]); }
    l_reg = l_reg * alpha + ps;
#define PK4(P, B_, OUT) do { unsigned a0 = cvtpk(P[B_+0], P[B_+1]), a1 = cvtpk(P[B_+2], P[B_+3]);                          \
        unsigned b0 = cvtpk(P[B_+4], P[B_+5]), b1 = cvtpk(P[B_+6], P[B_+7]);                                             \
        auto r0 = __builtin_amdgcn_permlane32_swap(a0, b0, false, false); auto r1 = __builtin_amdgcn_permlane32_swap(a1, b1, false, false); \
        u32x4 w = {r0[0], r1[0], r0[1], r1[1]}; OUT = *reinterpret_cast<bf16x8*>(&w); } while (0)
    PK4(p0, 0, pa0); PK4(p0, 8, pa1); PK4(p1, 0, pa2); PK4(p1, 8, pa3);
#undef PK4
}
template <int KB>
__device__ __forceinline__ void qkt(f32x16& p0, f32x16& p1, const LAS char* K_lds, int r32, int hi, const bf16x8* qr) {
    const LAS char* kb[4];
#pragma unroll
    for (int dd = 0; dd < 4; ++dd) kb[dd] = K_lds + KB * SHM_K + KSWZ(r32, (dd * 16 + hi * 8) * 2);
#pragma unroll
    for (int d0 = 0; d0 < 8; ++d0) { const LAS char* a = kb[d0 & 3] + (d0 >> 2) * 128;
        bf16x8 b0 = *reinterpret_cast<const LAS bf16x8*>(a);
        bf16x8 b1 = *reinterpret_cast<const LAS bf16x8*>(a + 32 * 256);
        p0 = __builtin_amdgcn_mfma_f32_32x32x16_bf16(b0, qr[d0], p0, 0, 0, 0);
        p1 = __builtin_amdgcn_mfma_f32_32x32x16_bf16(b1, qr[d0], p1, 0, 0, 0); }
}
template <int VB>
__device__ __forceinline__ void pv_tile(f32x16* o, int vb0, bf16x8 pa0, bf16x8 pa1, bf16x8 pa2, bf16x8 pa3) {
#define TRRD2(dst, off) asm volatile("ds_read_b64_tr_b16 %0, %1 offset:%2" : "=&v"(dst) : "v"(vb0), "i"(off) : "memory")
#define PV_D0(d0) do { s16x4 l0, l1, l2, l3, h0, h1, h2, h3; constexpr int b_ = VB * SHM_V + v_rd_off(d0, 0, 0); \
        TRRD2(l0, b_); TRRD2(h0, b_ + 2048); TRRD2(l1, b_ + 4096); TRRD2(h1, b_ + 6144); TRRD2(l2, b_ + 8192); TRRD2(h2, b_ + 10240); TRRD2(l3, b_ + 12288); TRRD2(h3, b_ + 14336); \
        asm volatile("s_waitcnt lgkmcnt(0)" ::: "memory"); SBAR();   \
        o[d0] = __builtin_amdgcn_mfma_f32_32x32x16_bf16(pa0, (bf16x8){l0[0], l0[1], l0[2], l0[3], h0[0], h0[1], h0[2], h0[3]}, o[d0], 0, 0, 0);   \
        o[d0] = __builtin_amdgcn_mfma_f32_32x32x16_bf16(pa1, (bf16x8){l1[0], l1[1], l1[2], l1[3], h1[0], h1[1], h1[2], h1[3]}, o[d0], 0, 0, 0);   \
        o[d0] = __builtin_amdgcn_mfma_f32_32x32x16_bf16(pa2, (bf16x8){l2[0], l2[1], l2[2], l2[3], h2[0], h2[1], h2[2], h2[3]}, o[d0], 0, 0, 0);   \
        o[d0] = __builtin_amdgcn_mfma_f32_32x32x16_bf16(pa3, (bf16x8){l3[0], l3[1], l3[2], l3[3], h3[0], h3[1], h3[2], h3[3]}, o[d0], 0, 0, 0); } while (0)
    PV_D0(0); PV_D0(1); PV_D0(2); PV_D0(3);
#undef PV_D0
#undef TRRD2
}
__device__ __forceinline__ void mask_init(f32x16& p0, f32x16& p1, unsigned long long mw, int hi) {
    const int lo = ~(int)((unsigned)mw >> (4 * hi)), hw = ~(int)((unsigned)(mw >> 32) >> (4 * hi));
#pragma unroll
    for (int r = 0; r < 16; ++r) { const int c = (r & 3) + 8 * (r >> 2);
        p0[r] = __int_as_float(((lo << (31 - c)) >> 31) & (int)0xFF800000);
        p1[r] = __int_as_float(((hw << (31 - c)) >> 31) & (int)0xFF800000); }
}
__device__ __forceinline__ void attn_block(LAS char* lds, const bf16_t* Qb  , const bf16_t* Kh  , const bf16_t* Vh, bf16_t* Ob, const unsigned long long* mblk  , int P0) {
    int tid_ = threadIdx.x; asm volatile("" : "+v"(tid_));
    const int tid = tid_, wid = __builtin_amdgcn_readfirstlane(tid >> 6), lane = tid & 63, r32 = lane & 31, hi = lane >> 5;
    const int NT = (P0 + QB) / KVBLK;
    LAS char* V_lds = lds; LAS char* K_lds = lds + 2 * SHM_V;
    LAS float* ws = (LAS float*)(lds + 2 * SHM_V + 2 * SHM_K) + wid * 64; LAS float* li_l = ws; LAS float* al_l = ws + 32;
    float m_reg = -1e30f, l_reg = 0; f32x16 o[4] = {};
    const int sr = tid >> 4, sc = (tid & 15) * 8, vst0 = v_st(sr, sc), vst1 = v_st(32 + sr, sc), kws = KSWZ(sr, sc * 2);
    const int vb0 = (int)(uintptr_t)V_lds + v_rd_base(lane);
    bf16x8 qr[8];
#pragma unroll
    for (int d0 = 0; d0 < 8; ++d0) qr[d0] = *(const bf16x8*)(Qb + (size_t)(wid * QBLK + r32) * LDQ + d0 * 16 + hi * 8);
    const unsigned long long* mrow = mblk + (wid * QBLK + r32);
    bf16x8 st_v0, st_v1, st_k0, st_k1;
#define SLOAD(k0) do { st_v0 = *(const bf16x8*)(Vh + (size_t)((k0) + sr) * LDQ + sc); st_v1 = *(const bf16x8*)(Vh + (size_t)((k0) + 32 + sr) * LDQ + sc); \
                       st_k0 = *(const bf16x8*)(Kh + (size_t)((k0) + sr) * LDQ + sc); st_k1 = *(const bf16x8*)(Kh + (size_t)((k0) + 32 + sr) * LDQ + sc); } while (0)
#define SWRITE(bf) do { *(LAS bf16x8*)(V_lds + (bf) * SHM_V + vst0) = st_v0; *(LAS bf16x8*)(V_lds + (bf) * SHM_V + vst1) = st_v1; \
                        *(LAS bf16x8*)(K_lds + (bf) * SHM_K + kws) = st_k0; *(LAS bf16x8*)(K_lds + (bf) * SHM_K + kws + 32 * 256) = st_k1; } while (0)
#define RESC(a) do { if (__any((a) < 1.f)) { if (hi == 0) al_l[r32] = (a); asm volatile("s_waitcnt lgkmcnt(0)" ::: "memory");              \
                     _Pragma("unroll") for (int d_ = 0; d_ < 4; ++d_) _Pragma("unroll") for (int r = 0; r < 16; ++r) o[d_][r] *= al_l[crow(r, hi)]; } } while (0)
#define STEP(BUF, t) do { \
        SWRITE(BUF); LDS_WAIT(); __syncthreads();                                          \
        const unsigned long long mw_ = mnext;                                               \
        if ((t) + 1 < NT) { SLOAD(((t) + 1) * KVBLK); mnext = mrow[(size_t)((t) + 1) * 256]; } \
        f32x16 p0, p1; float mn, alpha; bf16x8 pa0, pa1, pa2, pa3;                          \
        mask_init(p0, p1, mw_, hi);                                                         \
        qkt<BUF>(p0, p1, K_lds, r32, hi, qr);                                               \
        partialSM(p0, p1, m_reg, mn, alpha); RESC(alpha);                                   \
        finishSM(p0, p1, alpha, l_reg, pa0, pa1, pa2, pa3); SBAR();                         \
        pv_tile<BUF>(o, vb0, pa0, pa1, pa2, pa3); } while (0)
    SLOAD(0); unsigned long long mnext = mrow[0];
    for (int t = 0; t < NT; t += 2) {
        VM_WAIT(); STEP(0, t);
        VM_WAIT(); STEP(1, t + 1);
    }
    if (hi == 0) li_l[r32] = l_reg; asm volatile("s_waitcnt lgkmcnt(0)" ::: "memory");
    float rli[16];
#pragma unroll
    for (int r = 0; r < 16; ++r) rli[r] = __builtin_amdgcn_rcpf(li_l[crow(r, hi)]);
    bf16_t* Ow = Ob + (size_t)(wid * QBLK) * LDQ;
#pragma unroll
    for (int r = 0; r < 16; ++r) { const int orow = crow(r, hi);
#pragma unroll
        for (int d0 = 0; d0 < 4; ++d0) { const float v = o[d0][r] * rli[r]; const float vn = __shfl_xor(v, 1);
            if ((r32 & 1) == 0) *(unsigned*)(Ow + (size_t)orow * LDQ + d0 * 32 + r32) = cvtpk(v, vn); } }
    __syncthreads();
#undef SLOAD
#undef SWRITE
#undef RESC
#undef STEP
}
}
#ifdef SELFCHECK
__device__ __forceinline__ float bf2f(bf16_t v) { return __uint_as_float(((unsigned)v) << 16); }
__device__ __forceinline__ void selfcheck_row(LAS unsigned char* lds, int b, int t, const bf16_t* QI, const bf16_t* KI, const float* WI, const unsigned long long* MASK,
                                              const bf16_t* Q, const bf16_t* K, const bf16_t* V, const bf16_t* YBp, unsigned* err, int tid) {
    LAS unsigned short* keys = (LAS unsigned short*)lds;
    LAS float* qv = (LAS float*)(lds + 32768);
    LAS int* sel = (LAS int*)(lds + 32768 + 4096);
    LAS float* lg = (LAS float*)(lds + 32768 + 8192);
    LAS unsigned* cnts = (LAS unsigned*)(lds + 32768 + 16384);
    const int n = t + 1; const size_t row = (size_t)b * SEQ + t;
    if (tid < 256) qv[tid] = bf2f(QI[row * 256 + tid]);
    if (tid < 8) cnts[tid] = 0u;
    __syncthreads();
    const float w0 = WI[row * 4 + 0], w1 = WI[row * 4 + 1], w2 = WI[row * 4 + 2], w3 = WI[row * 4 + 3];
    for (int s = tid; s < SEQ; s += NTHREADS) {
        unsigned k15 = 0u;
        if (s < n) { const bf16_t* kp = KI + ((size_t)b * SEQ + s) * 64; float d[4] = {0.f, 0.f, 0.f, 0.f};
            for (int k = 0; k < 64; ++k) { const float kv = bf2f(kp[k]); d[0] += qv[k] * kv; d[1] += qv[64 + k] * kv; d[2] += qv[128 + k] * kv; d[3] += qv[192 + k] * kv; }
            const float sc = fmaxf(d[0], 0.f) * w0 + fmaxf(d[1], 0.f) * w1 + fmaxf(d[2], 0.f) * w2 + fmaxf(d[3], 0.f) * w3;
            k15 = key15(sc); }
        keys[s] = (unsigned short)k15; }
    __syncthreads();
    const unsigned long long* mrow = MASK + ((size_t)(b * 64 + (t >> 8)) * 256 * 256 + (size_t)(t & 255));
    const int ncheck = ((t & ~255) + 256);
    for (int s = tid; s < ncheck; s += NTHREADS) {
        bool want = false;
        if (s < n) { if (n <= 256) want = true; else { const unsigned k = keys[s]; int rank = 0; for (int s2 = 0; s2 < n; ++s2) { const unsigned k2 = keys[s2]; rank += (k2 > k || (k2 == k && s2 < s)) ? 1 : 0; } want = rank < 256; } }
        const bool got = (mrow[(size_t)(s >> 6) * 256] >> (s & 63)) & 1ull;
        if (want != got) atomicAdd((unsigned*)&cnts[0], 1u);
        if (got) { const unsigned j = atomicAdd((unsigned*)&cnts[1], 1u); if (j < 256u) sel[j] = s; } }
    __syncthreads();
    const int nsel = (int)cnts[1]; const int nexp = n < 256 ? n : 256;
    qv[tid] = bf2f(Q[row * 512 + tid]);
    __syncthreads();
    if (nsel == nexp) {
        if (tid < nsel) { const bf16_t* kp = K + ((size_t)b * SEQ + sel[tid]) * 512;
            for (int h = 0; h < 4; ++h) { float d = 0.f; for (int k = 0; k < 128; ++k) d += qv[h * 128 + k] * bf2f(kp[h * 128 + k]); lg[h * 256 + tid] = d * 0.08838834764831845f; } }
        __syncthreads();
        if (tid < 4) { float mx = -1e30f; for (int j = 0; j < nsel; ++j) mx = fmaxf(mx, lg[tid * 256 + j]); float sm = 0.f; for (int j = 0; j < nsel; ++j) { const float e = expf(lg[tid * 256 + j] - mx); lg[tid * 256 + j] = e; sm += e; }
            const float inv = 1.0f / sm; for (int j = 0; j < nsel; ++j) lg[tid * 256 + j] *= inv; }
        __syncthreads();
        { const int h = tid >> 7; float o = 0.f; for (int j = 0; j < nsel; ++j) o += lg[h * 256 + j] * bf2f(V[((size_t)b * SEQ + sel[j]) * 512 + tid]);
            const float got = bf2f(YBp[row * 512 + tid]); const float dd = o - got;
            atomicAdd((float*)&cnts[2], dd * dd); atomicAdd((float*)&cnts[3], o * o); }
        __syncthreads();
    }
    if (tid == 0) { const float e2 = __uint_as_float(cnts[2]), r2 = __uint_as_float(cnts[3]);
        const bool bad = (cnts[0] > 4u) || (nsel != nexp) || !(e2 <= (SELFCHECK == 2 ? 1e-9f : 0.0009f) * r2 + 1e-12f);
        if (bad) atomicAdd(err, 1u); }
    __syncthreads();
}
#endif
__device__ __forceinline__ void route_a(LAS unsigned char* lds, int blk, const float* LOG, const float* rgb, const float* reb, int* TE, float* TW, unsigned* CNT, const int tid) {
    LAS unsigned* cnt = (LAS unsigned*)lds;
    if (tid < 32) cnt[tid] = 0u;
    __syncthreads();
    if (tid < 128) { const int t = blk * 128 + tid; const float* lg = LOG + (size_t)t * 64;
        float g[4]; int grp = 0;
#pragma unroll
        for (int j = 0; j < 4; ++j) g[j] = lg[j] + rgb[j];
#pragma unroll
        for (int j = 1; j < 4; ++j) if (g[j] > g[grp]) grp = j;
        float den = 0.f;
#pragma unroll
        for (int j = 0; j < 4; ++j) den += expf(g[j] - g[grp]);
        const float gw = 1.0f / den;
        float el[8]; int i0 = 0;
#pragma unroll
        for (int j = 0; j < 8; ++j) el[j] = lg[4 + grp * 8 + j] + reb[grp * 8 + j];
#pragma unroll
        for (int j = 1; j < 8; ++j) if (el[j] > el[i0]) i0 = j;
        int i1 = (i0 == 0) ? 1 : 0;
#pragma unroll
        for (int j = 0; j < 8; ++j) if (j != i0 && j != i1 && el[j] > el[i1]) i1 = j;
        const float e1 = expf(el[i1] - el[i0]); const float w0 = gw / (1.0f + e1), w1 = gw * e1 / (1.0f + e1);
        const int x0 = grp * 8 + i0, x1 = grp * 8 + i1;
        TE[2 * t] = x0; TE[2 * t + 1] = x1; TW[2 * t] = w0; TW[2 * t + 1] = w1;
        __hip_atomic_fetch_add(&cnt[x0], 1u, __ATOMIC_RELAXED, __HIP_MEMORY_SCOPE_WORKGROUP); __hip_atomic_fetch_add(&cnt[x1], 1u, __ATOMIC_RELAXED, __HIP_MEMORY_SCOPE_WORKGROUP); }
    __syncthreads();
    if (tid < 32) CNT[blk * 32 + tid] = cnt[tid];
    __syncthreads();
}
__device__ __forceinline__ void route_b(LAS unsigned char* lds, int blk, const unsigned* CNT, const int* TE, const float* TW, const bf16_t* HB2, bf16_t* XS, float* WSLOT, int* SLOT, int* TILETAB, int wid, int lane, const int tid) {
    LAS unsigned* ptot = (LAS unsigned*)lds;
    LAS unsigned* pbef = ptot + 512;
    LAS unsigned* tot = pbef + 512;
    LAS unsigned* base = tot + 32;
    LAS unsigned* estart = base + 32;
    LAS int* pos = (LAS int*)(estart + 64);
    LAS int* lte = pos + 256;
    { const int e = tid & 31, part = tid >> 5; unsigned s = 0u, bsum = 0u;
        for (int b2 = part * 16; b2 < part * 16 + 16; ++b2) { const unsigned c = CNT[b2 * 32 + e]; s += c; if (b2 < blk) bsum += c; }
        ptot[part * 32 + e] = s; pbef[part * 32 + e] = bsum; }
    if (tid < 256) lte[tid] = TE[blk * 256 + tid];
    __syncthreads();
    if (tid < 32) { unsigned s = 0u, bsum = 0u;
        for (int p = 0; p < 16; ++p) { s += ptot[p * 32 + tid]; bsum += pbef[p * 32 + tid]; }
        tot[tid] = s; base[tid] = bsum; }
    __syncthreads();
    if (tid == 0) { unsigned run = 0u; for (int e = 0; e < 32; ++e) { estart[e] = run; run += (tot[e] + 255u) & ~255u; } estart[32] = run; }
    __syncthreads();
    if (tid < 32) { int k = (int)(estart[tid] + base[tid]);
        for (int a = 0; a < 256; ++a) if (lte[a] == tid) pos[a] = k++; }
    __syncthreads();
    for (int a = wid * 32; a < wid * 32 + 32; ++a) { const int t = blk * 128 + (a >> 1), p = pos[a];
        const u32x4* src = (const u32x4*)(HB2 + (size_t)t * 1024); u32x4* dst = (u32x4*)(XS + (size_t)p * 1024);
        dst[lane] = src[lane]; dst[64 + lane] = src[64 + lane];
        if (lane == 0) { WSLOT[p] = TW[blk * 256 + a]; SLOT[blk * 256 + a] = p; } }
    if (blk < 32) {
        const int r0 = (int)(estart[blk] + tot[blk]), r1 = (int)estart[blk + 1];
        for (int r = r0 + wid; r < r1; r += NWAVES) { u32x4* dst = (u32x4*)(XS + (size_t)r * 1024); dst[lane] = (u32x4){0u, 0u, 0u, 0u}; dst[64 + lane] = (u32x4){0u, 0u, 0u, 0u}; if (lane == 0) WSLOT[r] = 0.f; }
    }
    if (blk == 0) { if (tid == 0) TILETAB[0] = (int)(estart[32] >> 8);
        if (tid < 32) for (unsigned rt = estart[tid] >> 8; rt < (estart[tid + 1] >> 8); ++rt) TILETAB[1 + rt] = tid; }
    __syncthreads();
}

#ifndef PHASE_MASK
#define PHASE_MASK 0x3FFF
#endif
#define PK(i) ((PHASE_MASK >> (i)) & 1)
#ifndef REPEAT_MASK
#define REPEAT_MASK 0
#endif
#define REPS(i) (((REPEAT_MASK >> (i)) & 1) ? 2 : 1)
#ifndef IX_FAST_MIN_QT
#define IX_FAST_MIN_QT 128
#endif
constexpr int NPH_LAYER = 13, NPHASES = 1 + DEPTH * NPH_LAYER;
struct Args {
    const float* in[20]; float* out; unsigned char* ws;
    float invq[16]; float invi[8];
    int ph_lo, ph_hi, li, pad;
};

__global__ void __launch_bounds__(NTHREADS, 2) fwd_kernel(Args args) {
    extern __shared__ __attribute__((aligned(16))) unsigned char lds_raw[];
    LAS unsigned char* lds = (LAS unsigned char*)lds_raw;
    volatile LAS unsigned* MISC = (volatile LAS unsigned*)(lds + MISC_OFF);
    const int tid = threadIdx.x;
    unsigned* ctl = (unsigned*)(args.ws + WS_CTL);
    if (tid < 64) ((LAS unsigned*)(lds + MISC_OFF))[tid] = 0u;
    __syncthreads();
    XcdBarrier bar = xcd_barrier_post(ctl + CW_BAR + args.li * XCD_BAR_WORDS, MISC + 8);
    const int lo = args.ph_lo, hi = args.ph_hi;
#define IN(k) (lo <= (k) && (k) < hi)
#define SEAM(k) do { if (IN(k) && IN((k) + 1)) xcd_barrier(bar); } while (0)
#define CAS __attribute__((address_space(4)))
#define OPQ() const CAS Args* ap = (const CAS Args*)__builtin_amdgcn_kernarg_segment_ptr(); asm volatile("" : "+s"(ap)); unsigned char* const ws = ap->ws; (void)ws; int bid = blockIdx.x, G = gridDim.x; asm volatile("" : "+s"(bid), "+s"(G)); const int NGW = G * NWAVES; (void)NGW; int tid_o = threadIdx.x; asm volatile("" : "+v"(tid_o)); const int lane = tid_o & 63, wid = __builtin_amdgcn_readfirstlane(tid_o >> 6), gw = bid * NWAVES + wid; (void)lane; (void)gw;

#define x_in (ap->in[0])
#define positions ((const int*)ap->in[1])
#define g_mix (ap->in[2])
#define g_ffn (ap->in[3])
#define g_fin (ap->in[4])
#define XA (ap->out)
#define cosq ((float*)(ws + WS_COSQ))
#define sinq ((float*)(ws + WS_SINQ))
#define cosi ((float*)(ws + WS_COSI))
#define sini ((float*)(ws + WS_SINI))
#define WIN ((bf16_t*)(ws + WS_WIN))
#define WP ((bf16_t*)(ws + WS_WP))
#define WO ((bf16_t*)(ws + WS_WO))
#define WR ((bf16_t*)(ws + WS_WR))
#define R (ws + WS_R)
#define HB ((bf16_t*)(R + R_HB))
#define VA ((bf16_t*)(R + R_VA))
#define CC ((bf16_t*)(R + R_CC))
#define CX ((bf16_t*)(R + R_CX))
#define YB ((bf16_t*)(R + R_YB))
#define UA ((bf16_t*)(R + R_UA))
#define Qm ((bf16_t*)(R + R_Q))
#define Km ((bf16_t*)(R + R_K))
#define VB ((bf16_t*)(R + R_VB))
#define CB ((bf16_t*)(R + R_CB))
#define QI ((bf16_t*)(R + R_QI))
#define KI ((bf16_t*)(R + R_KI))
#define WI ((float*)(R + R_WI))
#define G8 (R + R_G8)
#define MASK ((unsigned long long*)(R + R_MASK))
#define MG ((bf16_t*)(R + R_MERGED))
#define WGU ((bf16_t*)(R + R_WGU))
#define WD ((bf16_t*)(R + R_WD))
#define HB2 ((bf16_t*)(R + R_HB2))
#define LOG ((float*)(R + R_LOG))
#define XS ((bf16_t*)(R + R_XS))
#define HID ((bf16_t*)(R + R_HID))
#define CNT ((unsigned*)(ws + WS_MISC + MS_CNT))
#define TE ((int*)(ws + WS_MISC + MS_TE))
#define TW ((float*)(ws + WS_MISC + MS_TW))
#define SLOT ((int*)(ws + WS_MISC + MS_SLOT))
#define WSLOT ((float*)(ws + WS_MISC + MS_WSLOT))
#define TILETAB ((int*)(ws + WS_MISC + MS_TILE))

    if (PK(0) && IN(0)) for (int rep_ = 0; rep_ < REPS(0); ++rep_) { asm volatile("; PHASE_MARK 0"); OPQ();
        for (int t = bid * NTHREADS + tid_o; t < T; t += G * NTHREADS) { const float p = (float)positions[t];
#pragma unroll 4
            for (int j = 0; j < 16; ++j) { float s, c; sincos_f32(p * ap->invq[j], s, c); cosq[(size_t)t * 16 + j] = c; sinq[(size_t)t * 16 + j] = s; }
#pragma unroll 4
            for (int j = 0; j < 8; ++j) { float s, c; sincos_f32(p * ap->invi[j], s, c); cosi[(size_t)t * 8 + j] = c; sini[(size_t)t * 8 + j] = s; } }
        LAS float* scr = (LAS float*)(lds + wid * 16384);
        constexpr int I_WIN = 16 * 240, I_WP = 8 * 32, I_WO = 16 * 32, I_WR = 16 * 8, I_LAYER = I_WIN + 3 * I_WP + I_WO + I_WR;
        for (int it = gw; it < DEPTH * I_LAYER; it += NGW) { const int l = it / I_LAYER; int r = it % I_LAYER;
            if (r < I_WIN) { cvt_item(SrcWin{ap->in[5] + (size_t)l * DM * D_IN}, WIN + (size_t)l * NPROJ * DM, DM, 64 * (r / 240), 32 * (r % 240), scr, lane); continue; } r -= I_WIN;
            if (r < 3 * I_WP) { const int br = r / I_WP, q = r % I_WP; cvt_item(SrcPlain{ap->in[9 + br] + (size_t)l * 512 * DM, DM}, WP + ((size_t)l * 3 + br) * DM * 512, 512, 64 * (q / 32), 32 * (q % 32), scr, lane); continue; } r -= 3 * I_WP;
            if (r < I_WO) { cvt_item(SrcPlain{ap->in[12] + (size_t)l * DM * DM, DM}, WO + (size_t)l * DM * DM, DM, 64 * (r / 32), 32 * (r % 32), scr, lane); continue; } r -= I_WO;
            cvt_item(SrcRouter{ap->in[13] + (size_t)l * DM * 4, ap->in[15] + (size_t)l * DM * 32}, WR + (size_t)l * 256 * DM, DM, 64 * (r / 8), 32 * (r % 8), scr, lane);
        }
        for (int m = gw; m < T; m += NGW) rms_row(x_in + (size_t)m * DM, nullptr, nullptr, g_mix, nullptr, HB + (size_t)m * DM, nullptr, lane);
    }
    SEAM(0);

#pragma unroll 1
    for (int l = 0; l < DEPTH; ++l) {
        const int pb = 1 + l * NPH_LAYER;
        if (PK(1) && IN(pb + 0)) for (int rep_ = 0; rep_ < REPS(1); ++rep_) { asm volatile("; PHASE_MARK 1"); OPQ();
            pg8::DenseOrder S; S.init(HB, WIN + (size_t)l * NPROJ * DM, T, NPROJ, DM, G, bid);
            EpiProj E{ws};
            pg8::gemm_phase(lds, DM, S, E);
        }
        SEAM(pb + 0);
        if (PK(2) && IN(pb + 1)) for (int rep_ = 0; rep_ < REPS(2); ++rep_) { asm volatile("; PHASE_MARK 2"); OPQ();
            for (int item = bid; item < T / 128; item += G)
                gmlp_conv_item(lds, item, UA, VA, CB, CC, CX, ap->in[6] + (size_t)l * 4 * 128 * 128, ap->in[7] + (size_t)l * 4 * 128, ap->in[8] + (size_t)l * 3 * 512, wid, lane);
        }
        SEAM(pb + 1);
        if (PK(3) && IN(pb + 2)) for (int rep_ = 0; rep_ < REPS(3); ++rep_) { asm volatile("; PHASE_MARK 3"); OPQ();
            unsigned char* scr = (unsigned char*)(R + R_SCR + (size_t)bid * SCR_PER_WG);
            int nslow = 0;
            for (int i = 0; i * G < 2048; ++i) { const int idx = i * G + ((i & 1) ? (G - 1 - bid) : bid); if (idx >= 2048) continue;
                const int ib = idx >> 10, iq = idx & 1023;
                bool done = false;
                if (iq >= IX_FAST_MIN_QT) done = indexer_item_fast(lds, ib, iq, QI, KI, WI, MASK, wid, lane, tid_o);
                if (!done) { if (tid_o == 0) MISC[16 + nslow] = (unsigned)idx; ++nslow; } }
            __syncthreads();
            for (int k = 0; k < nslow; ++k) { const int idx = (int)MISC[16 + k];
                indexer_item(lds, scr, idx >> 10, idx & 1023, QI, KI, WI, MASK, wid, lane); }
        }
        SEAM(pb + 2);
        if (PK(4) && IN(pb + 3)) for (int rep_ = 0; rep_ < REPS(4); ++rep_) { asm volatile("; PHASE_MARK 4"); OPQ();
            for (int it = bid; it < 256; it += G) { const int bh = it & 7, y = it >> 3, b = bh >> 2, h = bh & 3;
#pragma unroll 1
                for (int half = 0; half < 2; ++half) { const int qb = half ? 63 - y : y, P0 = qb * 256;
                    const size_t hoff = (size_t)b * SEQ * 512 + h * 128;
                    att::attn_block((LAS char*)lds, Qm + hoff + (size_t)P0 * 512, Km + hoff, VB + hoff, YB + hoff + (size_t)P0 * 512, MASK + (size_t)(b * 64 + qb) * 256 * 256, P0); } }
#ifdef SELFCHECK
            xcd_barrier(bar);
            if (bid < 64) { const int tl[32] = {0, 1, 63, 64, 255, 256, 257, 300, 383, 511, 512, 600, 777, 1023, 1024, 2000, 3333, 4095, 4096, 5000, 7000, 8191, 8192, 9000, 11111, 12287, 12288, 14000, 15000, 16000, 16382, 16383};
                int tsel = 0;
#pragma unroll
                for (int q = 0; q < 32; ++q) tsel = ((bid & 31) == q) ? tl[q] : tsel;
                selfcheck_row(lds, bid >> 5, tsel, QI, KI, WI, MASK, Qm, Km, VB, YB, (unsigned*)(ws + WS_CTL) + CW_ERR, tid_o); }
#endif
        }
        SEAM(pb + 3);
        if (PK(5) && IN(pb + 4)) for (int rep_ = 0; rep_ < REPS(5); ++rep_) { asm volatile("; PHASE_MARK 5"); OPQ();
            MergeOrder S{(const char*)R, (const char*)(WP + (size_t)l * 3 * DM * 512), G, bid};
            EpiMerge E{MG, G8};
            pg8::gemm_phase(lds, 512, S, E);
        }
        SEAM(pb + 4);
        if (PK(6) && IN(pb + 5)) for (int rep_ = 0; rep_ < REPS(6); ++rep_) { asm volatile("; PHASE_MARK 6"); OPQ();
            pg8::DenseOrder S; S.init(MG, WO + (size_t)l * DM * DM, T, DM, DM, G, bid);
            EpiWout E{l == 0 ? x_in : (const float*)XA, XA};
            pg8::gemm_phase(lds, DM, S, E);
        }
        SEAM(pb + 5);
        if (PK(7) && IN(pb + 6)) for (int rep_ = 0; rep_ < REPS(7); ++rep_) { asm volatile("; PHASE_MARK 7"); OPQ();
            for (int m = gw; m < T; m += NGW) rms_row(XA + (size_t)m * DM, nullptr, nullptr, g_ffn + (size_t)l * DM, nullptr, HB2 + (size_t)m * DM, nullptr, lane);
            LAS float* scr = (LAS float*)(lds + wid * 16384);
            constexpr int I_GU = 16 * 32, I_D = 8 * 32, I_E = I_GU + I_D;
            for (int it = gw; it < NEXP * I_E; it += NGW) { const int e = it / I_E, r = it % I_E; const size_t eo = ((size_t)l * NEXP + e) * DM * DFF;
                if (r < I_GU) cvt_item(SrcGateUp{ap->in[17] + eo, ap->in[18] + eo}, WGU + (size_t)e * DM * DM, DM, 64 * (r / 32), 32 * (r % 32), scr, lane);
                else { const int q = r - I_GU; cvt_item(SrcPlain{ap->in[19] + eo, DM}, WD + (size_t)e * DM * DFF, DFF, 64 * (q / 32), 32 * (q % 32), scr, lane); } }
        }
        SEAM(pb + 6);
        if (PK(8) && IN(pb + 7)) for (int rep_ = 0; rep_ < REPS(8); ++rep_) { asm volatile("; PHASE_MARK 8"); OPQ();
            pg8::DenseOrder S; S.init(HB2, WR + (size_t)l * 256 * DM, T, 256, DM, G, bid);
            EpiRouter E{LOG};
            pg8::gemm_phase(lds, DM, S, E);
        }
        SEAM(pb + 7);
        if (PK(9) && IN(pb + 8)) for (int rep_ = 0; rep_ < REPS(9); ++rep_) { asm volatile("; PHASE_MARK 9"); OPQ(); for (int blk = bid; blk < 256; blk += G) route_a(lds, blk, LOG, ap->in[14] + l * 4, ap->in[16] + l * 32, TE, TW, CNT, tid_o); }
        SEAM(pb + 8);
        if (PK(10) && IN(pb + 9)) for (int rep_ = 0; rep_ < REPS(10); ++rep_) { asm volatile("; PHASE_MARK 10"); OPQ(); for (int blk = bid; blk < 256; blk += G) route_b(lds, blk, CNT, TE, TW, HB2, XS, WSLOT, SLOT, TILETAB, wid, lane, tid_o); }
        SEAM(pb + 9);
        if (PK(11) && IN(pb + 10)) for (int rep_ = 0; rep_ < REPS(11); ++rep_) { asm volatile("; PHASE_MARK 11"); OPQ();
            MoeOrder S{(const char*)XS, (const char*)WGU, TILETAB, (size_t)256 * DM * 2, (size_t)DM * DM * 2, (size_t)256 * DM * 2, G, bid};
            EpiGateUp E{HID};
            pg8::gemm_phase(lds, DM, S, E);
        }
        SEAM(pb + 10);
        if (PK(12) && IN(pb + 11)) for (int rep_ = 0; rep_ < REPS(12); ++rep_) { asm volatile("; PHASE_MARK 12"); OPQ();
            MoeOrder S{(const char*)HID, (const char*)WD, TILETAB, (size_t)256 * DFF * 2, (size_t)DM * DFF * 2, (size_t)256 * DFF * 2, G, bid};
            EpiDown E{XS, WSLOT};
            pg8::gemm_phase(lds, DFF, S, E);
        }
        SEAM(pb + 11);
        if (PK(13) && IN(pb + 12)) for (int rep_ = 0; rep_ < REPS(13); ++rep_) { asm volatile("; PHASE_MARK 13"); OPQ();
            const bool lastl = (l == DEPTH - 1);
#ifdef SELFCHECK
            const float probe_scale = 1.0f + (float)__hip_atomic_load((unsigned*)(ws + WS_CTL) + CW_ERR, __ATOMIC_RELAXED, __HIP_MEMORY_SCOPE_AGENT);
#endif
            for (int m = gw; m < T; m += NGW) { const int s0 = SLOT[2 * m], s1 = SLOT[2 * m + 1];
                rms_row(XA + (size_t)m * DM, XS + (size_t)s0 * DM, XS + (size_t)s1 * DM, lastl ? g_fin : g_mix + (size_t)(l + 1) * DM,
                        lastl ? nullptr : XA + (size_t)m * DM, lastl ? nullptr : HB + (size_t)m * DM, lastl ? XA + (size_t)m * DM : nullptr, lane);
#ifdef SELFCHECK
                if (lastl) { f32x4* o4 = (f32x4*)(XA + (size_t)m * DM) + lane;
#pragma unroll
                    for (int j = 0; j < 4; ++j) o4[64 * j] = o4[64 * j] * probe_scale; }
#endif
            }
        }
        SEAM(pb + 12);
    }
#undef IN
#undef SEAM
#undef x_in
#undef positions
#undef g_mix
#undef g_ffn
#undef g_fin
#undef XA
#undef cosq
#undef sinq
#undef cosi
#undef sini
#undef WIN
#undef WP
#undef WO
#undef WR
#undef R
#undef HB
#undef VA
#undef CC
#undef CX
#undef YB
#undef UA
#undef Qm
#undef Km
#undef VB
#undef CB
#undef QI
#undef KI
#undef WI
#undef G8
#undef MASK
#undef MG
#undef WGU
#undef WD
#undef HB2
#undef LOG
#undef XS
#undef HID
#undef CNT
#undef TE
#undef TW
#undef SLOT
#undef WSLOT
#undef TILETAB
}

#ifndef N_LAUNCH_MODE
#define N_LAUNCH_MODE 1
#endif
extern "C" void kernel_launch(void* const* d_in, const int* in_sizes, int n_in, void* d_out, int out_size, void* d_ws, size_t ws_size, hipStream_t stream) {
    static int grid = 0;
    if (grid == 0) {
        if (n_in != 20 || in_sizes[0] != T * DM || out_size != T * DM || ws_size < WS_END) { fprintf(stderr, "kernel_launch: unexpected shapes (n_in %d, in0 %d, out %d, ws %zu < %zu)\n", n_in, n_in > 0 ? in_sizes[0] : -1, out_size, ws_size, (size_t)WS_END); grid = -1; return; }
        int dev = 0, cus = 0, per_cu = 0;
        if (hipGetDevice(&dev) != hipSuccess || hipDeviceGetAttribute(&cus, hipDeviceAttributeMultiprocessorCount, dev) != hipSuccess) { grid = -1; return; }
        if (hipFuncSetAttribute((const void*)fwd_kernel, hipFuncAttributeMaxDynamicSharedMemorySize, LDS_BYTES) != hipSuccess) { fprintf(stderr, "kernel_launch: hipFuncSetAttribute failed\n"); grid = -1; return; }
        if (hipOccupancyMaxActiveBlocksPerMultiprocessor(&per_cu, (const void*)fwd_kernel, NTHREADS, LDS_BYTES) != hipSuccess || per_cu < 1) { fprintf(stderr, "kernel_launch: occupancy query says %d\n", per_cu); }
        (void)hipGetLastError();
        grid = cus;
    }
    if (grid < 0) return;
    if (hipMemsetAsync((char*)d_ws + WS_CTL, 0, CTL_ZERO_BYTES, stream) != hipSuccess) return;
    Args a{};
    for (int i = 0; i < 20; ++i) a.in[i] = (const float*)d_in[i];
    a.out = (float*)d_out; a.ws = (unsigned char*)d_ws;
    for (int j = 0; j < 16; ++j) a.invq[j] = powf(500000.0f, -(float)j * 2.0f / 32.0f);
    for (int j = 0; j < 8; ++j) a.invi[j] = powf(500000.0f, -(float)j * 2.0f / 16.0f);
#if N_LAUNCH_MODE == 1
    a.ph_lo = 0; a.ph_hi = NPHASES; a.li = 0;
    hipLaunchKernelGGL(fwd_kernel, dim3(grid), dim3(NTHREADS), LDS_BYTES, stream, a);
#else
    for (int p = 0; p < NPHASES; ++p) { a.ph_lo = p; a.ph_hi = p + 1; a.li = p; hipLaunchKernelGGL(fwd_kernel, dim3(grid), dim3(NTHREADS), LDS_BYTES, stream, a); }
#endif
}
```

```cpp
#include <hip/hip_runtime.h>
#include <cstdio>
#include <cstdint>
#include <cmath>

#define LAS __attribute__((address_space(3)))
#define GAS __attribute__((address_space(1)))
typedef unsigned short bf16_t;
typedef short bf16x8 __attribute__((ext_vector_type(8)));
typedef short s16x4 __attribute__((ext_vector_type(4)));
typedef float f32x4 __attribute__((ext_vector_type(4)));
typedef float f32x16 __attribute__((ext_vector_type(16)));
typedef unsigned u32x4 __attribute__((ext_vector_type(4)));
typedef unsigned u32x2 __attribute__((ext_vector_type(2)));

constexpr int DM = 1024, NB = 2, SEQ = 16384, T = NB * SEQ, DEPTH = 2;
constexpr int D_IN = 7492, NPROJ = 7680;
constexpr int NEXP = 32, DFF = 512;
constexpr int MAXROWS = 2 * T + NEXP * 256;
constexpr float EPS = 1e-6f;
constexpr int NWAVES = 8, NTHREADS = 512;

constexpr size_t MiB = 1u << 20;
constexpr size_t WS_CTL = 0, CTL_ZERO_BYTES = 1 * MiB;
constexpr size_t WS_COSQ = 1 * MiB, WS_SINQ = 3 * MiB, WS_COSI = 5 * MiB, WS_SINI = 6 * MiB;
constexpr size_t WS_WIN = 8 * MiB;
constexpr size_t WS_WP = 38 * MiB;
constexpr size_t WS_WO = 44 * MiB;
constexpr size_t WS_WR = 48 * MiB;
constexpr size_t WS_MISC = 49 * MiB;
constexpr size_t MS_CNT = 0;
constexpr size_t MS_TE = 64 * 1024;
constexpr size_t MS_TW = MS_TE + 256 * 1024;
constexpr size_t MS_SLOT = MS_TW + 256 * 1024;
constexpr size_t MS_WSLOT = MS_SLOT + 256 * 1024;
constexpr size_t MS_TILE = MS_WSLOT + 320 * 1024;
constexpr size_t WS_R = 52 * MiB;
constexpr size_t R_HB = 0, R_VA = 64 * MiB, R_CC = 96 * MiB, R_CX = 128 * MiB, R_SCR = 0  , R_YB = 128 * MiB  , R_UA = 160 * MiB, R_Q = 192 * MiB,
                 R_K = 224 * MiB, R_VB = 256 * MiB, R_CB = 288 * MiB, R_QI = 320 * MiB, R_KI = 336 * MiB, R_WI = 340 * MiB, R_G8 = 342 * MiB, R_MASK = 438 * MiB,
                 R_MERGED = 224 * MiB  , R_MIX_END = 502 * MiB;
constexpr size_t R_WGU = 0, R_WD = 64 * MiB, R_HB2 = 96 * MiB, R_LOG = 160 * MiB, R_XS = 168 * MiB, R_HID = 312 * MiB, R_MOE_END = 384 * MiB;
constexpr size_t WS_END = WS_R + R_MIX_END;
static_assert((size_t)MAXROWS * 2048 <= 144 * MiB && (size_t)MAXROWS * 1024 <= 72 * MiB, "moe buffers");
constexpr size_t SCR_PER_WG = 512 * 1024;

constexpr int CW_ERR = 0;
constexpr int CW_WQ = 1024;
constexpr int CW_BAR = 4096;

constexpr int RING_BYTES = 131072;
constexpr int LDS_BYTES = 163840;
constexpr int MISC_OFF = LDS_BYTES - 256;

__host__ __device__ __forceinline__ size_t ki_chunk(int b, int s, int chunk  ) {
    const int st = s >> 7, ko = s & 127, a = ko >> 5, j = (ko >> 2) & 7, c = ko & 3, m = 4 * a + c, half = chunk >> 2, g4 = chunk & 3;
    return ((((size_t)(b * 128 + st) * 8 + j) * 2 + half) * 64 + g4 * 16 + m) * 8;
}
#define LDS_WAIT() asm volatile("s_waitcnt lgkmcnt(0)" ::: "memory")
#define VM_WAIT() asm volatile("s_waitcnt vmcnt(0)" ::: "memory")
#define SBAR() __builtin_amdgcn_sched_barrier(0)
__device__ __forceinline__ unsigned cvtpk(float lo, float hi) { unsigned r; asm volatile("v_cvt_pk_bf16_f32 %0, %1, %2" : "=v"(r) : "v"(lo), "v"(hi)); return r; }
__device__ __forceinline__ float bf_lo(unsigned w) { return __uint_as_float(w << 16); }
__device__ __forceinline__ float bf_hi(unsigned w) { return __uint_as_float(w & 0xffff0000u); }
__device__ __forceinline__ unsigned wave_sum_u(unsigned v) {
    v += (unsigned)__builtin_amdgcn_update_dpp(0, (int)v, 0xB1, 0xF, 0xF, true);
    v += (unsigned)__builtin_amdgcn_update_dpp(0, (int)v, 0x4E, 0xF, 0xF, true);
    v += (unsigned)__builtin_amdgcn_update_dpp(0, (int)v, 0x141, 0xF, 0xF, true);
    v += (unsigned)__builtin_amdgcn_update_dpp(0, (int)v, 0x140, 0xF, 0xF, true);
    return (unsigned)__builtin_amdgcn_readlane((int)v, 0) + (unsigned)__builtin_amdgcn_readlane((int)v, 16) + (unsigned)__builtin_amdgcn_readlane((int)v, 32) + (unsigned)__builtin_amdgcn_readlane((int)v, 48);
}
__device__ __forceinline__ float wave_sum(float v) {
    v += __int_as_float(__builtin_amdgcn_update_dpp(0, __float_as_int(v), 0xB1, 0xF, 0xF, true));
    v += __int_as_float(__builtin_amdgcn_update_dpp(0, __float_as_int(v), 0x4E, 0xF, 0xF, true));
    v += __int_as_float(__builtin_amdgcn_update_dpp(0, __float_as_int(v), 0x141, 0xF, 0xF, true));
    v += __int_as_float(__builtin_amdgcn_update_dpp(0, __float_as_int(v), 0x140, 0xF, 0xF, true));
    return (__int_as_float(__builtin_amdgcn_readlane(__float_as_int(v), 0)) + __int_as_float(__builtin_amdgcn_readlane(__float_as_int(v), 16))) +
           (__int_as_float(__builtin_amdgcn_readlane(__float_as_int(v), 32)) + __int_as_float(__builtin_amdgcn_readlane(__float_as_int(v), 48)));
}
__device__ __forceinline__ float relu_f(float x) { const int xi = __float_as_int(x); return __int_as_float(xi > 0 ? xi : 0); }
__device__ __forceinline__ float fast_sigmoid(float x) { return __builtin_amdgcn_rcpf(1.0f + __builtin_amdgcn_exp2f(-1.4426950408889634f * x)); }
__device__ __forceinline__ float gelu_tanh(float x) { const float z = 0.7978845608028654f * (x + 0.044715f * x * x * x); return x * fast_sigmoid(2.0f * z); }

#define XB_TMO      128
#define XB_XCNT(j)  (256  + 64 * (j))
#define XB_XSUB(j)  (1280 + 64 * (j))
#define XB_XGEN(j)  (2304 + 64 * (j))
#define XB_TOP      3328
#define XB_TOPGEN   3392
#define XCD_BAR_WORDS 3456
#define XB_SPIN_CAP (1u << 18)

__device__ __forceinline__ unsigned xb_ld(unsigned* p)              { return __hip_atomic_load(p, __ATOMIC_RELAXED, __HIP_MEMORY_SCOPE_AGENT); }
__device__ __forceinline__ unsigned xb_add(unsigned* p, unsigned v) { return __hip_atomic_fetch_add(p, v, __ATOMIC_RELAXED, __HIP_MEMORY_SCOPE_AGENT); }
__device__ __forceinline__ unsigned xb_xcc_id() { return (unsigned)__builtin_amdgcn_s_getreg((3 << 11) | 20) & 0xFu; }
#define XB_SPIN(cond, bar) do { unsigned _sp = 0; while (cond) { __builtin_amdgcn_s_sleep(1); \
    if ((++_sp & 255u) == 0u) { if (xb_ld(&(bar)[XB_TMO])) break; if (_sp > XB_SPIN_CAP) { atomicAdd(&(bar)[XB_TMO], 1u); break; } } } } while (0)

struct XcdBarrier {
    unsigned* bar; unsigned x;
    volatile LAS unsigned* st;
};

__device__ __forceinline__ XcdBarrier xcd_barrier_post(unsigned* bar, volatile LAS unsigned* st) {
    XcdBarrier b; b.bar = bar; b.x = xb_xcc_id(); b.st = st;
    if (threadIdx.x == 0) (void)xb_add(&bar[XB_XCNT(b.x)], 1u);
    return b;
}
__device__ __forceinline__ void xcd_barrier_complete(unsigned* bar, unsigned x, unsigned& nloc, unsigned& nx) {
    const unsigned G = gridDim.x * gridDim.y * gridDim.z;
    unsigned sum, cnt, mine, sp = 0u;
    for (;;) {
        sum = 0u; cnt = 0u; mine = 0u;
#pragma unroll
        for (unsigned j = 0; j < 16; ++j) { const unsigned c = xb_ld(&bar[XB_XCNT(j)]); sum += c; cnt += (c > 0u) ? 1u : 0u; mine = (j == x) ? c : mine; }
        if (sum == G) break;
        __builtin_amdgcn_s_sleep(1);
        if ((++sp & 255u) == 0u) { if (xb_ld(&bar[XB_TMO])) break; if (sp > XB_SPIN_CAP) { atomicAdd(&bar[XB_TMO], 1u); break; } }
    }
    nloc = mine > 0u ? mine : 1u; nx = cnt > 0u ? cnt : 1u;
}

__device__ __forceinline__ void xcd_barrier(const XcdBarrier& b) {
    asm volatile("s_waitcnt vmcnt(0)" ::: "memory");
    __syncthreads();
    unsigned xb_t = threadIdx.x; asm volatile("" : "+v"(xb_t));
    if (xb_t == 0) {
        unsigned* bar = b.bar;
        __builtin_amdgcn_s_waitcnt(0);
        unsigned nloc = b.st[0], nx = b.st[1];
        if (nloc == 0u) { xcd_barrier_complete(bar, b.x, nloc, nx); b.st[0] = nloc; b.st[1] = nx; }
        const unsigned old = xb_add(&bar[XB_XSUB(b.x)], 1u);
        const unsigned gen = old / nloc;
        if (old + 1u == (gen + 1u) * nloc) {
            __builtin_amdgcn_fence(__ATOMIC_RELEASE, "agent");
            asm volatile("s_waitcnt vmcnt(0)" ::: "memory");
            const unsigned og = xb_add(&bar[XB_TOP], 1u);
            const unsigned tg = og / nx;
            if (og + 1u == (tg + 1u) * nx) xb_add(&bar[XB_TOPGEN], 1u);
            else XB_SPIN(xb_ld(&bar[XB_TOPGEN]) == tg, bar);
            __builtin_amdgcn_fence(__ATOMIC_ACQUIRE, "agent");
            xb_add(&bar[XB_XGEN(b.x)], 1u);
            asm volatile("s_waitcnt vmcnt(0)" ::: "memory");
        } else {
            XB_SPIN(xb_ld(&bar[XB_XGEN(b.x)]) == gen, bar);
            __builtin_amdgcn_fence(__ATOMIC_ACQUIRE, "agent");
            asm volatile("s_waitcnt vmcnt(0)" ::: "memory");
        }
    }
    __syncthreads();
}
namespace pg8 {
constexpr int BM = 256, BK = 64, HALF = 128, HTB = HALF * BK * 2, STAGE_BYTES = 8 * HTB, NXCD = 8, WGM = 8;
__host__ __device__ __forceinline__ int lds_byte(int r, int c) { const int st = (r >> 4) * 2 + (c >> 5), rr = r & 15, cc = c & 31, ob = rr * 64 + cc * 2; return st * 1024 + (ob ^ (((ob >> 9) & 1) << 5)); }
__host__ __device__ __forceinline__ void stage_rc(int b, int& R, int& C) { const int st = b / 1024, sb = b % 1024, swz = sb ^ (((sb >> 9) & 1) << 5); R = (st >> 1) * 16 + swz / 64; C = (st & 1) * 32 + (swz % 64) / 2; }
__host__ __device__ __forceinline__ int perm32(int rho) { const int n = rho >> 4, i = rho & 15; return 8 * (i >> 2) + 4 * n + (i & 3); }

struct Unit { const char* a; const char* b; int pm, pn, z; };

struct DenseOrder {
    const char* A; const char* Bt; int K; int nM, nN, nwg, G, c;
    __device__ void init(const void* A_, const void* Bt_, int M, int N, int K_, int G_, int c_) { A = (const char*)A_; Bt = (const char*)Bt_; K = K_; nM = M / BM; nN = N / BM; nwg = nM * nN; G = G_; c = c_; }
    __device__ bool next(int i, Unit& u) const {
        const long L = (long)i * G + c; if (L >= nwg) return false;
        int wgid = (int)L; { const int q = nwg / NXCD, r = nwg % NXCD, xcd = wgid % NXCD, off = wgid / NXCD; wgid = (xcd < r ? xcd * (q + 1) : r * (q + 1) + (xcd - r) * q) + off; }
        const int nig = WGM * nN, gid = wgid / nig, fm = gid * WGM, gsz = (nM - fm) < WGM ? (nM - fm) : WGM;
        u.pm = fm + ((wgid % nig) % gsz); u.pn = (wgid % nig) / gsz; u.z = 0;
        u.a = A + (size_t)u.pm * BM * K * 2; u.b = Bt + (size_t)u.pn * BM * K * 2; return true;
    }
};

template <class Epi, class Sched>
__device__ __forceinline__ void gemm_phase(LAS unsigned char* lds, const int K, const Sched& S, const Epi& E) {
    int tid_ = threadIdx.x; asm volatile("" : "+v"(tid_));
    const int tid = tid_, wid = __builtin_amdgcn_readfirstlane(tid >> 6), lane = tid & 63, wr = wid >> 2, wc = wid & 3, fr = lane & 15, fq = lane >> 4;
    const int nt = K / BK;
    unsigned voffA[2], voffB[2];
#pragma unroll
    for (int i = 0; i < 2; ++i) { int R, C; stage_rc(tid * 16 + i * 8192, R, C); const int Rb = Epi::PERM ? ((R & ~31) + perm32(R & 31)) : R;
        voffA[i] = (unsigned)(R * K + C) * 2u; voffB[i] = (unsigned)(Rb * K + C) * 2u; }
    const size_t kstep = (size_t)(BK * 2);
    const size_t hstep = (size_t)HALF * K * 2;
    const unsigned ldsw = (unsigned)wid * 1024u;
    const int aoff = lds_byte(wr * 64 + fr, fq * 8), boff = lds_byte(wc * 32 + fr, fq * 8);
#define PG8_SA(b, h) (((b) * 2 + (h)) * HTB)
#define PG8_SB(b, h) ((4 + (b) * 2 + (h)) * HTB)
#define PG8_STAGE(bufoff, gbase, voff) do { _Pragma("unroll") for (int _i = 0; _i < 2; ++_i) \
        __builtin_amdgcn_global_load_lds((const unsigned*)((const char*)(gbase) + (voff)[_i]), (LAS unsigned*)(lds + (bufoff) + ldsw + _i * 8192), 16, 0, 0); } while (0)
#define PG8_LDA(dst, b, h) do { _Pragma("unroll") for (int m = 0; m < 4; ++m) _Pragma("unroll") for (int k = 0; k < 2; ++k) dst[m][k] = *(const LAS bf16x8*)(lds + PG8_SA(b, h) + aoff + m * 2048 + k * 1024); } while (0)
#define PG8_LDB(dst, b, h) do { _Pragma("unroll") for (int n = 0; n < 2; ++n) _Pragma("unroll") for (int k = 0; k < 2; ++k) dst[n][k] = *(const LAS bf16x8*)(lds + PG8_SB(b, h) + boff + n * 2048 + k * 1024); } while (0)
#define PG8_MMA(ai, bj, At, Bt) do { __builtin_amdgcn_s_setprio(1); _Pragma("unroll") for (int m = 0; m < 4; ++m) _Pragma("unroll") for (int n = 0; n < 2; ++n) _Pragma("unroll") for (int k = 0; k < 2; ++k) \
        acc[ai][bj][m][n] = __builtin_amdgcn_mfma_f32_16x16x32_bf16(Bt[n][k], At[m][k], acc[ai][bj][m][n], 0, 0, 0); __builtin_amdgcn_s_setprio(0); } while (0)
#define PG8_WAIT_V(n) asm volatile("s_waitcnt vmcnt(" #n ")" ::: "memory")
#define PG8_WAIT_L(n) asm volatile("s_waitcnt lgkmcnt(" #n ")" ::: "memory")
#define PG8_BAR __builtin_amdgcn_s_barrier()
#define PG8_SCHED __builtin_amdgcn_sched_barrier(0)
    Unit cur, nxt; int ui = 0;
    if (!S.next(0, cur)) return;
#ifdef PG8_STAGGER
    { const int dl_ = ((int)blockIdx.x >> 3) & 3; for (int i_ = 0; i_ < dl_; ++i_) __builtin_amdgcn_s_sleep(PG8_STAGGER); }
#endif
    f32x4 acc[2][2][4][2];
#pragma unroll
    for (int a = 0; a < 2; ++a)
#pragma unroll
        for (int b = 0; b < 2; ++b)
#pragma unroll
            for (int m = 0; m < 4; ++m)
#pragma unroll
                for (int n = 0; n < 2; ++n) acc[a][b][m][n] = (f32x4){0.f, 0.f, 0.f, 0.f};
    bf16x8 At[4][2], B0[2][2], B1[2][2];
    const char* cA = cur.a; const char* cB = cur.b;
    PG8_STAGE(PG8_SB(0, 0), cB, voffB); PG8_STAGE(PG8_SA(0, 0), cA, voffA); PG8_STAGE(PG8_SB(0, 1), cB + hstep, voffB); PG8_STAGE(PG8_SA(0, 1), cA + hstep, voffA);
    if (wr == 1) PG8_BAR;
    PG8_WAIT_V(4); PG8_BAR;
    PG8_STAGE(PG8_SB(1, 0), cB + kstep, voffB); PG8_STAGE(PG8_SA(1, 0), cA + kstep, voffA); PG8_STAGE(PG8_SB(1, 1), cB + hstep + kstep, voffB);
    PG8_WAIT_V(6); PG8_BAR;
    for (;;) {
        const bool has_next = S.next(ui + 1, nxt);
        const char* nA = has_next ? nxt.a : cA; const char* nB = has_next ? nxt.b : cB;
        for (int t = 0; t < nt; t += 2) {
            const bool last = (t == nt - 2);
            const char* a1 = cA + (size_t)(t + 1) * kstep;
            const char* a2 = last ? nA : cA + (size_t)(t + 2) * kstep; const char* b2 = last ? nB : cB + (size_t)(t + 2) * kstep;
            const char* a3 = a2 + kstep; const char* b3 = b2 + kstep;
            PG8_LDB(B0, 0, 0); PG8_SCHED; PG8_LDA(At, 0, 0); PG8_STAGE(PG8_SA(1, 1), a1 + hstep, voffA);
            PG8_WAIT_L(8); PG8_BAR; PG8_WAIT_L(0); PG8_MMA(0, 0, At, B0); PG8_BAR; PG8_SCHED;
            PG8_LDB(B1, 0, 1); PG8_STAGE(PG8_SB(0, 0), b2, voffB);
            PG8_BAR; PG8_WAIT_L(0); PG8_MMA(0, 1, At, B1); PG8_BAR;
            PG8_LDA(At, 0, 1); PG8_STAGE(PG8_SA(0, 0), a2, voffA);
            PG8_BAR; PG8_WAIT_L(0); PG8_MMA(1, 0, At, B0); PG8_BAR; PG8_SCHED;
            PG8_STAGE(PG8_SB(0, 1), b2 + hstep, voffB);
            PG8_WAIT_V(6); PG8_BAR; PG8_MMA(1, 1, At, B1); PG8_BAR;
            PG8_LDB(B0, 1, 0); PG8_SCHED; PG8_LDA(At, 1, 0); PG8_STAGE(PG8_SA(0, 1), a2 + hstep, voffA);
            PG8_WAIT_L(8); PG8_BAR; PG8_WAIT_L(0); PG8_MMA(0, 0, At, B0); PG8_BAR; PG8_SCHED;
            PG8_LDB(B1, 1, 1); PG8_STAGE(PG8_SB(1, 0), b3, voffB);
            PG8_BAR; PG8_WAIT_L(0); PG8_MMA(0, 1, At, B1); PG8_BAR;
            PG8_LDA(At, 1, 1); PG8_STAGE(PG8_SA(1, 0), a3, voffA);
            PG8_BAR; PG8_WAIT_L(0); PG8_MMA(1, 0, At, B0); PG8_BAR; PG8_SCHED;
            PG8_STAGE(PG8_SB(1, 1), b3 + hstep, voffB);
            PG8_WAIT_V(6); PG8_BAR; PG8_MMA(1, 1, At, B1); PG8_BAR;
        }
        E(acc, cur, wr, wc, fr, fq);
        if (!has_next) break;
#pragma unroll
        for (int a = 0; a < 2; ++a)
#pragma unroll
            for (int b = 0; b < 2; ++b)
#pragma unroll
                for (int m = 0; m < 4; ++m)
#pragma unroll
                    for (int n = 0; n < 2; ++n) acc[a][b][m][n] = (f32x4){0.f, 0.f, 0.f, 0.f};
        cur = nxt; cA = nA; cB = nB; ++ui;
    }
    PG8_WAIT_V(0);
    if (wr == 0) PG8_BAR;
    PG8_BAR;
#undef PG8_SA
#undef PG8_SB
#undef PG8_STAGE
#undef PG8_LDA
#undef PG8_LDB
#undef PG8_MMA
#undef PG8_WAIT_V
#undef PG8_WAIT_L
#undef PG8_BAR
#undef PG8_SCHED
}
}
__host__ __device__ __forceinline__ int ropemap128(int o) { if (o >= 32) return o; const int a = o >> 3, b = o & 7; return b < 4 ? 4 * a + b : 16 + 4 * a + (b - 4); }
__host__ __device__ __forceinline__ int ropemap64(int o) { if (o >= 16) return o; const int a = o >> 3, b = o & 7; return b < 4 ? 4 * a + b : 8 + 4 * a + (b - 4); }
__host__ __device__ __forceinline__ int colmap_proj(int s) {
    if (s < 1024) return s;
    if (s < 2048) { const int base = s < 1536 ? 1024 : 1536, o = s - base; return base + (o & ~127) + ropemap128(o & 127); }
    if (s < 2560) return s;
    if (s < 2816) { const int o = s - 2560; return 2560 + (o & ~63) + ropemap64(o & 63); }
    if (s < 3072) { const int o = s - 2816; if (o < 64) return 2816 + ropemap64(o); if (o < 68) return 2880 + (o - 64); return -1; }
    if (s < 4608) return 2884 + (s - 3072);
    return 4420 + (s - 4608);
}

struct EpiProj {
    static constexpr bool PERM = true;
    unsigned char* wsb;
    __device__ __forceinline__ void operator()(const f32x4 (&acc)[2][2][4][2], const pg8::Unit& u, int wr, int wc, int fr, int fq) const {
        asm volatile("" : "+v"(fr), "+v"(fq));
        unsigned char* const Rr = wsb + WS_R;
        bf16_t* const UA = (bf16_t*)(Rr + R_UA); bf16_t* const VA = (bf16_t*)(Rr + R_VA); bf16_t* const Q = (bf16_t*)(Rr + R_Q); bf16_t* const Kk = (bf16_t*)(Rr + R_K); bf16_t* const VB = (bf16_t*)(Rr + R_VB);
        bf16_t* const QI = (bf16_t*)(Rr + R_QI); bf16_t* const KI = (bf16_t*)(Rr + R_KI); bf16_t* const CB = (bf16_t*)(Rr + R_CB); bf16_t* const CC = (bf16_t*)(Rr + R_CC); bf16_t* const CX = (bf16_t*)(Rr + R_CX);
        float* const WI = (float*)(Rr + R_WI); unsigned char* const G8 = Rr + R_G8;
        const float* const cosq = (const float*)(wsb + WS_COSQ); const float* const sinq = (const float*)(wsb + WS_SINQ); const float* const cosi = (const float*)(wsb + WS_COSI); const float* const sini = (const float*)(wsb + WS_SINI);
        const int pn = u.pn;
        const int row0 = u.pm * 256 + wr * 64 + fr;
        const int cw = wc * 32 + 8 * fq;
        if (pn < 4 || (pn >= 8 && pn < 10) || (pn >= 12 && pn < 18)) {
            bf16_t* base; int ld = 512, c0 = (pn & 1) * 256;
            if (pn < 2) base = UA; else if (pn < 4) base = VA; else if (pn < 10) base = VB; else if (pn < 14) base = CB; else if (pn < 16) base = CC; else base = CX;
            const bool act = pn < 4;
#pragma unroll
            for (int ai = 0; ai < 2; ++ai)
#pragma unroll
                for (int m = 0; m < 4; ++m) { bf16_t* rowp = base + (size_t)(row0 + ai * 128 + m * 16) * ld + c0 + cw;
#pragma unroll
                    for (int bj = 0; bj < 2; ++bj) { f32x4 v0 = acc[ai][bj][m][0], v1 = acc[ai][bj][m][1];
                        if (act) {
#pragma unroll
                            for (int j = 0; j < 4; ++j) { v0[j] = gelu_tanh(v0[j]); v1[j] = gelu_tanh(v1[j]); } }
                        u32x4 w; w.x = cvtpk(v0[0], v0[1]); w.y = cvtpk(v0[2], v0[3]); w.z = cvtpk(v1[0], v1[1]); w.w = cvtpk(v1[2], v1[3]);
                        *(u32x4*)(rowp + bj * 128) = w; } }
        } else if (pn < 8) {
            bf16_t* base = pn < 6 ? Q : Kk; const int c0 = (pn & 1) * 256;
            f32x4 cs[2][4], sn[2][4];
#pragma unroll
            for (int ai = 0; ai < 2; ++ai)
#pragma unroll
                for (int m = 0; m < 4; ++m) { const int row = row0 + ai * 128 + m * 16; cs[ai][m] = (f32x4){1.f, 1.f, 1.f, 1.f}; sn[ai][m] = (f32x4){0.f, 0.f, 0.f, 0.f};
                    if (wc == 0) { cs[ai][m] = *(const f32x4*)(cosq + (size_t)row * 16 + 4 * fq); sn[ai][m] = *(const f32x4*)(sinq + (size_t)row * 16 + 4 * fq); } }
#pragma unroll
            for (int ai = 0; ai < 2; ++ai)
#pragma unroll
                for (int m = 0; m < 4; ++m) { const int row = row0 + ai * 128 + m * 16; bf16_t* rowp = base + (size_t)row * 512 + c0 + cw;
#pragma unroll
                    for (int bj = 0; bj < 2; ++bj) { const f32x4 x1 = acc[ai][bj][m][0], x2 = acc[ai][bj][m][1];
                        f32x4 v0 = x1, v1 = x2;
                        if (wc == 0) { v0 = x1 * cs[ai][m] - x2 * sn[ai][m]; v1 = x1 * sn[ai][m] + x2 * cs[ai][m]; }
                        u32x4 w; w.x = cvtpk(v0[0], v0[1]); w.y = cvtpk(v0[2], v0[3]); w.z = cvtpk(v1[0], v1[1]); w.w = cvtpk(v1[2], v1[3]);
                        *(u32x4*)(rowp + bj * 128) = w; } }
        } else if (pn == 10) {
            const bool rot = ((wc & 1) == 0) && fq < 2;
            f32x4 cs[2][4], sn[2][4];
#pragma unroll
            for (int ai = 0; ai < 2; ++ai)
#pragma unroll
                for (int m = 0; m < 4; ++m) { const int row = row0 + ai * 128 + m * 16; cs[ai][m] = (f32x4){1.f, 1.f, 1.f, 1.f}; sn[ai][m] = (f32x4){0.f, 0.f, 0.f, 0.f};
                    if (rot) { cs[ai][m] = *(const f32x4*)(cosi + (size_t)row * 8 + 4 * fq); sn[ai][m] = *(const f32x4*)(sini + (size_t)row * 8 + 4 * fq); } }
#pragma unroll
            for (int ai = 0; ai < 2; ++ai)
#pragma unroll
                for (int m = 0; m < 4; ++m) { const int row = row0 + ai * 128 + m * 16; bf16_t* rowp = QI + (size_t)row * 256 + cw;
#pragma unroll
                    for (int bj = 0; bj < 2; ++bj) { const f32x4 x1 = acc[ai][bj][m][0], x2 = acc[ai][bj][m][1];
                        const f32x4 v0 = x1 * cs[ai][m] - x2 * sn[ai][m], v1 = x1 * sn[ai][m] + x2 * cs[ai][m];
                        u32x4 w; w.x = cvtpk(v0[0], v0[1]); w.y = cvtpk(v0[2], v0[3]); w.z = cvtpk(v1[0], v1[1]); w.w = cvtpk(v1[2], v1[3]);
                        *(u32x4*)(rowp + bj * 128) = w; } }
        } else if (pn == 11) {
            const bool rot = (wc == 0) && fq < 2;
            f32x4 cs[2][4], sn[2][4];
#pragma unroll
            for (int ai = 0; ai < 2; ++ai)
#pragma unroll
                for (int m = 0; m < 4; ++m) { const int row = row0 + ai * 128 + m * 16; cs[ai][m] = (f32x4){1.f, 1.f, 1.f, 1.f}; sn[ai][m] = (f32x4){0.f, 0.f, 0.f, 0.f};
                    if (rot) { cs[ai][m] = *(const f32x4*)(cosi + (size_t)row * 8 + 4 * fq); sn[ai][m] = *(const f32x4*)(sini + (size_t)row * 8 + 4 * fq); } }
#pragma unroll
            for (int ai = 0; ai < 2; ++ai)
#pragma unroll
                for (int m = 0; m < 4; ++m) { const int row = row0 + ai * 128 + m * 16;
                    if (wc < 2) {
                        const f32x4 x1 = acc[ai][0][m][0], x2 = acc[ai][0][m][1];
                        const f32x4 v0 = x1 * cs[ai][m] - x2 * sn[ai][m], v1 = x1 * sn[ai][m] + x2 * cs[ai][m];
                        u32x4 w; w.x = cvtpk(v0[0], v0[1]); w.y = cvtpk(v0[2], v0[3]); w.z = cvtpk(v1[0], v1[1]); w.w = cvtpk(v1[2], v1[3]);
                        *(u32x4*)(KI + ki_chunk(row >> 14, row & (SEQ - 1), cw >> 3)) = w;
                    } else if (wc == 2 && fq == 0) {
                        *(f32x4*)(WI + (size_t)row * 4) = acc[ai][0][m][0] * 0.0625f;
                    } }
        } else {
            unsigned char* base = G8 + (size_t)(pn - 18) * 256 + cw;
#pragma unroll
            for (int ai = 0; ai < 2; ++ai)
#pragma unroll
                for (int m = 0; m < 4; ++m) { unsigned char* rowp = base + (size_t)(row0 + ai * 128 + m * 16) * 3072;
#pragma unroll
                    for (int bj = 0; bj < 2; ++bj) { const f32x4 v0 = acc[ai][bj][m][0], v1 = acc[ai][bj][m][1];
                        unsigned q[8];
#pragma unroll
                        for (int j = 0; j < 4; ++j) { q[j] = (unsigned)(fast_sigmoid(v0[j]) * 255.0f + 0.5f); q[4 + j] = (unsigned)(fast_sigmoid(v1[j]) * 255.0f + 0.5f); }
                        u32x2 w; w.x = q[0] | (q[1] << 8) | (q[2] << 16) | (q[3] << 24); w.y = q[4] | (q[5] << 8) | (q[6] << 16) | (q[7] << 24);
                        *(u32x2*)(rowp + bj * 128) = w; } }
        }
    }
};

struct EpiMerge {
    static constexpr bool PERM = true;
    bf16_t* MG; const unsigned char* G8;
    __device__ __forceinline__ void operator()(const f32x4 (&acc)[2][2][4][2], const pg8::Unit& u, int wr, int wc, int fr, int fq) const {
        asm volatile("" : "+v"(fr), "+v"(fq));
        const int row0 = u.pm * 256 + wr * 64 + fr, col0 = u.pn * 256 + wc * 32 + 8 * fq, z = u.z;
        const float s = 1.0f / 255.0f;
        u32x2 g[2][4][2];
#pragma unroll
        for (int ai = 0; ai < 2; ++ai)
#pragma unroll
            for (int m = 0; m < 4; ++m)
#pragma unroll
                for (int bj = 0; bj < 2; ++bj) g[ai][m][bj] = *(const u32x2*)(G8 + (size_t)(row0 + ai * 128 + m * 16) * 3072 + z * 1024 + col0 + bj * 128);
#pragma unroll
        for (int ai = 0; ai < 2; ++ai) {
            u32x4 p[4][2];
#pragma unroll
            for (int m = 0; m < 4; ++m)
#pragma unroll
                for (int bj = 0; bj < 2; ++bj) { const int row = row0 + ai * 128 + m * 16;
                    p[m][bj] = (u32x4){0u, 0u, 0u, 0u};
                    if (z > 0) p[m][bj] = *(const u32x4*)(MG + (size_t)row * 1024 + col0 + bj * 128); }
#pragma unroll
            for (int m = 0; m < 4; ++m)
#pragma unroll
                for (int bj = 0; bj < 2; ++bj) { const int row = row0 + ai * 128 + m * 16;
                    const f32x4 a0 = acc[ai][bj][m][0], a1 = acc[ai][bj][m][1]; const u32x2 gg = g[ai][m][bj]; const u32x4 pp = p[m][bj];
                    u32x4 w;
                    w.x = cvtpk(bf_lo(pp.x) + a0[0] * ((float)(gg.x & 255u) * s), bf_hi(pp.x) + a0[1] * ((float)((gg.x >> 8) & 255u) * s));
                    w.y = cvtpk(bf_lo(pp.y) + a0[2] * ((float)((gg.x >> 16) & 255u) * s), bf_hi(pp.y) + a0[3] * ((float)(gg.x >> 24) * s));
                    w.z = cvtpk(bf_lo(pp.z) + a1[0] * ((float)(gg.y & 255u) * s), bf_hi(pp.z) + a1[1] * ((float)((gg.y >> 8) & 255u) * s));
                    w.w = cvtpk(bf_lo(pp.w) + a1[2] * ((float)((gg.y >> 16) & 255u) * s), bf_hi(pp.w) + a1[3] * ((float)(gg.y >> 24) * s));
                    *(u32x4*)(MG + (size_t)row * 1024 + col0 + bj * 128) = w; }
#ifndef MERGE_NOSBAR
            SBAR();
#endif
        }
    }
};
struct MergeOrder {
    const char* Rb; const char* Wb; int G, c;
    __device__ bool next(int i, pg8::Unit& u) const {
        const int tile = (i / 3) * G + (((G & 7) == 0) ? (c & 7) * (G >> 3) + (c >> 3) : c);
        if (tile >= 512) return false;
        const int z = i % 3; u.pm = tile >> 2; u.pn = tile & 3; u.z = z;
        const char* a = Rb + (z == 0 ? R_UA : (z == 1 ? R_YB : R_CB)); const char* b = Wb + (size_t)z * DM * 512 * 2;
        u.a = a + (size_t)u.pm * 256 * 512 * 2; u.b = b + (size_t)u.pn * 256 * 512 * 2; return true;
    }
};

struct EpiWout {
    static constexpr bool PERM = false;
    const float* xin; float* xout;
    __device__ __forceinline__ void operator()(const f32x4 (&acc)[2][2][4][2], const pg8::Unit& u, int wr, int wc, int fr, int fq) const {
        asm volatile("" : "+v"(fr), "+v"(fq));
        const int row0 = u.pm * 256 + wr * 64 + fr, col0 = u.pn * 256 + wc * 32 + 4 * fq;
#ifndef WOUT_BATCH
#define WOUT_BATCH 4
#endif
        constexpr int NB = WOUT_BATCH;
#pragma unroll
        for (int ai = 0; ai < 2; ++ai)
#pragma unroll
            for (int mh = 0; mh < 4 / NB; ++mh) {
                f32x4 b[NB][2][2];
#pragma unroll
                for (int m2 = 0; m2 < NB; ++m2) { const size_t off = (size_t)(row0 + ai * 128 + (NB * mh + m2) * 16) * 1024 + col0;
#pragma unroll
                    for (int bj = 0; bj < 2; ++bj)
#pragma unroll
                        for (int n = 0; n < 2; ++n) b[m2][bj][n] = *(const f32x4*)(xin + off + bj * 128 + n * 16); }
#pragma unroll
                for (int m2 = 0; m2 < NB; ++m2) { const size_t off = (size_t)(row0 + ai * 128 + (NB * mh + m2) * 16) * 1024 + col0;
#pragma unroll
                    for (int bj = 0; bj < 2; ++bj)
#pragma unroll
                        for (int n = 0; n < 2; ++n) *(f32x4*)(xout + off + bj * 128 + n * 16) = b[m2][bj][n] + acc[ai][bj][NB * mh + m2][n]; }
                SBAR(); }
    }
};
struct EpiRouter {
    static constexpr bool PERM = false;
    float* LOG;
    __device__ __forceinline__ void operator()(const f32x4 (&acc)[2][2][4][2], const pg8::Unit& u, int wr, int wc, int fr, int fq) const {
        asm volatile("" : "+v"(fr), "+v"(fq));
        if (wc >= 2) return;
        const int row0 = u.pm * 256 + wr * 64 + fr, col0 = wc * 32 + 4 * fq;
#pragma unroll
        for (int ai = 0; ai < 2; ++ai)
#pragma unroll
            for (int m = 0; m < 4; ++m)
#pragma unroll
                for (int n = 0; n < 2; ++n) *(f32x4*)(LOG + (size_t)(row0 + ai * 128 + m * 16) * 64 + col0 + n * 16) = acc[ai][0][m][n];
    }
};
struct EpiGateUp {
    static constexpr bool PERM = true;
    bf16_t* HID;
    __device__ __forceinline__ void operator()(const f32x4 (&acc)[2][2][4][2], const pg8::Unit& u, int wr, int wc, int fr, int fq) const {
        asm volatile("" : "+v"(fr), "+v"(fq));
        const int row0 = u.pm * 256 + wr * 64 + fr, col0 = u.pn * 128 + wc * 16 + 4 * fq;
#pragma unroll
        for (int ai = 0; ai < 2; ++ai)
#pragma unroll
            for (int m = 0; m < 4; ++m) { bf16_t* rowp = HID + (size_t)(row0 + ai * 128 + m * 16) * 512 + col0;
#pragma unroll
                for (int bj = 0; bj < 2; ++bj) { const f32x4 g = acc[ai][bj][m][0], up = acc[ai][bj][m][1]; float h[4];
#pragma unroll
                    for (int j = 0; j < 4; ++j) h[j] = g[j] * fast_sigmoid(g[j]) * up[j];
                    u32x2 w; w.x = cvtpk(h[0], h[1]); w.y = cvtpk(h[2], h[3]); *(u32x2*)(rowp + bj * 64) = w; } }
    }
};
struct EpiDown {
    static constexpr bool PERM = true;
    bf16_t* CT; const float* wslot;
    __device__ __forceinline__ void operator()(const f32x4 (&acc)[2][2][4][2], const pg8::Unit& u, int wr, int wc, int fr, int fq) const {
        asm volatile("" : "+v"(fr), "+v"(fq));
        const int row0 = u.pm * 256 + wr * 64 + fr, col0 = u.pn * 256 + wc * 32 + 8 * fq;
        float wsl[2][4];
#pragma unroll
        for (int ai = 0; ai < 2; ++ai)
#pragma unroll
            for (int m = 0; m < 4; ++m) wsl[ai][m] = wslot[row0 + ai * 128 + m * 16];
#pragma unroll
        for (int ai = 0; ai < 2; ++ai)
#pragma unroll
            for (int m = 0; m < 4; ++m) { const int row = row0 + ai * 128 + m * 16; const float ws = wsl[ai][m]; bf16_t* rowp = CT + (size_t)row * 1024 + col0;
#pragma unroll
                for (int bj = 0; bj < 2; ++bj) { const f32x4 v0 = acc[ai][bj][m][0] * ws, v1 = acc[ai][bj][m][1] * ws;
                    u32x4 w; w.x = cvtpk(v0[0], v0[1]); w.y = cvtpk(v0[2], v0[3]); w.z = cvtpk(v1[0], v1[1]); w.w = cvtpk(v1[2], v1[3]);
                    *(u32x4*)(rowp + bj * 128) = w; } }
    }
};
struct MoeOrder {
    const char* A; const char* Bt; const int* tiletab; size_t a_tile_bytes, b_exp_bytes, b_tile_bytes; int G, c;
    __device__ bool next(int i, pg8::Unit& u) const {
        const int L = i * G + c; const int ntile = tiletab[0]; if (L >= ntile * 4) return false;
        const int rt = L >> 2, pn = L & 3, e = tiletab[1 + rt];
        u.pm = rt; u.pn = pn; u.z = e; u.a = A + (size_t)rt * a_tile_bytes; u.b = Bt + (size_t)e * b_exp_bytes + (size_t)pn * b_tile_bytes; return true;
    }
};
struct SrcCol { const float* p; int ld; };
struct CvtRegs { f32x4 va[8], vb[8]; };
template <class SrcFn>
__device__ __forceinline__ void cvt_load(CvtRegs& Rg, const SrcFn& src, int k0, int n0, int lane) {
    const int g = lane >> 4, c4 = 4 * (lane & 15);
    const SrcCol sc = src(n0 + c4);
#pragma unroll
    for (int i = 0; i < 8; ++i) { const int k = k0 + 8 * i + 2 * g;
        Rg.va[i] = (f32x4){0.f, 0.f, 0.f, 0.f}; Rg.vb[i] = Rg.va[i];
        if (sc.p) { Rg.va[i] = *(const f32x4*)(sc.p + (size_t)k * sc.ld); Rg.vb[i] = *(const f32x4*)(sc.p + (size_t)(k + 1) * sc.ld); } }
}
__device__ __forceinline__ void cvt_store(const CvtRegs& Rg, bf16_t* dst, int K, int k0, int n0, LAS float* scr_, int lane) {
    LAS unsigned* Tt = (LAS unsigned*)scr_;
    const int g = lane >> 4, c4 = 4 * (lane & 15);
#pragma unroll
    for (int i = 0; i < 8; ++i) {
#pragma unroll
        for (int j = 0; j < 4; ++j) Tt[(c4 + j) * 33 + 4 * i + g] = cvtpk(Rg.va[i][j], Rg.vb[i][j]); }
    LDS_WAIT(); asm volatile("" ::: "memory");
#pragma unroll
    for (int r = 0; r < 8; ++r) { const int n = (lane >> 3) + 8 * r, q = lane & 7; const LAS unsigned* t = Tt + n * 33 + 4 * q;
        u32x4 o; o.x = t[0]; o.y = t[1]; o.z = t[2]; o.w = t[3];
        *(u32x4*)(dst + (size_t)(n0 + n) * K + k0 + 8 * q) = o; }
    LDS_WAIT(); asm volatile("" ::: "memory");
}
template <class SrcFn>
__device__ __forceinline__ void cvt_item(const SrcFn& src, bf16_t* dst, int K, int k0, int n0, LAS float* scr_, int lane) {
    CvtRegs Rg; cvt_load(Rg, src, k0, n0, lane); cvt_store(Rg, dst, K, k0, n0, scr_, lane);
}
struct SrcWin { const float* w; __device__ SrcCol operator()(int n) const { const int c = colmap_proj(n); return SrcCol{c >= 0 ? w + c : nullptr, D_IN}; } };
struct SrcPlain { const float* w; int ld; __device__ SrcCol operator()(int n) const { return SrcCol{w + n, ld}; } };
struct SrcRouter { const float* wg; const float* we; __device__ SrcCol operator()(int n) const { if (n < 4) return SrcCol{wg + n, 4}; if (n < 36) return SrcCol{we + (n - 4), 32}; return SrcCol{nullptr, 1}; } };
struct SrcGateUp { const float* g; const float* u; __device__ SrcCol operator()(int n) const { const int a = n >> 3, b = n & 7; return b < 4 ? SrcCol{g + 4 * a + b, DFF} : SrcCol{u + 4 * a + (b - 4), DFF}; } };

__device__ __forceinline__ void sincos_f32(float xf, float& s, float& c) {
    const double x = (double)xf;
    const double kd = __builtin_rint(x * 0.63661977236758134308);
    double r = __builtin_fma(-kd, 1.57079632679489655800e+00, x); r = __builtin_fma(-kd, 6.12323399573676603587e-17, r);
    const double r2 = r * r;
    double sp = -2.5052108385441718775e-08; sp = sp * r2 + 2.7557319223985890653e-06; sp = sp * r2 - 1.9841269841269841270e-04; sp = sp * r2 + 8.3333333333333332177e-03; sp = sp * r2 - 1.6666666666666665741e-01;
    const double sr = r + r * r2 * sp;
    double cp = 2.0876756987868098979e-09; cp = cp * r2 - 2.7557319223985888e-07; cp = cp * r2 + 2.4801587301587301566e-05; cp = cp * r2 - 1.3888888888888889419e-03; cp = cp * r2 + 4.1666666666666664354e-02; cp = cp * r2 - 0.5;
    const double cr = 1.0 + r2 * cp;
    const int q = ((int)kd) & 3;
    const double ss = (q & 1) ? cr : sr, cc = (q & 1) ? sr : cr;
    s = (float)((q & 2) ? -ss : ss); c = (float)(((q + 1) & 2) ? -cc : cc);
}

struct RmsRow { f32x4 v[4]; u32x2 a[4], b[4]; };
__device__ __forceinline__ void rms_load(RmsRow& R_, const float* xrow, const bf16_t* c0, const bf16_t* c1, int lane) {
    const f32x4* xr = (const f32x4*)xrow + lane;
#pragma unroll
    for (int j = 0; j < 4; ++j) R_.v[j] = xr[64 * j];
    if (c0) {
#pragma unroll
        for (int j = 0; j < 4; ++j) { R_.a[j] = *((const u32x2*)c0 + lane + 64 * j); R_.b[j] = *((const u32x2*)c1 + lane + 64 * j); } }
}
__device__ __forceinline__ void rms_finish(RmsRow& R_, bool has_c, const float* g, float* xsum_out, bf16_t* hb_out, float* f_out, int lane) {
    float s = 0.f;
    if (has_c) {
#pragma unroll
        for (int j = 0; j < 4; ++j) { const u32x2 a = R_.a[j], b = R_.b[j];
            R_.v[j][0] += bf_lo(a.x) + bf_lo(b.x); R_.v[j][1] += bf_hi(a.x) + bf_hi(b.x); R_.v[j][2] += bf_lo(a.y) + bf_lo(b.y); R_.v[j][3] += bf_hi(a.y) + bf_hi(b.y); } }
#pragma unroll
    for (int j = 0; j < 4; ++j) s += (R_.v[j][0] * R_.v[j][0] + R_.v[j][1] * R_.v[j][1]) + (R_.v[j][2] * R_.v[j][2] + R_.v[j][3] * R_.v[j][3]);
    const float rstd = 1.0f / sqrtf(wave_sum(s) * (1.0f / DM) + EPS);
    if (xsum_out) {
#pragma unroll
        for (int j = 0; j < 4; ++j) *((f32x4*)xsum_out + lane + 64 * j) = R_.v[j]; }
#pragma unroll
    for (int j = 0; j < 4; ++j) { const f32x4 gg = *((const f32x4*)g + lane + 64 * j); const f32x4 o = R_.v[j] * rstd * gg;
        if (hb_out) { u32x2 w; w.x = cvtpk(o[0], o[1]); w.y = cvtpk(o[2], o[3]); *((u32x2*)hb_out + lane + 64 * j) = w; }
        if (f_out) *((f32x4*)f_out + lane + 64 * j) = o; }
}
__device__ __forceinline__ void rms_row(const float* xrow, const bf16_t* c0, const bf16_t* c1, const float* g, float* xsum_out, bf16_t* hb_out, float* f_out, int lane) {
    RmsRow R_; rms_load(R_, xrow, c0, c1, lane); rms_finish(R_, c0 != nullptr, g, xsum_out, hb_out, f_out, lane);
}

constexpr int VN_PITCH = 1040;
#define TRRD(dst, addr, off) asm volatile("ds_read_b64_tr_b16 %0, %1 offset:%2" : "=&v"(dst) : "v"(addr), "i"(off) : "memory")
__device__ __forceinline__ void gmlp_conv_item(LAS unsigned char* lds, int item, bf16_t* UA, const bf16_t* VA, bf16_t* CB, const bf16_t* CC, const bf16_t* CX,
                                               const float* ws  , const float* bs  , const float* cw  , int wid, int lane, const bool dry = false  ) {
    const int t0 = item * 128;
#ifndef GM_ABATCH
#define GM_ABATCH 4
#endif
#pragma unroll 1
    for (int p4 = 0; p4 < 16 / GM_ABATCH; ++p4) {
        u32x4 raw[GM_ABATCH];
#pragma unroll
        for (int q = 0; q < GM_ABATCH; ++q) raw[q] = *((const u32x4*)(VA + (size_t)(t0 + wid * 16 + GM_ABATCH * p4 + q) * 512) + lane);
#pragma unroll
        for (int q = 0; q < GM_ABATCH; ++q) { const int p = wid * 16 + GM_ABATCH * p4 + q;
            float x[8] = {bf_lo(raw[q].x), bf_hi(raw[q].x), bf_lo(raw[q].y), bf_hi(raw[q].y), bf_lo(raw[q].z), bf_hi(raw[q].z), bf_lo(raw[q].w), bf_hi(raw[q].w)};
            float s = 0.f;
#pragma unroll
            for (int j = 0; j < 8; ++j) s += x[j];
            const float mean = wave_sum(s) * (1.0f / 512.0f); float qq = 0.f;
#pragma unroll
            for (int j = 0; j < 8; ++j) { x[j] -= mean; qq += x[j] * x[j]; }
            const float rstd = 1.0f / sqrtf(wave_sum(qq) * (1.0f / 512.0f) + EPS);
            u32x4 o; o.x = cvtpk(x[0] * rstd, x[1] * rstd); o.y = cvtpk(x[2] * rstd, x[3] * rstd); o.z = cvtpk(x[4] * rstd, x[5] * rstd); o.w = cvtpk(x[6] * rstd, x[7] * rstd);
            *(LAS u32x4*)(lds + p * VN_PITCH + lane * 16) = o; } }
    LDS_WAIT(); __syncthreads();
    {
        const int g = wid >> 1, i16 = lane & 15, g4 = lane >> 4;
        const float* Wg = ws + (size_t)g * 128 * 128;
        const unsigned trbase = (unsigned)(uintptr_t)lds + (unsigned)((8 * g4 + ((lane >> 2) & 3)) * VN_PITCH + (64 * wid + 4 * (lane & 3)) * 2);
#pragma unroll
        for (int th = 0; th < 2; ++th) {
            f32x4 acc[4][4];
#pragma unroll
            for (int ct = 0; ct < 4; ++ct)
#pragma unroll
                for (int tt = 0; tt < 4; ++tt) acc[ct][tt] = (f32x4){0.f, 0.f, 0.f, 0.f};
#pragma unroll
            for (int ks = 0; ks < 4; ++ks) {
                if (32 * ks > 16 * (4 * th + 3) + 15) continue;
                bf16x8 vf[4];
                const unsigned trk = trbase + (unsigned)(ks * 32 * VN_PITCH);
#pragma unroll
                for (int ct = 0; ct < 4; ++ct) { s16x4 lo, hi;
                    TRRD(lo, trk, ct * 32); TRRD(hi, trk, 4 * VN_PITCH + ct * 32);
                    asm volatile("s_waitcnt lgkmcnt(0)" ::: "memory");
                    vf[ct] = (bf16x8){lo[0], lo[1], lo[2], lo[3], hi[0], hi[1], hi[2], hi[3]}; }
                SBAR();
                f32x4 w0a[4], w1a[4];
#pragma unroll
                for (int t4 = 0; t4 < 4; ++t4) { const int tt = 4 * th + t4; const int tl = 16 * tt + i16, s0 = 32 * ks + 8 * g4;
                    w0a[t4] = *(const f32x4*)(Wg + (size_t)tl * 128 + s0); w1a[t4] = *(const f32x4*)(Wg + (size_t)tl * 128 + s0 + 4); }
#pragma unroll
                for (int t4 = 0; t4 < 4; ++t4) { const int tt = 4 * th + t4;
                    if (32 * ks > 16 * tt + 15) continue;
                    const int tl = 16 * tt + i16, s0 = 32 * ks + 8 * g4;
                    const f32x4 w0 = w0a[t4], w1 = w1a[t4];
                    float wv[8] = {w0[0], w0[1], w0[2], w0[3], w1[0], w1[1], w1[2], w1[3]};
#pragma unroll
                    for (int j = 0; j < 8; ++j) wv[j] = (s0 + j <= tl) ? wv[j] : 0.f;
                    u32x4 wp; wp.x = cvtpk(wv[0], wv[1]); wp.y = cvtpk(wv[2], wv[3]); wp.z = cvtpk(wv[4], wv[5]); wp.w = cvtpk(wv[6], wv[7]);
                    const bf16x8 wf = *reinterpret_cast<const bf16x8*>(&wp);
#pragma unroll
                    for (int ct = 0; ct < 4; ++ct) acc[ct][t4] = __builtin_amdgcn_mfma_f32_16x16x32_bf16(vf[ct], wf, acc[ct][t4], 0, 0, 0);
                }
                SBAR();
            }
            u32x2 uu[4][4]; float bb[4];
#pragma unroll
            for (int t4 = 0; t4 < 4; ++t4) { const int tl = 16 * (4 * th + t4) + i16; bb[t4] = bs[g * 128 + tl];
#pragma unroll
                for (int ct = 0; ct < 4; ++ct) uu[t4][ct] = *(const u32x2*)(UA + (size_t)(t0 + tl) * 512 + 64 * wid + 16 * ct + 4 * g4); }
#pragma unroll
            for (int t4 = 0; t4 < 4; ++t4) { const int tl = 16 * (4 * th + t4) + i16; const float b = bb[t4];
#pragma unroll
                for (int ct = 0; ct < 4; ++ct) { bf16_t* up = UA + (size_t)(t0 + tl) * 512 + 64 * wid + 16 * ct + 4 * g4; const f32x4 a = acc[ct][t4]; const u32x2 u2 = uu[t4][ct];
                    u32x2 o; o.x = cvtpk(bf_lo(u2.x) * (a[0] + b), bf_hi(u2.x) * (a[1] + b)); o.y = cvtpk(bf_lo(u2.y) * (a[2] + b), bf_hi(u2.y) * (a[3] + b));
                    if (!dry) *(u32x2*)up = o; else asm volatile("" :: "v"(o.x), "v"(o.y)); } }
        }
    }
    {
        const int c8 = lane * 8;
        float w0[8], w1[8], w2[8], z1[8], z2[8];
#pragma unroll
        for (int j = 0; j < 8; ++j) { w0[j] = cw[c8 + j]; w1[j] = cw[512 + c8 + j]; w2[j] = cw[1024 + c8 + j]; z1[j] = 0.f; z2[j] = 0.f; }
        const int r0 = t0 + wid * 16, sq0 = r0 & (SEQ - 1);
#pragma unroll
        for (int back = 2; back >= 1; --back) {
            if (sq0 - back >= 0) { const u32x4 a = *((const u32x4*)(CC + (size_t)(r0 - back) * 512) + lane), b = *((const u32x4*)(CX + (size_t)(r0 - back) * 512) + lane);
                float z[8] = {bf_lo(a.x) * bf_lo(b.x), bf_hi(a.x) * bf_hi(b.x), bf_lo(a.y) * bf_lo(b.y), bf_hi(a.y) * bf_hi(b.y), bf_lo(a.z) * bf_lo(b.z), bf_hi(a.z) * bf_hi(b.z), bf_lo(a.w) * bf_lo(b.w), bf_hi(a.w) * bf_hi(b.w)};
#pragma unroll
                for (int j = 0; j < 8; ++j) { if (back == 2) z2[j] = z[j]; else z1[j] = z[j]; } } }
#ifndef GM_CBATCH
#define GM_CBATCH 2
#endif
#pragma unroll 1
        for (int r4 = 0; r4 < 16 / GM_CBATCH; ++r4) {
            u32x4 av[GM_CBATCH], bv[GM_CBATCH], cv[GM_CBATCH];
#pragma unroll
            for (int q = 0; q < GM_CBATCH; ++q) { const size_t ro = (size_t)(r0 + GM_CBATCH * r4 + q) * 512; av[q] = *((const u32x4*)(CC + ro) + lane); bv[q] = *((const u32x4*)(CX + ro) + lane); cv[q] = *((const u32x4*)(CB + ro) + lane); }
#pragma unroll
            for (int q = 0; q < GM_CBATCH; ++q) { const size_t ro = (size_t)(r0 + GM_CBATCH * r4 + q) * 512; const u32x4 a = av[q], b = bv[q], cbv = cv[q];
                float z[8] = {bf_lo(a.x) * bf_lo(b.x), bf_hi(a.x) * bf_hi(b.x), bf_lo(a.y) * bf_lo(b.y), bf_hi(a.y) * bf_hi(b.y), bf_lo(a.z) * bf_lo(b.z), bf_hi(a.z) * bf_hi(b.z), bf_lo(a.w) * bf_lo(b.w), bf_hi(a.w) * bf_hi(b.w)};
                const float cbf[8] = {bf_lo(cbv.x), bf_hi(cbv.x), bf_lo(cbv.y), bf_hi(cbv.y), bf_lo(cbv.z), bf_hi(cbv.z), bf_lo(cbv.w), bf_hi(cbv.w)};
                float y[8];
#pragma unroll
                for (int j = 0; j < 8; ++j) { y[j] = cbf[j] * (w0[j] * z2[j] + w1[j] * z1[j] + w2[j] * z[j]); z2[j] = z1[j]; z1[j] = z[j]; }
                u32x4 o; o.x = cvtpk(y[0], y[1]); o.y = cvtpk(y[2], y[3]); o.z = cvtpk(y[4], y[5]); o.w = cvtpk(y[6], y[7]);
                if (!dry) *((u32x4*)(CB + ro) + lane) = o; else asm volatile("" :: "v"(o.x), "v"(o.y), "v"(o.z), "v"(o.w)); } }
    }
    __syncthreads();
}
typedef unsigned short u16x2 __attribute__((ext_vector_type(2)));
__device__ __forceinline__ unsigned key15(float sc) { float f = (sc + 8.0f) * 1024.0f + 0.5f; f = fminf(fmaxf(f, 1.0f), 32767.0f); return (unsigned)f; }
__device__ __forceinline__ unsigned long long lowest_k_bits(unsigned long long e, unsigned k) {
    unsigned long long r = 0ull;
    for (unsigned i = 0; i < k; ++i) { const unsigned long long bb = e & (0ull - e); r |= bb; e ^= bb; }
    return r;
}

__device__ __forceinline__ void select_row(const unsigned char* rowp, int ntile128, int t_seq, unsigned long long* mrow, int ntile_out, int lane, LAS unsigned long long* wl  ) {
    const int n = t_seq + 1;
    if (n <= 256) {
        const int T = lane;
        if (T < ntile_out) { const int lo = 64 * T; unsigned long long w;
            if (lo + 63 <= t_seq) w = ~0ull; else if (lo > t_seq) w = 0ull; else w = (1ull << (t_seq - lo + 1)) - 1ull;
            mrow[(size_t)T * 256] = w; }
        for (int T2 = 64 + lane; T2 < ntile_out; T2 += 64) mrow[(size_t)T2 * 256] = 0ull;
        return;
    }
    unsigned kq[4][32];
    const unsigned* rp = (const unsigned*)rowp + lane;
    const int nq = (ntile128 + 31) >> 5;
#pragma unroll
    for (int q = 0; q < 4; ++q) {
        if (q < nq) {
            const unsigned* rq = rp + 64 * (32 * q + 16); asm volatile("" : "+v"(rq));
#pragma unroll
            for (int m = 0; m < 32; ++m) kq[q][m] = rq[64 * (m - 16)];
        } else {
#pragma unroll
            for (int m = 0; m < 32; ++m) kq[q][m] = 0u;
        }
    }
#define COUNT_GE(cand, out) do { const unsigned Kc_ = (0x8000u - (cand)) * 0x10001u; const u16x2 Kv_ = __builtin_bit_cast(u16x2, Kc_); u16x2 a_ = (u16x2){0, 0}; \
        _Pragma("unroll") for (int q = 0; q < 4; ++q) { if (q < nq) { _Pragma("unroll") for (int m = 0; m < 32; ++m) { u16x2 t_ = __builtin_bit_cast(u16x2, kq[q][m]) + Kv_; t_ = t_ >> 15; a_ += t_; } } } \
        out = wave_sum_u((unsigned)a_.x + (unsigned)a_.y); } while (0)
    unsigned prefix = 0u;
    for (int bit = 14; bit >= 0; --bit) { const unsigned cand = prefix | (1u << bit); unsigned c; COUNT_GE(cand, c); if (c >= 256u) prefix = cand; }
    const unsigned tau = prefix;
    unsigned c_ge, c_gt; COUNT_GE(tau, c_ge); COUNT_GE(tau + 1u, c_gt);
#undef COUNT_GE
    unsigned rem = 256u - c_gt;
#pragma unroll
    for (int q = 0; q < 4; ++q) {
        if (q < nq) {
#pragma unroll
            for (int m = 0; m < 32; ++m) {
#pragma unroll
                for (int h = 0; h < 2; ++h) { const unsigned kv = h ? (kq[q][m] >> 16) : (kq[q][m] & 0xffffu);
                    const unsigned long long gt = __ballot(kv > tau); unsigned long long e = __ballot(kv == tau);
                    const unsigned pe = (unsigned)__popcll(e);
                    if (pe <= rem) rem -= pe; else { e = lowest_k_bits(e, rem); rem = 0u; }
                    const unsigned long long w = gt | e;
                    wl[64 * q + 2 * m + h] = w; SBAR(); }
            }
        } else {
            wl[64 * q + lane] = 0ull;
        }
    }
    LDS_WAIT();
#pragma unroll
    for (int g = 0; g < 4; ++g) { const int T = 64 * g + lane; if (T < ntile_out) mrow[(size_t)T * 256] = wl[T]; }
    LDS_WAIT();
}

__device__ __forceinline__ void indexer_item(LAS unsigned char* lds, unsigned char* scr, int b, int qt, const bf16_t* QI, const bf16_t* KI, const float* WI, unsigned long long* MASK, int wid, int lane) {
    asm volatile("" : "+v"(lane));
    const int s0 = qt * 16, t0 = b * SEQ + s0, i16 = lane & 15, g4 = lane >> 4;
    const int nk128 = (s0 + 16 + 127) & ~127, nsteps = nk128 >> 7;
    {
        bf16x8 bq[4][2];
#pragma unroll
        for (int hh = 0; hh < 4; ++hh)
#pragma unroll
            for (int kk = 0; kk < 2; ++kk) bq[hh][kk] = *(const bf16x8*)(QI + (size_t)(t0 + i16) * 256 + hh * 64 + kk * 32 + 8 * g4);
        const f32x4 w = *(const f32x4*)(WI + (size_t)(t0 + i16) * 4);
        const int qpos = s0 + i16;
        const int nsteps_pad = (nsteps + 31) & ~31;
        for (int st = wid; st < nsteps_pad; st += 8) {
            if (st >= nsteps) {
#pragma unroll
                for (int jp = 0; jp < 4; ++jp) *(u32x4*)(scr + (size_t)i16 * 32768 + (size_t)(64 * st + 16 * jp + 4 * g4) * 4) = (u32x4){0u, 0u, 0u, 0u};
                continue; }
#pragma unroll
            for (int jp = 0; jp < 4; ++jp) {
                unsigned kk2[2][4];
#pragma unroll
                for (int par = 0; par < 2; ++par) { const int keybase = 128 * st + 64 * par + 16 * jp;
                    const bf16x8 a0 = *(const bf16x8*)(KI + ki_chunk(b, keybase + i16, g4)), a1 = *(const bf16x8*)(KI + ki_chunk(b, keybase + i16, 4 + g4));
                    float sc[4] = {0.f, 0.f, 0.f, 0.f};
#pragma unroll
                    for (int hh = 0; hh < 4; ++hh) { f32x4 d = {0.f, 0.f, 0.f, 0.f};
                        d = __builtin_amdgcn_mfma_f32_16x16x32_bf16(a0, bq[hh][0], d, 0, 0, 0); d = __builtin_amdgcn_mfma_f32_16x16x32_bf16(a1, bq[hh][1], d, 0, 0, 0);
#pragma unroll
                        for (int r = 0; r < 4; ++r) sc[r] = fmaf(relu_f(d[r]), w[hh], sc[r]); }
#pragma unroll
                    for (int r = 0; r < 4; ++r) { const int kidx = keybase + 4 * g4 + r; kk2[par][r] = (kidx <= qpos) ? key15(sc[r]) : 0u; } }
                u32x4 o; o.x = kk2[0][0] | (kk2[1][0] << 16); o.y = kk2[0][1] | (kk2[1][1] << 16); o.z = kk2[0][2] | (kk2[1][2] << 16); o.w = kk2[0][3] | (kk2[1][3] << 16);
                *(u32x4*)(scr + (size_t)i16 * 32768 + (size_t)(64 * st + 16 * jp + 4 * g4) * 4) = o;
            }
        }
    }
    VM_WAIT(); __syncthreads();
    __builtin_amdgcn_fence(__ATOMIC_ACQUIRE, "agent");
    VM_WAIT();
    const int qblk = s0 >> 8, ntile_out = ((s0 & ~255) + 256) >> 6;
#pragma unroll 1
    for (int rr = 0; rr < 2; ++rr) { const int i = wid * 2 + rr, tq = s0 + i;
        unsigned long long* mrow = MASK + ((size_t)(b * 64 + qblk) * 256 * 256 + (size_t)(tq & 255));
        select_row(scr + (size_t)i * 32768, nk128 >> 7, tq, mrow, ntile_out, lane, (LAS unsigned long long*)(lds + wid * 2048)); }
    VM_WAIT(); __syncthreads();
}
#ifndef IX_CAP_N
#define IX_CAP_N 1472
#endif
constexpr int IX_CAP = IX_CAP_N, IX_B = 59;
constexpr int IX_GCAP = 8192;
#ifndef IX_REP
#define IX_REP 0
#endif
#ifndef IX_SKIP
#define IX_SKIP 0
#endif
#ifdef IX_STAMP
#define IXT(k) do { if (tid == 0) { const unsigned long long t_ = __builtin_amdgcn_s_memrealtime(); ((LAS unsigned*)(lds + IXL_ROW))[96 + (k)] += (unsigned)(t_ - t_prev); t_prev = t_; } } while (0)
#else
#define IXT(k) do {} while (0)
#endif
constexpr int IXL_SK = 0, IXL_MI = 16 * IX_CAP * 4, IXL_ROW = IXL_MI + 32768, IXL_STG = IXL_ROW + 512;
static_assert(IXL_SK + 16 * 2048 * 2 <= IXL_MI && IXL_STG + 8 * 4096 <= MISC_OFF, "indexer LDS map");
constexpr float KMAGIC = 8388608.0f;
__device__ __forceinline__ float key15f(float sc) { return __builtin_amdgcn_fmed3f(fmaf(sc, 1024.0f, KMAGIC + 8192.0f), KMAGIC + 1.0f, KMAGIC + 32767.0f); }

template <int NR>
__device__ __forceinline__ unsigned kth_largest15(const unsigned (&kr)[NR], unsigned rank) {
    unsigned prefix = 0u;
    for (int bit = 14; bit >= 0; --bit) { const unsigned cand = prefix | (1u << bit);
        const unsigned Kc = (0x8000u - cand) * 0x10001u; const u16x2 Kv = __builtin_bit_cast(u16x2, Kc); u16x2 a = (u16x2){0, 0};
#pragma unroll
        for (int r = 0; r < NR; ++r) { u16x2 t = __builtin_bit_cast(u16x2, kr[r]) + Kv; t = t >> 15; a += t; }
        const unsigned c = wave_sum_u((unsigned)a.x + (unsigned)a.y);
        if (c >= rank) prefix = cand; }
    return prefix;
}

__device__ __forceinline__ bool indexer_item_fast(LAS unsigned char* lds, int b, int qt, const bf16_t* QI, const bf16_t* KI, const float* WI, unsigned long long* MASK, int wid, int lane_, int tid, unsigned* probe_ctr, unsigned* clg  ) {
    (void)probe_ctr;
    asm volatile("" : "+v"(tid));
    const int lane = tid & 63; (void)lane_;
    const int s0 = qt * 16, t0 = b * SEQ + s0, i16 = lane & 15, g4 = lane >> 4;
    const int nk128 = (s0 + 16 + 127) & ~127, nsteps = nk128 >> 7;
    LAS unsigned short* SK = (LAS unsigned short*)(lds + IXL_SK); LAS unsigned* CL = (LAS unsigned*)(lds + IXL_SK);
    LAS unsigned* MI = (LAS unsigned*)(lds + IXL_MI);
    LAS float* U1F = (LAS float*)(lds + IXL_ROW); LAS float* LF = U1F + 16; LAS unsigned* NCAND = (LAS unsigned*)(LF + 16); LAS unsigned* FAIL = NCAND + 32;
#ifdef IX_STAMP
    unsigned long long t_prev = __builtin_amdgcn_s_memrealtime();
#endif
#pragma unroll
    for (int k = 0; k < 4; ++k) *(LAS u32x4*)(lds + IXL_MI + (tid + 512 * k) * 16) = (u32x4){0u, 0u, 0u, 0u};
    if (tid < 80) ((LAS unsigned*)(lds + IXL_ROW))[tid] = 0u;
    bf16x8 bq[4][2];
#pragma unroll
    for (int hh = 0; hh < 4; ++hh)
#pragma unroll
        for (int kk = 0; kk < 2; ++kk) bq[hh][kk] = *(const bf16x8*)(QI + (size_t)(t0 + i16) * 256 + hh * 64 + kk * 32 + 8 * g4);
    const f32x4 w = *(const f32x4*)(WI + (size_t)(t0 + i16) * 4);
    const int qpos = s0 + i16;
    const int m = nk128 >> 3;
    for (int repA = 0; repA < ((IX_REP & 1) ? 2 : 1); ++repA) {
#define IX_ALOAD(A0, A1, tau_) do { A0 = *(const bf16x8*)(KI + ki_chunk(b, 8 * (16 * (tau_) + i16), g4)); A1 = *(const bf16x8*)(KI + ki_chunk(b, 8 * (16 * (tau_) + i16), 4 + g4)); } while (0)
#define IX_ATILE(A0, A1, tau_) do { float sc[4] = {0.f, 0.f, 0.f, 0.f}; \
            _Pragma("unroll") for (int hh = 0; hh < 4; ++hh) { f32x4 d = {0.f, 0.f, 0.f, 0.f}; \
                d = __builtin_amdgcn_mfma_f32_16x16x32_bf16(A0, bq[hh][0], d, 0, 0, 0); d = __builtin_amdgcn_mfma_f32_16x16x32_bf16(A1, bq[hh][1], d, 0, 0, 0); \
                _Pragma("unroll") for (int r = 0; r < 4; ++r) sc[r] = fmaf(relu_f(d[r]), w[hh], sc[r]); } \
            unsigned k4[4]; \
            _Pragma("unroll") for (int r = 0; r < 4; ++r) { const int ks = 8 * (16 * (tau_) + 4 * g4 + r); k4[r] = (ks <= qpos) ? (__float_as_uint(key15f(sc[r])) & 0xffffu) : 0u; } \
            u32x2 o; o.x = k4[0] | (k4[1] << 16); o.y = k4[2] | (k4[3] << 16); \
            *(LAS u32x2*)(lds + IXL_SK + ((size_t)i16 * 2048 + 16 * (tau_) + 4 * g4) * 2) = o; } while (0)
        const int ntau = m >> 4;
        for (int tau = wid; tau < ntau; tau += 16) {
            bf16x8 a0, a1, c0, c1; const bool two = tau + 8 < ntau;
            IX_ALOAD(a0, a1, tau); if (two) IX_ALOAD(c0, c1, tau + 8);
            IX_ATILE(a0, a1, tau); if (two) IX_ATILE(c0, c1, tau + 8); }
#undef IX_ATILE
#undef IX_ALOAD
    }
    LDS_WAIT(); __syncthreads(); IXT(0);
    for (int repK = 0; repK < ((IX_REP & 2) ? 2 : 1); ++repK) {
        const int nd = m >> 1;
        unsigned pb0 = 0u, pb1 = 0u;
#define IX_BRACKET(NR) do { \
        unsigned kr0[NR], kr1[NR]; \
        { const LAS unsigned* sp0 = (const LAS unsigned*)(lds + IXL_SK + (size_t)(wid * 2) * 4096) + lane; const LAS unsigned* sp1 = sp0 + 1024; \
            _Pragma("unroll") for (int r = 0; r < NR; ++r) { const unsigned v0 = sp0[64 * r], v1 = sp1[64 * r]; const bool in = (64 * r + lane < nd); kr0[r] = in ? v0 : 0u; kr1[r] = in ? v1 : 0u; } } \
        for (int bit = 14; bit >= 0; --bit) { \
            const unsigned cb0 = pb0 | (1u << bit), cb1 = pb1 | (1u << bit); \
            const u16x2 Kb0 = __builtin_bit_cast(u16x2, (0x8000u - cb0) * 0x10001u), Kb1 = __builtin_bit_cast(u16x2, (0x8000u - cb1) * 0x10001u); \
            u16x2 ab0 = (u16x2){0, 0}, ab1 = ab0; \
            _Pragma("unroll") for (int r = 0; r < NR; ++r) { const u16x2 x0 = __builtin_bit_cast(u16x2, kr0[r]), x1 = __builtin_bit_cast(u16x2, kr1[r]); \
                ab0 += (x0 + Kb0) >> 15; ab1 += (x1 + Kb1) >> 15; } \
            const unsigned s01 = ((unsigned)ab0.x + (unsigned)ab0.y) | (((unsigned)ab1.x + (unsigned)ab1.y) << 16); \
            const unsigned t01 = wave_sum_u(s01);                            \
            if ((t01 & 0xffffu) >= (unsigned)IX_B) pb0 = cb0; if ((t01 >> 16) >= (unsigned)IX_B) pb1 = cb1; } } while (0)
        if (nd <= 512) IX_BRACKET(8); else IX_BRACKET(16);
#undef IX_BRACKET
        if (lane == 0) { LF[wid * 2] = KMAGIC + (float)(pb0 > 0u ? pb0 : 1u); LF[wid * 2 + 1] = KMAGIC + (float)(pb1 > 0u ? pb1 : 1u); }
    }
    LDS_WAIT(); __syncthreads(); IXT(1);
    for (int repB = 0; repB < ((IX_REP & 4) ? 2 : 1); ++repB) {
        if (repB) { __syncthreads(); if (tid < 32) NCAND[tid] = 0u; __syncthreads(); }
        const float lf = LF[i16];
        const bf16_t* kbase = KI + (size_t)b * 128 * 8192 + (size_t)lane * 8;
        LAS unsigned char* stg_ = lds + IXL_STG + wid * 4096 + lane * 16;
        bf16x8 fa0[8], fa1[8], fb0[8], fb1[8];
#define IX_LOADSTEP(A0, A1, st_) do { const bf16_t* kp_ = kbase + (size_t)(st_) * 8192; _Pragma("unroll") for (int j = 0; j < 8; ++j) { A0[j] = *(const bf16x8*)(kp_ + j * 1024); A1[j] = *(const bf16x8*)(kp_ + j * 1024 + 512); } } while (0)
#define IX_STEP(A0, A1, N0, N1, st_) do { \
            if ((st_) + 8 < nsteps) IX_LOADSTEP(N0, N1, (st_) + 8);                           \
            float fv[32]; unsigned nge = 0u;                                                 \
            for (int rep2_ = 0; rep2_ < ((IX_REP & 32) ? 2 : 1); ++rep2_) { if (rep2_) { asm volatile("" :: "v"(nge)); nge = 0u; } \
            _Pragma("unroll") for (int j = 0; j < 8; ++j) { \
                float sc[4] = {0.f, 0.f, 0.f, 0.f}; \
                _Pragma("unroll") for (int hh = 0; hh < 4; ++hh) { f32x4 d = {0.f, 0.f, 0.f, 0.f}; \
                    d = __builtin_amdgcn_mfma_f32_16x16x32_bf16(A0[j], bq[hh][0], d, 0, 0, 0); d = __builtin_amdgcn_mfma_f32_16x16x32_bf16(A1[j], bq[hh][1], d, 0, 0, 0); \
                    _Pragma("unroll") for (int r = 0; r < 4; ++r) sc[r] = fmaf(relu_f(d[r]), w[hh], sc[r]); } \
                _Pragma("unroll") for (int r = 0; r < 4; ++r) { float f = key15f(sc[r]); \
                    fv[4 * j + r] = f; \
                    nge = __builtin_amdgcn_alignbit(nge, __float_as_uint(f - lf), 31); } } } \
            const int lim_ = qpos - (128 * (st_) + 32 * g4);                                \
            const unsigned cmask_ = lim_ >= 31 ? 0xffffffffu : (lim_ < 0 ? 0u : ((2u << lim_) - 1u)); \
            unsigned cm = ~__brev(nge) & cmask_;                                             \
            if (!(IX_SKIP & 32) && __any(cm != 0u)) { \
                  \
                _Pragma("unroll") for (int q = 0; q < 4; ++q) { u32x4 pk_; \
                    pk_.x = __builtin_amdgcn_perm(__float_as_uint(fv[8 * q + 1]), __float_as_uint(fv[8 * q + 0]), 0x05040100u); pk_.y = __builtin_amdgcn_perm(__float_as_uint(fv[8 * q + 3]), __float_as_uint(fv[8 * q + 2]), 0x05040100u); \
                    pk_.z = __builtin_amdgcn_perm(__float_as_uint(fv[8 * q + 5]), __float_as_uint(fv[8 * q + 4]), 0x05040100u); pk_.w = __builtin_amdgcn_perm(__float_as_uint(fv[8 * q + 7]), __float_as_uint(fv[8 * q + 6]), 0x05040100u); \
                    *(LAS u32x4*)(stg_ + q * 1024) = pk_; } \
                unsigned pos = 0u; \
                if (cm) pos = __hip_atomic_fetch_add(&NCAND[i16], (unsigned)__popc(cm), __ATOMIC_RELAXED, __HIP_MEMORY_SCOPE_WORKGROUP); \
                const unsigned idxb = 16383u - (unsigned)(128 * (st_) + 32 * g4); \
                while (__any(cm != 0u)) {                                                     \
                    const unsigned p = cm ? (unsigned)__builtin_ctz(cm) : 0u; \
                    const unsigned k_ = *(const LAS unsigned short*)(stg_ + ((p & 24u) << 7) + ((p & 7u) << 1)); \
                    if (cm) { const unsigned comp_ = (k_ << 14) | (idxb - p); \
                        if (pos < (unsigned)IX_CAP) CL[i16 * IX_CAP + pos] = comp_; else if (pos < (unsigned)(IX_CAP + IX_GCAP)) __hip_atomic_store(clg + i16 * IX_GCAP + (pos - IX_CAP), comp_, __ATOMIC_RELAXED, __HIP_MEMORY_SCOPE_AGENT); \
                        ++pos; cm &= cm - 1u; } } } \
        } while (0)
#if (IX_SKIP & 4)
        for (int st = wid; st < nsteps; st += 8) MI[i16 * 512 + 4 * st + g4] = (st == 0 && g4 == 0) ? 1u : 0u;
        (void)lf; (void)kbase; (void)fa0; (void)fa1; (void)fb0; (void)fb1;
#else
        if (wid < nsteps) IX_LOADSTEP(fa0, fa1, wid);
        for (int st = wid; st < nsteps; st += 16) {
            IX_STEP(fa0, fa1, fb0, fb1, st);
            if (st + 8 < nsteps) IX_STEP(fb0, fb1, fa0, fa1, st + 8);
        }
#endif
#undef IX_STEP
#undef IX_LOADSTEP
    }
    VM_WAIT(); LDS_WAIT(); __syncthreads(); IXT(2);
    for (int repC = 0; repC < ((IX_SKIP & (8 | 32)) ? 0 : 1); ++repC) {
        constexpr int NCR = IX_CAP / 64;
        const int row0 = wid * 2, row1 = row0 + 1;
        const unsigned nc0 = NCAND[row0], ca0 = 0u, nc1 = NCAND[row1], ca1 = 0u;
        const bool ok0 = (nc0 <= (unsigned)(IX_CAP + IX_GCAP)) && (ca0 <= 256u) && (ca0 + nc0 >= 256u), ok1 = (nc1 <= (unsigned)(IX_CAP + IX_GCAP)) && (ca1 <= 256u) && (ca1 + nc1 >= 256u);
        if (!(ok0 && ok1)) { if (lane == 0) { FAIL[0] = 1u;
#ifdef IX_PROBE_TYPE
            unsigned cnt_ = 0u; if (IX_PROBE_TYPE == 1) cnt_ = (nc0 > (unsigned)IX_CAP) + (nc1 > (unsigned)IX_CAP); if (IX_PROBE_TYPE == 2) cnt_ = (ca0 > 256u) + (ca1 > 256u); if (IX_PROBE_TYPE == 3) cnt_ = (ca0 + nc0 < 256u) + (ca1 + nc1 < 256u);
            if (cnt_) atomicAdd(probe_ctr, cnt_);
#endif
            } }
        else {
            const unsigned need0 = 256u - ca0, need1 = 256u - ca1;
            const unsigned nl0 = nc0 < (unsigned)IX_CAP ? nc0 : (unsigned)IX_CAP, nl1 = nc1 < (unsigned)IX_CAP ? nc1 : (unsigned)IX_CAP;
            unsigned c0[NCR], c1[NCR]; const LAS unsigned* cp0 = CL + row0 * IX_CAP + lane; const LAS unsigned* cp1 = CL + row1 * IX_CAP + lane;
#pragma unroll
            for (int r = 0; r < NCR; ++r) { const unsigned v0 = cp0[64 * r], v1 = cp1[64 * r]; c0[r] = (64 * r + lane < (int)nl0) ? v0 : 0u; c1[r] = (64 * r + lane < (int)nl1) ? v1 : 0u; }
            unsigned p0 = 0u, p1 = 0u;
            const unsigned nlm = nl0 > nl1 ? nl0 : nl1;
#define IX_CSEARCH(NRC) do { for (int bit = 28; bit >= 0; --bit) { const unsigned d0 = p0 | (1u << bit), d1 = p1 | (1u << bit); unsigned n0 = 0u, n1 = 0u; \
                _Pragma("unroll") for (int r = 0; r < NRC; ++r) { n0 += (c0[r] >= d0) ? 1u : 0u; n1 += (c1[r] >= d1) ? 1u : 0u; } \
                const unsigned t = wave_sum_u(n0 | (n1 << 16));                   \
                if ((t & 0xffffu) >= need0 && need0 > 0u) p0 = d0; if ((t >> 16) >= need1 && need1 > 0u) p1 = d1; } } while (0)
            if (nlm <= 512u) IX_CSEARCH(8); else if (nlm <= 640u) IX_CSEARCH(10); else if (nlm <= 1024u) IX_CSEARCH(16); else IX_CSEARCH(NCR);
#undef IX_CSEARCH
#define IX_OVERFLOW_ROW(CX, PX, NCX, NEEDX, ROWX) do { if ((NCX) > (unsigned)IX_CAP && (NEEDX) > 0u) { \
                unsigned g0 = 0u, g1 = 0u, g2 = 0u, g3 = 0u, ng = 0u; \
                for (unsigned i = lane; i < (NCX) - (unsigned)IX_CAP; i += 256) { unsigned v4[4]; \
                    _Pragma("unroll") for (int u = 0; u < 4; ++u) v4[u] = (i + 64 * u < (NCX) - (unsigned)IX_CAP) ? __hip_atomic_load(clg + (ROWX) * IX_GCAP + i + 64 * u, __ATOMIC_RELAXED, __HIP_MEMORY_SCOPE_AGENT) : 0u; \
                    _Pragma("unroll") for (int u = 0; u < 4; ++u) if (v4[u] >= (PX) && v4[u] != 0u) { g3 = g2; g2 = g1; g1 = g0; g0 = v4[u]; ++ng; } } \
                if (__any(ng > 4u)) { if (lane == 0) FAIL[0] = 1u; } \
                else if (__any(ng > 0u)) { unsigned px = 0u; \
                    for (int bit = 28; bit >= 0; --bit) { const unsigned dx = px | (1u << bit); unsigned nx = (g0 >= dx ? 1u : 0u) + (g1 >= dx ? 1u : 0u) + (g2 >= dx ? 1u : 0u) + (g3 >= dx ? 1u : 0u); \
                        _Pragma("unroll") for (int r = 0; r < NCR; ++r) nx += (CX[r] >= dx) ? 1u : 0u; \
                        nx = wave_sum_u(nx); if (nx >= (NEEDX)) px = dx; } \
                    PX = px; \
                    if (g0 >= px && g0) { const unsigned idx = 16383u - (g0 & 16383u); __hip_atomic_fetch_or(&MI[(ROWX) * 512 + (idx >> 5)], 1u << (idx & 31u), __ATOMIC_RELAXED, __HIP_MEMORY_SCOPE_WORKGROUP); } \
                    if (g1 >= px && g1) { const unsigned idx = 16383u - (g1 & 16383u); __hip_atomic_fetch_or(&MI[(ROWX) * 512 + (idx >> 5)], 1u << (idx & 31u), __ATOMIC_RELAXED, __HIP_MEMORY_SCOPE_WORKGROUP); } \
                    if (g2 >= px && g2) { const unsigned idx = 16383u - (g2 & 16383u); __hip_atomic_fetch_or(&MI[(ROWX) * 512 + (idx >> 5)], 1u << (idx & 31u), __ATOMIC_RELAXED, __HIP_MEMORY_SCOPE_WORKGROUP); } \
                    if (g3 >= px && g3) { const unsigned idx = 16383u - (g3 & 16383u); __hip_atomic_fetch_or(&MI[(ROWX) * 512 + (idx >> 5)], 1u << (idx & 31u), __ATOMIC_RELAXED, __HIP_MEMORY_SCOPE_WORKGROUP); } } } } while (0)
            IX_OVERFLOW_ROW(c0, p0, nc0, need0, row0);
            IX_OVERFLOW_ROW(c1, p1, nc1, need1, row1);
#undef IX_OVERFLOW_ROW
#pragma unroll
            for (int r = 0; r < NCR; ++r) { if (64u * (unsigned)r >= nlm) break;
                if (need0 > 0u && c0[r] >= p0 && c0[r] != 0u) { const unsigned idx = 16383u - (c0[r] & 16383u); __hip_atomic_fetch_or(&MI[row0 * 512 + (idx >> 5)], 1u << (idx & 31u), __ATOMIC_RELAXED, __HIP_MEMORY_SCOPE_WORKGROUP); }
                if (need1 > 0u && c1[r] >= p1 && c1[r] != 0u) { const unsigned idx = 16383u - (c1[r] & 16383u); __hip_atomic_fetch_or(&MI[row1 * 512 + (idx >> 5)], 1u << (idx & 31u), __ATOMIC_RELAXED, __HIP_MEMORY_SCOPE_WORKGROUP); } }
        }
    }
    LDS_WAIT(); __syncthreads(); IXT(3);
    const bool good = (FAIL[0] == 0u) || (IX_SKIP != 0);
    if (good) { const int qblk = s0 >> 8, ntile_out = ((s0 & ~255) + 256) >> 6;
        unsigned long long* mb = MASK + ((size_t)(b * 64 + qblk) * 256 * 256 + (size_t)(s0 & 255));
        for (int idx = tid; idx < 16 * ntile_out; idx += NTHREADS) { const int row = idx & 15, Tt = idx >> 4;
            const u32x2 wv = *(const LAS u32x2*)(MI + row * 512 + 2 * Tt);
            mb[(size_t)Tt * 256 + row] = ((unsigned long long)wv.y << 32) | wv.x; } }
    __syncthreads(); IXT(4);
    return good;
}
namespace att {
constexpr int QBLK = 32, KVBLK = 64, QB = 256, HD = 128, LDQ = 512;
constexpr int SHM_V = KVBLK * HD * 2, SHM_K = KVBLK * HD * 2;
constexpr int LDS_NEED = 2 * SHM_V + 2 * SHM_K + NWAVES * 64 * 4;
constexpr float SCALE = 0.08838834764831845f;
constexpr float THR = 8.f;
#define KSWZ(row, colB) ((row) * 256 + ((colB) ^ (((row) & 7) << 4)))
__device__ __forceinline__ int v_st(int k, int c) { const int kk = (k & ~0xC) | ((k & 4) << 1) | ((k & 8) >> 1); return ((kk >> 3) * 4 + (c >> 5)) * 512 + ((kk & 7) * 32 + (c & 31)) * 2; }
__device__ __forceinline__ int v_rd_base(int lane) { return ((lane & 3) << 3) | (((lane >> 2) & 3) << 6) | (((lane >> 4) & 1) << 5) | (((lane >> 5) & 1) << 8); }
constexpr int v_rd_off(int d0, int ks, int half) { return d0 * 512 + ks * 4096 + half * 2048; }
__device__ __forceinline__ int crow(int r, int hi) { return (r & 3) + 8 * (r >> 2) + 4 * hi; }

__device__ __forceinline__ void partialSM(f32x16& p0, f32x16& p1, float& m_reg, float& mn, float& alpha) {
    float pmax = p0[0];
#pragma unroll
    for (int r = 1; r < 16; ++r) pmax = fmaxf(pmax, p0[r]);
#pragma unroll
    for (int r = 0; r < 16; ++r) pmax = fmaxf(pmax, p1[r]);
    { auto rr = __builtin_amdgcn_permlane32_swap(__float_as_uint(pmax), __float_as_uint(pmax), false, false);
      pmax = fmaxf(__uint_as_float(rr[0]), __uint_as_float(rr[1])); }
    constexpr float C2 = 1.4426950408889634f * SCALE;
    if (__builtin_expect(__all((pmax - m_reg) * SCALE <= THR), 1)) { mn = m_reg; alpha = 1.f; }
    else { mn = fmaxf(m_reg, pmax); alpha = __builtin_amdgcn_exp2f((m_reg - mn) * C2); m_reg = mn; }
    const float mnL = -mn * C2;
#pragma unroll
    for (int r = 0; r < 16; ++r) p0[r] = fmaf(p0[r], C2, mnL);
#pragma unroll
    for (int r = 0; r < 16; ++r) p1[r] = fmaf(p1[r], C2, mnL);
#pragma unroll
    for (int r = 0; r < 16; ++r) p0[r] = __builtin_amdgcn_exp2f(p0[r]);
}
__device__ __forceinline__ void finishSM(f32x16& p0, f32x16& p1, float alpha, float& l_reg, bf16x8& pa0, bf16x8& pa1, bf16x8& pa2, bf16x8& pa3) {
#pragma unroll
    for (int r = 0; r < 16; ++r) p1[r] = __builtin_amdgcn_exp2f(p1[r]);
    float ps = 0;
#pragma unroll
    for (int r = 0; r < 16; ++r) ps += p0[r];
#pragma unroll
    for (int r = 0; r < 16; ++r) ps += p1[r];
    { auto rr = __builtin_amdgcn_permlane32_swap(__float_as_uint(ps), __float_as_uint(ps), false, false);
      ps = __uint_as_float(rr[0]) + __uint_as_float(rr[1]); }
    l_reg = l_reg * alpha + ps;
#define PK4(P, B_, OUT) do { unsigned a0 = cvtpk(P[B_+0], P[B_+1]), a1 = cvtpk(P[B_+2], P[B_+3]);                          \
        unsigned b0 = cvtpk(P[B_+4], P[B_+5]), b1 = cvtpk(P[B_+6], P[B_+7]);                                             \
        auto r0 = __builtin_amdgcn_permlane32_swap(a0, b0, false, false); auto r1 = __builtin_amdgcn_permlane32_swap(a1, b1, false, false); \
        u32x4 w = {r0[0], r1[0], r0[1], r1[1]}; OUT = *reinterpret_cast<bf16x8*>(&w); } while (0)
    PK4(p0, 0, pa0); PK4(p0, 8, pa1); PK4(p1, 0, pa2); PK4(p1, 8, pa3);
#undef PK4
}
template <int KB>
__device__ __forceinline__ void qkt(f32x16& p0, f32x16& p1, const LAS char* K_lds, int r32, int hi, const bf16x8* qr) {
    const LAS char* kb[4];
#pragma unroll
    for (int dd = 0; dd < 4; ++dd) kb[dd] = K_lds + KB * SHM_K + KSWZ(r32, (dd * 16 + hi * 8) * 2);
#pragma unroll
    for (int d0 = 0; d0 < 8; ++d0) { const LAS char* a = kb[d0 & 3] + (d0 >> 2) * 128;
        bf16x8 b0 = *reinterpret_cast<const LAS bf16x8*>(a);
        bf16x8 b1 = *reinterpret_cast<const LAS bf16x8*>(a + 32 * 256);
        p0 = __builtin_amdgcn_mfma_f32_32x32x16_bf16(b0, qr[d0], p0, 0, 0, 0);
        p1 = __builtin_amdgcn_mfma_f32_32x32x16_bf16(b1, qr[d0], p1, 0, 0, 0); }
}
template <int VB>
__device__ __forceinline__ void pv_tile(f32x16* o, int vb0, bf16x8 pa0, bf16x8 pa1, bf16x8 pa2, bf16x8 pa3) {
#define TRRD2(dst, off) asm volatile("ds_read_b64_tr_b16 %0, %1 offset:%2" : "=&v"(dst) : "v"(vb0), "i"(off) : "memory")
#define PV_D0(d0) do { s16x4 l0, l1, l2, l3, h0, h1, h2, h3; constexpr int b_ = VB * SHM_V + v_rd_off(d0, 0, 0); \
        TRRD2(l0, b_); TRRD2(h0, b_ + 2048); TRRD2(l1, b_ + 4096); TRRD2(h1, b_ + 6144); TRRD2(l2, b_ + 8192); TRRD2(h2, b_ + 10240); TRRD2(l3, b_ + 12288); TRRD2(h3, b_ + 14336); \
        asm volatile("s_waitcnt lgkmcnt(0)" ::: "memory"); SBAR();   \
        o[d0] = __builtin_amdgcn_mfma_f32_32x32x16_bf16(pa0, (bf16x8){l0[0], l0[1], l0[2], l0[3], h0[0], h0[1], h0[2], h0[3]}, o[d0], 0, 0, 0);   \
        o[d0] = __builtin_amdgcn_mfma_f32_32x32x16_bf16(pa1, (bf16x8){l1[0], l1[1], l1[2], l1[3], h1[0], h1[1], h1[2], h1[3]}, o[d0], 0, 0, 0);   \
        o[d0] = __builtin_amdgcn_mfma_f32_32x32x16_bf16(pa2, (bf16x8){l2[0], l2[1], l2[2], l2[3], h2[0], h2[1], h2[2], h2[3]}, o[d0], 0, 0, 0);   \
        o[d0] = __builtin_amdgcn_mfma_f32_32x32x16_bf16(pa3, (bf16x8){l3[0], l3[1], l3[2], l3[3], h3[0], h3[1], h3[2], h3[3]}, o[d0], 0, 0, 0); } while (0)
    PV_D0(0); PV_D0(1); PV_D0(2); PV_D0(3);
#undef PV_D0
#undef TRRD2
}
__device__ __forceinline__ void mask_init(f32x16& p0, f32x16& p1, unsigned long long mw, int hi) {
    const int lo = ~(int)((unsigned)mw >> (4 * hi)), hw = ~(int)((unsigned)(mw >> 32) >> (4 * hi));
#pragma unroll
    for (int r = 0; r < 16; ++r) { const int c = (r & 3) + 8 * (r >> 2);
        p0[r] = __int_as_float(((lo << (31 - c)) >> 31) & (int)0xFF800000);
        p1[r] = __int_as_float(((hw << (31 - c)) >> 31) & (int)0xFF800000); }
}
__device__ __forceinline__ void attn_block(LAS char* lds, const bf16_t* Qb  , const bf16_t* Kh  , const bf16_t* Vh, bf16_t* Ob, const unsigned long long* mblk  , int P0) {
    int tid_ = threadIdx.x; asm volatile("" : "+v"(tid_));
    const int tid = tid_, wid = __builtin_amdgcn_readfirstlane(tid >> 6), lane = tid & 63, r32 = lane & 31, hi = lane >> 5;
    const int NT = (P0 + QB) / KVBLK;
    LAS char* V_lds = lds; LAS char* K_lds = lds + 2 * SHM_V;
    LAS float* ws = (LAS float*)(lds + 2 * SHM_V + 2 * SHM_K) + wid * 64; LAS float* li_l = ws; LAS float* al_l = ws + 32;
    float m_reg = -1e30f, l_reg = 0; f32x16 o[4] = {};
    const int sr = tid >> 4, sc = (tid & 15) * 8, vst0 = v_st(sr, sc), vst1 = v_st(32 + sr, sc), kws = KSWZ(sr, sc * 2);
    const int vb0 = (int)(uintptr_t)V_lds + v_rd_base(lane);
    bf16x8 qr[8];
#pragma unroll
    for (int d0 = 0; d0 < 8; ++d0) qr[d0] = *(const bf16x8*)(Qb + (size_t)(wid * QBLK + r32) * LDQ + d0 * 16 + hi * 8);
    const unsigned long long* mrow = mblk + (wid * QBLK + r32);
    bf16x8 st_v0, st_v1, st_k0, st_k1;
#define SLOAD(k0) do { st_v0 = *(const bf16x8*)(Vh + (size_t)((k0) + sr) * LDQ + sc); st_v1 = *(const bf16x8*)(Vh + (size_t)((k0) + 32 + sr) * LDQ + sc); \
                       st_k0 = *(const bf16x8*)(Kh + (size_t)((k0) + sr) * LDQ + sc); st_k1 = *(const bf16x8*)(Kh + (size_t)((k0) + 32 + sr) * LDQ + sc); } while (0)
#define SWRITE(bf) do { *(LAS bf16x8*)(V_lds + (bf) * SHM_V + vst0) = st_v0; *(LAS bf16x8*)(V_lds + (bf) * SHM_V + vst1) = st_v1; \
                        *(LAS bf16x8*)(K_lds + (bf) * SHM_K + kws) = st_k0; *(LAS bf16x8*)(K_lds + (bf) * SHM_K + kws + 32 * 256) = st_k1; } while (0)
#define RESC(a) do { if (__any((a) < 1.f)) { if (hi == 0) al_l[r32] = (a); asm volatile("s_waitcnt lgkmcnt(0)" ::: "memory");              \
                     _Pragma("unroll") for (int d_ = 0; d_ < 4; ++d_) _Pragma("unroll") for (int r = 0; r < 16; ++r) o[d_][r] *= al_l[crow(r, hi)]; } } while (0)
    f32x16 pA0, pA1, pB0, pB1; float mnA, mnB, alA, alB; bf16x8 pa0, pa1, pa2, pa3;
    unsigned long long mnext;
#define HALF_STEP(PX0, PX1, mnX, alX, PY0, PY1, alY, t, KB, VB, SB) do {                                                      \
        const unsigned long long mw_ = mnext; if ((t) + 1 < NT) mnext = mrow[(size_t)((t) + 1) * 256];                        \
        SBAR(); mask_init(PX0, PX1, mw_, hi); qkt<KB>(PX0, PX1, K_lds, r32, hi, qr);                                          \
        finishSM(PY0, PY1, alY, l_reg, pa0, pa1, pa2, pa3); SBAR();                                                           \
        if ((t) + 1 < NT) { SLOAD(((t) + 1) * KVBLK); SBAR(); }                                                               \
        pv_tile<VB>(o, vb0, pa0, pa1, pa2, pa3); partialSM(PX0, PX1, m_reg, mnX, alX);                                        \
        __syncthreads();                                                                                                      \
        if ((t) + 1 < NT) { VM_WAIT(); SWRITE(SB); }                                                                          \
        RESC(alX); LDS_WAIT(); __syncthreads(); } while (0)
    SLOAD(0); { const unsigned long long mw0 = mrow[0]; mnext = mrow[256];
        VM_WAIT(); SWRITE(0); LDS_WAIT(); __syncthreads();
        SLOAD(KVBLK);
        SBAR(); mask_init(pA0, pA1, mw0, hi); qkt<0>(pA0, pA1, K_lds, r32, hi, qr); }
    partialSM(pA0, pA1, m_reg, mnA, alA);
    VM_WAIT(); SWRITE(1); LDS_WAIT();
    __syncthreads();
    for (int t = 1; t + 1 < NT; t += 2) {
        HALF_STEP(pB0, pB1, mnB, alB, pA0, pA1, alA, t, 1, 0, 0);
        HALF_STEP(pA0, pA1, mnA, alA, pB0, pB1, alB, t + 1, 0, 1, 1);
    }
    { const unsigned long long mw_ = mnext;
        SBAR(); mask_init(pB0, pB1, mw_, hi); qkt<1>(pB0, pB1, K_lds, r32, hi, qr); SBAR();
        finishSM(pA0, pA1, alA, l_reg, pa0, pa1, pa2, pa3); SBAR();
        pv_tile<0>(o, vb0, pa0, pa1, pa2, pa3);
        partialSM(pB0, pB1, m_reg, mnB, alB); RESC(alB);
        finishSM(pB0, pB1, alB, l_reg, pa0, pa1, pa2, pa3); SBAR();
        pv_tile<1>(o, vb0, pa0, pa1, pa2, pa3); }
#undef HALF_STEP
    if (hi == 0) li_l[r32] = l_reg; asm volatile("s_waitcnt lgkmcnt(0)" ::: "memory");
    float rli[16];
#pragma unroll
    for (int r = 0; r < 16; ++r) rli[r] = __builtin_amdgcn_rcpf(li_l[crow(r, hi)]);
    bf16_t* Ow = Ob + (size_t)(wid * QBLK) * LDQ;
#pragma unroll
    for (int r = 0; r < 16; ++r) { const int orow = crow(r, hi);
#pragma unroll
        for (int d0 = 0; d0 < 4; ++d0) { const float v = o[d0][r] * rli[r]; const float vn = __shfl_xor(v, 1);
            if ((r32 & 1) == 0) *(unsigned*)(Ow + (size_t)orow * LDQ + d0 * 32 + r32) = cvtpk(v, vn); } }
    __syncthreads();
#undef SLOAD
#undef SWRITE
#undef RESC
}
}
#ifdef SELFCHECK
__device__ __forceinline__ float bf2f(bf16_t v) { return __uint_as_float(((unsigned)v) << 16); }
__device__ __forceinline__ void selfcheck_row(LAS unsigned char* lds, int b, int t, const bf16_t* QI, const bf16_t* KI, const float* WI, const unsigned long long* MASK,
                                              const bf16_t* Q, const bf16_t* K, const bf16_t* V, const bf16_t* YBp, unsigned* err, int tid) {
    LAS unsigned short* keys = (LAS unsigned short*)lds;
    LAS float* qv = (LAS float*)(lds + 32768);
    LAS int* sel = (LAS int*)(lds + 32768 + 4096);
    LAS float* lg = (LAS float*)(lds + 32768 + 8192);
    LAS unsigned* cnts = (LAS unsigned*)(lds + 32768 + 16384);
    const int n = t + 1; const size_t row = (size_t)b * SEQ + t;
    if (tid < 256) qv[tid] = bf2f(QI[row * 256 + tid]);
    if (tid < 8) cnts[tid] = 0u;
    __syncthreads();
    const float w0 = WI[row * 4 + 0], w1 = WI[row * 4 + 1], w2 = WI[row * 4 + 2], w3 = WI[row * 4 + 3];
    for (int s = tid; s < SEQ; s += NTHREADS) {
        unsigned k15 = 0u;
        if (s < n) { float d[4] = {0.f, 0.f, 0.f, 0.f};
            for (int k = 0; k < 64; ++k) { const float kv = bf2f(KI[ki_chunk(b, s, k >> 3) + (k & 7)]); d[0] += qv[k] * kv; d[1] += qv[64 + k] * kv; d[2] += qv[128 + k] * kv; d[3] += qv[192 + k] * kv; }
            const float sc = fmaxf(d[0], 0.f) * w0 + fmaxf(d[1], 0.f) * w1 + fmaxf(d[2], 0.f) * w2 + fmaxf(d[3], 0.f) * w3;
            k15 = key15(sc); }
        keys[s] = (unsigned short)k15; }
    __syncthreads();
    const unsigned long long* mrow = MASK + ((size_t)(b * 64 + (t >> 8)) * 256 * 256 + (size_t)(t & 255));
    const int ncheck = ((t & ~255) + 256);
    for (int s = tid; s < ncheck; s += NTHREADS) {
        bool want = false;
        if (s < n) { if (n <= 256) want = true; else { const unsigned k = keys[s]; int rank = 0; for (int s2 = 0; s2 < n; ++s2) { const unsigned k2 = keys[s2]; rank += (k2 > k || (k2 == k && s2 < s)) ? 1 : 0; } want = rank < 256; } }
        const bool got = (mrow[(size_t)(s >> 6) * 256] >> (s & 63)) & 1ull;
        if (want != got) atomicAdd((unsigned*)&cnts[0], 1u);
        if (got) { const unsigned j = atomicAdd((unsigned*)&cnts[1], 1u); if (j < 256u) sel[j] = s; } }
    __syncthreads();
    const int nsel = (int)cnts[1]; const int nexp = n < 256 ? n : 256;
    qv[tid] = bf2f(Q[row * 512 + tid]);
    __syncthreads();
    if (nsel == nexp) {
        if (tid < nsel) { const bf16_t* kp = K + ((size_t)b * SEQ + sel[tid]) * 512;
            for (int h = 0; h < 4; ++h) { float d = 0.f; for (int k = 0; k < 128; ++k) d += qv[h * 128 + k] * bf2f(kp[h * 128 + k]); lg[h * 256 + tid] = d * 0.08838834764831845f; } }
        __syncthreads();
        if (tid < 4) { float mx = -1e30f; for (int j = 0; j < nsel; ++j) mx = fmaxf(mx, lg[tid * 256 + j]); float sm = 0.f; for (int j = 0; j < nsel; ++j) { const float e = expf(lg[tid * 256 + j] - mx); lg[tid * 256 + j] = e; sm += e; }
            const float inv = 1.0f / sm; for (int j = 0; j < nsel; ++j) lg[tid * 256 + j] *= inv; }
        __syncthreads();
        { const int h = tid >> 7; float o = 0.f; for (int j = 0; j < nsel; ++j) o += lg[h * 256 + j] * bf2f(V[((size_t)b * SEQ + sel[j]) * 512 + tid]);
            const float got = bf2f(YBp[row * 512 + tid]); const float dd = o - got;
            atomicAdd((float*)&cnts[2], dd * dd); atomicAdd((float*)&cnts[3], o * o); }
        __syncthreads();
    }
    if (tid == 0) { const float e2 = __uint_as_float(cnts[2]), r2 = __uint_as_float(cnts[3]);
        const bool bad = (cnts[0] > 4u) || (nsel != nexp) || !(e2 <= (SELFCHECK == 2 ? 1e-9f : 0.0009f) * r2 + 1e-12f);
        if (bad) atomicAdd(err, 1u); }
    __syncthreads();
}
#endif
__device__ __forceinline__ void route_a(LAS unsigned char* lds, int blk, const float* LOG, const float* rgb, const float* reb, int* TE, float* TW, unsigned* CNT, const int tid) {
    LAS unsigned* cnt = (LAS unsigned*)lds;
    if (tid < 32) cnt[tid] = 0u;
    __syncthreads();
    if (tid < 128) { const int t = blk * 128 + tid; const float* lg = LOG + (size_t)t * 64;
        float g[4]; int grp = 0;
#pragma unroll
        for (int j = 0; j < 4; ++j) g[j] = lg[j] + rgb[j];
#pragma unroll
        for (int j = 1; j < 4; ++j) if (g[j] > g[grp]) grp = j;
        float den = 0.f;
#pragma unroll
        for (int j = 0; j < 4; ++j) den += expf(g[j] - g[grp]);
        const float gw = 1.0f / den;
        float el[8]; int i0 = 0;
#pragma unroll
        for (int j = 0; j < 8; ++j) el[j] = lg[4 + grp * 8 + j] + reb[grp * 8 + j];
#pragma unroll
        for (int j = 1; j < 8; ++j) if (el[j] > el[i0]) i0 = j;
        int i1 = (i0 == 0) ? 1 : 0;
#pragma unroll
        for (int j = 0; j < 8; ++j) if (j != i0 && j != i1 && el[j] > el[i1]) i1 = j;
        const float e1 = expf(el[i1] - el[i0]); const float w0 = gw / (1.0f + e1), w1 = gw * e1 / (1.0f + e1);
        const int x0 = grp * 8 + i0, x1 = grp * 8 + i1;
        TE[2 * t] = x0; TE[2 * t + 1] = x1; TW[2 * t] = w0; TW[2 * t + 1] = w1;
        __hip_atomic_fetch_add(&cnt[x0], 1u, __ATOMIC_RELAXED, __HIP_MEMORY_SCOPE_WORKGROUP); __hip_atomic_fetch_add(&cnt[x1], 1u, __ATOMIC_RELAXED, __HIP_MEMORY_SCOPE_WORKGROUP); }
    __syncthreads();
    if (tid < 32) CNT[blk * 32 + tid] = cnt[tid];
    __syncthreads();
}
__device__ __forceinline__ void route_b(LAS unsigned char* lds, int blk, const unsigned* CNT, const int* TE, const float* TW, const bf16_t* HB2, bf16_t* XS, float* WSLOT, int* SLOT, int* TILETAB, int wid, int lane, const int tid) {
    LAS unsigned* ptot = (LAS unsigned*)lds;
    LAS unsigned* pbef = ptot + 512;
    LAS unsigned* tot = pbef + 512;
    LAS unsigned* base = tot + 32;
    LAS unsigned* estart = base + 32;
    LAS int* pos = (LAS int*)(estart + 64);
    LAS int* lte = pos + 256;
    { const int e = tid & 31, part = tid >> 5; unsigned s = 0u, bsum = 0u;
        for (int b2 = part * 16; b2 < part * 16 + 16; ++b2) { const unsigned c = CNT[b2 * 32 + e]; s += c; if (b2 < blk) bsum += c; }
        ptot[part * 32 + e] = s; pbef[part * 32 + e] = bsum; }
    if (tid < 256) lte[tid] = TE[blk * 256 + tid];
    __syncthreads();
    if (tid < 32) { unsigned s = 0u, bsum = 0u;
        for (int p = 0; p < 16; ++p) { s += ptot[p * 32 + tid]; bsum += pbef[p * 32 + tid]; }
        tot[tid] = s; base[tid] = bsum; }
    __syncthreads();
    if (tid == 0) { unsigned run = 0u; for (int e = 0; e < 32; ++e) { estart[e] = run; run += (tot[e] + 255u) & ~255u; } estart[32] = run; }
    __syncthreads();
    if (tid < 32) { int k = (int)(estart[tid] + base[tid]);
        for (int a = 0; a < 256; ++a) if (lte[a] == tid) pos[a] = k++; }
    __syncthreads();
    for (int a = wid * 32; a < wid * 32 + 32; ++a) { const int t = blk * 128 + (a >> 1), p = pos[a];
        const u32x4* src = (const u32x4*)(HB2 + (size_t)t * 1024); u32x4* dst = (u32x4*)(XS + (size_t)p * 1024);
        dst[lane] = src[lane]; dst[64 + lane] = src[64 + lane];
        if (lane == 0) { WSLOT[p] = TW[blk * 256 + a]; SLOT[blk * 256 + a] = p; } }
    if (blk < 32) {
        const int r0 = (int)(estart[blk] + tot[blk]), r1 = (int)estart[blk + 1];
        for (int r = r0 + wid; r < r1; r += NWAVES) { u32x4* dst = (u32x4*)(XS + (size_t)r * 1024); dst[lane] = (u32x4){0u, 0u, 0u, 0u}; dst[64 + lane] = (u32x4){0u, 0u, 0u, 0u}; if (lane == 0) WSLOT[r] = 0.f; }
    }
    if (blk == 0) { if (tid == 0) TILETAB[0] = (int)(estart[32] >> 8);
        if (tid < 32) for (unsigned rt = estart[tid] >> 8; rt < (estart[tid + 1] >> 8); ++rt) TILETAB[1 + rt] = tid; }
    __syncthreads();
}

#ifndef PHASE_MASK
#define PHASE_MASK 0x3FFF
#endif
#define PK(i) ((PHASE_MASK >> (i)) & 1)
#ifndef REPEAT_MASK
#define REPEAT_MASK 0
#endif
#ifndef REPEAT_N
#define REPEAT_N 2
#endif
#define REPS(i) (((REPEAT_MASK >> (i)) & 1) ? REPEAT_N : 1)
#ifndef IX_FAST_MIN_QT
#define IX_FAST_MIN_QT 128
#endif
constexpr int NPH_LAYER = 13, NPHASES = 1 + DEPTH * NPH_LAYER;
struct Args {
    const float* in[20]; float* out; unsigned char* ws;
    float invq[16]; float invi[8];
    int ph_lo, ph_hi, li, pad;
};

__global__ void __launch_bounds__(NTHREADS, 2) fwd_kernel(Args args) {
    extern __shared__ __attribute__((aligned(16))) unsigned char lds_raw[];
    LAS unsigned char* lds = (LAS unsigned char*)lds_raw;
    volatile LAS unsigned* MISC = (volatile LAS unsigned*)(lds + MISC_OFF);
    const int tid = threadIdx.x;
    unsigned* ctl = (unsigned*)(args.ws + WS_CTL);
    if (tid < 64) ((LAS unsigned*)(lds + MISC_OFF))[tid] = 0u;
    __syncthreads();
    XcdBarrier bar = xcd_barrier_post(ctl + CW_BAR + args.li * XCD_BAR_WORDS, MISC + 8);
    const int lo = args.ph_lo, hi = args.ph_hi;
#define IN(k) (lo <= (k) && (k) < hi)
#define SEAM(k) do { if (IN(k) && IN((k) + 1)) xcd_barrier(bar); } while (0)
#define CAS __attribute__((address_space(4)))
#ifdef PH_STAMP
#define PHS_BEGIN(k) const unsigned long long phs_t0_ = __builtin_amdgcn_s_memrealtime(); const int phs_k_ = (k);
#define PHS_END() do { if (phs_k_ == PH_STAMP && blockIdx.x == 0 && threadIdx.x == 0) { unsigned* c_ = (unsigned*)(ap->ws + WS_CTL) + CW_ERR; atomicAdd(c_ + 1, (unsigned)(__builtin_amdgcn_s_memrealtime() - phs_t0_) / 100u); } } while (0)
#else
#define PHS_BEGIN(k)
#define PHS_END() do {} while (0)
#endif
#define OPQ() const CAS Args* ap = (const CAS Args*)__builtin_amdgcn_kernarg_segment_ptr(); asm volatile("" : "+s"(ap)); unsigned char* const ws = ap->ws; (void)ws; int bid = blockIdx.x, G = gridDim.x; asm volatile("" : "+s"(bid), "+s"(G)); const int NGW = G * NWAVES; (void)NGW; int tid_o = threadIdx.x; asm volatile("" : "+v"(tid_o)); const int lane = tid_o & 63, wid = __builtin_amdgcn_readfirstlane(tid_o >> 6), gw = bid * NWAVES + wid; (void)lane; (void)gw;

#define x_in (ap->in[0])
#define positions ((const int*)ap->in[1])
#define g_mix (ap->in[2])
#define g_ffn (ap->in[3])
#define g_fin (ap->in[4])
#define XA (ap->out)
#define cosq ((float*)(ws + WS_COSQ))
#define sinq ((float*)(ws + WS_SINQ))
#define cosi ((float*)(ws + WS_COSI))
#define sini ((float*)(ws + WS_SINI))
#define WIN ((bf16_t*)(ws + WS_WIN))
#define WP ((bf16_t*)(ws + WS_WP))
#define WO ((bf16_t*)(ws + WS_WO))
#define WR ((bf16_t*)(ws + WS_WR))
#define R (ws + WS_R)
#define HB ((bf16_t*)(R + R_HB))
#define VA ((bf16_t*)(R + R_VA))
#define CC ((bf16_t*)(R + R_CC))
#define CX ((bf16_t*)(R + R_CX))
#define YB ((bf16_t*)(R + R_YB))
#define UA ((bf16_t*)(R + R_UA))
#define Qm ((bf16_t*)(R + R_Q))
#define Km ((bf16_t*)(R + R_K))
#define VB ((bf16_t*)(R + R_VB))
#define CB ((bf16_t*)(R + R_CB))
#define QI ((bf16_t*)(R + R_QI))
#define KI ((bf16_t*)(R + R_KI))
#define WI ((float*)(R + R_WI))
#define G8 (R + R_G8)
#define MASK ((unsigned long long*)(R + R_MASK))
#define MG ((bf16_t*)(R + R_MERGED))
#define WGU ((bf16_t*)(R + R_WGU))
#define WD ((bf16_t*)(R + R_WD))
#define HB2 ((bf16_t*)(R + R_HB2))
#define LOG ((float*)(R + R_LOG))
#define XS ((bf16_t*)(R + R_XS))
#define HID ((bf16_t*)(R + R_HID))
#define CNT ((unsigned*)(ws + WS_MISC + MS_CNT))
#define TE ((int*)(ws + WS_MISC + MS_TE))
#define TW ((float*)(ws + WS_MISC + MS_TW))
#define SLOT ((int*)(ws + WS_MISC + MS_SLOT))
#define WSLOT ((float*)(ws + WS_MISC + MS_WSLOT))
#define TILETAB ((int*)(ws + WS_MISC + MS_TILE))

    if (PK(0) && IN(0)) for (int rep_ = 0; rep_ < REPS(0); ++rep_) { asm volatile("; PHASE_MARK 0"); OPQ();
        for (int e = bid * NTHREADS + tid_o; e < T * 24; e += G * NTHREADS) {
            const int t = e / 24, j = e - 24 * t; const float p = (float)positions[t]; float s, c;
            if (j < 16) { sincos_f32(p * ap->invq[j], s, c); cosq[(size_t)t * 16 + j] = c; sinq[(size_t)t * 16 + j] = s; }
            else { sincos_f32(p * ap->invi[j - 16], s, c); cosi[(size_t)t * 8 + (j - 16)] = c; sini[(size_t)t * 8 + (j - 16)] = s; } }
        LAS float* scr = (LAS float*)(lds + wid * 16384);
        constexpr int I_WIN = 16 * 120, I_WP = 8 * 16, I_WO = 16 * 16, I_WR = 16 * 4, I_LAYER = I_WIN + 3 * I_WP + I_WO + I_WR;
        for (int it = gw; it < DEPTH * I_LAYER; it += NGW) { const int l = it / I_LAYER; int r = it % I_LAYER;
            if (r < I_WIN) { cvt_item(SrcWin{ap->in[5] + (size_t)l * DM * D_IN}, WIN + (size_t)l * NPROJ * DM, DM, 64 * (r / 120), 64 * (r % 120), scr, lane); continue; } r -= I_WIN;
            if (r < 3 * I_WP) { const int br = r / I_WP, q = r % I_WP; cvt_item(SrcPlain{ap->in[9 + br] + (size_t)l * 512 * DM, DM}, WP + ((size_t)l * 3 + br) * DM * 512, 512, 64 * (q / 16), 64 * (q % 16), scr, lane); continue; } r -= 3 * I_WP;
            if (r < I_WO) { cvt_item(SrcPlain{ap->in[12] + (size_t)l * DM * DM, DM}, WO + (size_t)l * DM * DM, DM, 64 * (r / 16), 64 * (r % 16), scr, lane); continue; } r -= I_WO;
            cvt_item(SrcRouter{ap->in[13] + (size_t)l * DM * 4, ap->in[15] + (size_t)l * DM * 32}, WR + (size_t)l * 256 * DM, DM, 64 * (r / 4), 64 * (r % 4), scr, lane);
        }
        for (int m = gw; m < T; m += 2 * NGW) { const int m2 = (m + NGW < T) ? m + NGW : m;
            RmsRow ra, rb; rms_load(ra, x_in + (size_t)m * DM, nullptr, nullptr, lane); rms_load(rb, x_in + (size_t)m2 * DM, nullptr, nullptr, lane);
            rms_finish(ra, false, g_mix, nullptr, HB + (size_t)m * DM, nullptr, lane); rms_finish(rb, false, g_mix, nullptr, HB + (size_t)m2 * DM, nullptr, lane); }
    }
    SEAM(0);

#pragma unroll 1
    for (int l = 0; l < DEPTH; ++l) {
        const int pb = 1 + l * NPH_LAYER;
        if (PK(1) && IN(pb + 0)) for (int rep_ = 0; rep_ < REPS(1); ++rep_) { asm volatile("; PHASE_MARK 1"); OPQ();
            pg8::DenseOrder S; S.init(HB, WIN + (size_t)l * NPROJ * DM, T, NPROJ, DM, G, bid);
            EpiProj E{ws};
            pg8::gemm_phase(lds, DM, S, E);
        }
        SEAM(pb + 0);
        if (PK(2) && IN(pb + 1)) for (int rep_ = 0; rep_ < REPS(2); ++rep_) { asm volatile("; PHASE_MARK 2"); OPQ();
            PHS_BEGIN(2)
#ifdef GM_REP
            for (int gr_ = 0; gr_ < GM_REP; ++gr_) for (int item = bid; item < T / 128; item += G)
                gmlp_conv_item(lds, item, UA, VA, CB, CC, CX, ap->in[6] + (size_t)l * 4 * 128 * 128, ap->in[7] + (size_t)l * 4 * 128, ap->in[8] + (size_t)l * 3 * 512, wid, lane, true);
#endif
            for (int item = bid; item < T / 128; item += G)
                gmlp_conv_item(lds, item, UA, VA, CB, CC, CX, ap->in[6] + (size_t)l * 4 * 128 * 128, ap->in[7] + (size_t)l * 4 * 128, ap->in[8] + (size_t)l * 3 * 512, wid, lane);
            PHS_END();
        }
        SEAM(pb + 1);
        if (PK(3) && IN(pb + 2)) for (int rep_ = 0; rep_ < REPS(3); ++rep_) { asm volatile("; PHASE_MARK 3"); OPQ();
            unsigned char* scr = (unsigned char*)(R + R_SCR + (size_t)bid * SCR_PER_WG);
#ifdef IX_STAMP
            if (tid_o < 8) ((LAS unsigned*)(lds + IXL_ROW))[96 + tid_o] = 0u;
            __syncthreads();
            const unsigned long long tph0 = __builtin_amdgcn_s_memrealtime();
#endif
#if defined(IX_SKIP) && (IX_SKIP & 16)
            for (int row = bid * NTHREADS + tid_o; row < T; row += G * NTHREADS) { const int bb = row >> 14, tq = row & (SEQ - 1), qb = tq >> 8, nto = ((tq & ~255) + 256) >> 6;
                unsigned long long* mrow = MASK + ((size_t)(bb * 64 + qb) * 256 * 256 + (size_t)(tq & 255));
                for (int Tt = 0; Tt < nto; ++Tt) { unsigned long long w = 0ull; if (Tt < 4) { const int lo_ = 64 * Tt; w = (lo_ + 63 <= tq) ? ~0ull : (lo_ > tq ? 0ull : ((1ull << (tq - lo_ + 1)) - 1ull)); } mrow[(size_t)Tt * 256] = w; } }
#else
            int nslow = 0;
            constexpr int NFAST = 2 * (1024 - IX_FAST_MIN_QT);
            unsigned* wq = (unsigned*)(ws + WS_CTL) + CW_WQ + 64 * l + 16 * rep_;
            if (tid_o == 0) MISC[14] = __hip_atomic_fetch_add(wq, 1u, __ATOMIC_RELAXED, __HIP_MEMORY_SCOPE_AGENT);
            __syncthreads();
            for (int qi_ = 0;; ++qi_) {
                const int k = (int)MISC[14 + (qi_ & 1)];
                if (k >= NFAST) break;
                if (tid_o == 0) MISC[14 + ((qi_ + 1) & 1)] = __hip_atomic_fetch_add(wq, 1u, __ATOMIC_RELAXED, __HIP_MEMORY_SCOPE_AGENT);
                const int ib = k & 1, iq = 1023 - (k >> 1);
                const bool done = indexer_item_fast(lds, ib, iq, QI, KI, WI, MASK, wid, lane, tid_o, (unsigned*)(ws + WS_CTL) + CW_ERR, (unsigned*)scr);
                if (!done) { if (tid_o == 0 && nslow < 44) MISC[16 + nslow] = (unsigned)(ib * 1024 + iq); ++nslow;
#ifdef IX_PROBE_FAILS
                    if (tid_o == 0) atomicAdd((unsigned*)(ws + WS_CTL) + CW_ERR, 1u);
#endif
                } }
            for (int k = bid; k < 2 * IX_FAST_MIN_QT; k += G) { if (tid_o == 0 && nslow < 44) MISC[16 + nslow] = (unsigned)((k & 1) * 1024 + (k >> 1)); ++nslow; }
            if (nslow > 44) nslow = 44;
            __syncthreads();
#ifdef IX_STAMP
            const unsigned long long tp2 = __builtin_amdgcn_s_memrealtime();
#endif
            for (int k = 0; k < nslow; ++k) { const int idx = (int)MISC[16 + k];
                indexer_item(lds, scr, idx >> 10, idx & 1023, QI, KI, WI, MASK, wid, lane); }
#endif
#ifdef IX_STAMP
            if (bid == 0 && tid_o == 0) { const unsigned v = (IX_STAMP < 5) ? ((LAS unsigned*)(lds + IXL_ROW))[96 + IX_STAMP] : (IX_STAMP == 6 ? (unsigned)(__builtin_amdgcn_s_memrealtime() - tp2) : (unsigned)(__builtin_amdgcn_s_memrealtime() - tph0));
                atomicAdd((unsigned*)(ws + WS_CTL) + CW_ERR + 1, v / 100u);
                if (l == DEPTH - 1) { const unsigned us = __hip_atomic_load((unsigned*)(ws + WS_CTL) + CW_ERR + 1, __ATOMIC_RELAXED, __HIP_MEMORY_SCOPE_AGENT); unsigned code = 0u; float x = (float)us; while (x >= 1.4142135f) { x *= 0.70710678f; ++code; }
                    atomicAdd((unsigned*)(ws + WS_CTL) + CW_ERR, code); } }
#endif
        }
        SEAM(pb + 2);
        if (PK(4) && IN(pb + 3)) for (int rep_ = 0; rep_ < REPS(4); ++rep_) { asm volatile("; PHASE_MARK 4"); OPQ();
            for (int it = bid; it < 256; it += G) { const int bh = it & 7, y = it >> 3, b = bh >> 2, h = bh & 3;
#pragma unroll 1
                for (int half = 0; half < 2; ++half) { const int qb = half ? y : 63 - y, P0 = qb * 256;
                    const size_t hoff = (size_t)b * SEQ * 512 + h * 128;
                    att::attn_block((LAS char*)lds, Qm + hoff + (size_t)P0 * 512, Km + hoff, VB + hoff, YB + hoff + (size_t)P0 * 512, MASK + (size_t)(b * 64 + qb) * 256 * 256, P0); } }
#ifdef SELFCHECK
            xcd_barrier(bar);
            if (bid < 64) { const int tl[32] = {0, 1, 63, 64, 255, 256, 257, 300, 383, 511, 512, 600, 1023, 2047, 2048, 2049, 2063, 2064, 3333, 4095, 4096, 5000, 7000, 8191, 8192, 11111, 12287, 12288, 15000, 16368, 16382, 16383};
                int tsel = 0;
#pragma unroll
                for (int q = 0; q < 32; ++q) tsel = ((bid & 31) == q) ? tl[q] : tsel;
                selfcheck_row(lds, bid >> 5, tsel, QI, KI, WI, MASK, Qm, Km, VB, YB, (unsigned*)(ws + WS_CTL) + CW_ERR, tid_o); }
#endif
        }
        SEAM(pb + 3);
        if (PK(5) && IN(pb + 4)) for (int rep_ = 0; rep_ < REPS(5); ++rep_) { asm volatile("; PHASE_MARK 5"); OPQ();
            MergeOrder S{(const char*)R, (const char*)(WP + (size_t)l * 3 * DM * 512), G, bid};
            EpiMerge E{MG, G8};
            pg8::gemm_phase(lds, 512, S, E);
        }
        SEAM(pb + 4);
        if (PK(6) && IN(pb + 5)) for (int rep_ = 0; rep_ < (l == 0 ? REPS(6) : 1); ++rep_) {         asm volatile("; PHASE_MARK 6"); OPQ();
            pg8::DenseOrder S; S.init(MG, WO + (size_t)l * DM * DM, T, DM, DM, G, bid);
            EpiWout E{l == 0 ? x_in : (const float*)XA, XA};
            pg8::gemm_phase(lds, DM, S, E);
        }
        SEAM(pb + 5);
        if (PK(7) && IN(pb + 6)) for (int rep_ = 0; rep_ < REPS(7); ++rep_) { asm volatile("; PHASE_MARK 7"); OPQ();
            for (int m = gw; m < T; m += 2 * NGW) { const int m2 = (m + NGW < T) ? m + NGW : m;
                RmsRow ra, rb; rms_load(ra, XA + (size_t)m * DM, nullptr, nullptr, lane); rms_load(rb, XA + (size_t)m2 * DM, nullptr, nullptr, lane);
                rms_finish(ra, false, g_ffn + (size_t)l * DM, nullptr, HB2 + (size_t)m * DM, nullptr, lane); rms_finish(rb, false, g_ffn + (size_t)l * DM, nullptr, HB2 + (size_t)m2 * DM, nullptr, lane); }
            LAS float* scr = (LAS float*)(lds + wid * 16384);
            constexpr int I_GU = 16 * 16, I_D = 8 * 16, I_E = I_GU + I_D;
#define EXP_LOAD(Rg, it_) do { const int e_ = (it_) / I_E, r_ = (it_) % I_E; const size_t eo_ = ((size_t)l * NEXP + e_) * DM * DFF; \
                if (r_ < I_GU) cvt_load(Rg, SrcGateUp{ap->in[17] + eo_, ap->in[18] + eo_}, 64 * (r_ / 16), 64 * (r_ % 16), lane); \
                else { const int q_ = r_ - I_GU; cvt_load(Rg, SrcPlain{ap->in[19] + eo_, DM}, 64 * (q_ / 16), 64 * (q_ % 16), lane); } } while (0)
#define EXP_STORE(Rg, it_) do { const int e_ = (it_) / I_E, r_ = (it_) % I_E; \
                if (r_ < I_GU) cvt_store(Rg, WGU + (size_t)e_ * DM * DM, DM, 64 * (r_ / 16), 64 * (r_ % 16), scr, lane); \
                else { const int q_ = r_ - I_GU; cvt_store(Rg, WD + (size_t)e_ * DM * DFF, DFF, 64 * (q_ / 16), 64 * (q_ % 16), scr, lane); } } while (0)
            for (int it = gw; it < NEXP * I_E; it += NGW) { CvtRegs ra; EXP_LOAD(ra, it); EXP_STORE(ra, it); }
#undef EXP_LOAD
#undef EXP_STORE
        }
        SEAM(pb + 6);
        if (PK(8) && IN(pb + 7)) for (int rep_ = 0; rep_ < REPS(8); ++rep_) { asm volatile("; PHASE_MARK 8"); OPQ();
            pg8::DenseOrder S; S.init(HB2, WR + (size_t)l * 256 * DM, T, 256, DM, G, bid);
            EpiRouter E{LOG};
            pg8::gemm_phase(lds, DM, S, E);
        }
        SEAM(pb + 7);
        if (PK(9) && IN(pb + 8)) for (int rep_ = 0; rep_ < REPS(9); ++rep_) { asm volatile("; PHASE_MARK 9"); OPQ(); for (int blk = bid; blk < 256; blk += G) route_a(lds, blk, LOG, ap->in[14] + l * 4, ap->in[16] + l * 32, TE, TW, CNT, tid_o); }
        SEAM(pb + 8);
        if (PK(10) && IN(pb + 9)) for (int rep_ = 0; rep_ < REPS(10); ++rep_) { asm volatile("; PHASE_MARK 10"); OPQ(); for (int blk = bid; blk < 256; blk += G) route_b(lds, blk, CNT, TE, TW, HB2, XS, WSLOT, SLOT, TILETAB, wid, lane, tid_o); }
        SEAM(pb + 9);
        if (PK(11) && IN(pb + 10)) for (int rep_ = 0; rep_ < REPS(11); ++rep_) { asm volatile("; PHASE_MARK 11"); OPQ();
            MoeOrder S{(const char*)XS, (const char*)WGU, TILETAB, (size_t)256 * DM * 2, (size_t)DM * DM * 2, (size_t)256 * DM * 2, G, bid};
            EpiGateUp E{HID};
            pg8::gemm_phase(lds, DM, S, E);
        }
        SEAM(pb + 10);
        if (PK(12) && IN(pb + 11)) for (int rep_ = 0; rep_ < REPS(12); ++rep_) { asm volatile("; PHASE_MARK 12"); OPQ();
            MoeOrder S{(const char*)HID, (const char*)WD, TILETAB, (size_t)256 * DFF * 2, (size_t)DM * DFF * 2, (size_t)256 * DFF * 2, G, bid};
            EpiDown E{XS, WSLOT};
            pg8::gemm_phase(lds, DFF, S, E);
        }
        SEAM(pb + 11);
        if (PK(13) && IN(pb + 12)) for (int rep_ = 0; rep_ < REPS(13); ++rep_) { asm volatile("; PHASE_MARK 13"); OPQ();
            PHS_BEGIN(13)
            const bool lastl = (l == DEPTH - 1);
#ifdef PH_STAMP
            float probe_scale = 1.0f;
            if (l == DEPTH - 1 && PH_STAMP != 13) { const unsigned us = __hip_atomic_load((unsigned*)(ws + WS_CTL) + CW_ERR + 1, __ATOMIC_RELAXED, __HIP_MEMORY_SCOPE_AGENT); unsigned code = 0u; float x = (float)us; while (x >= 1.4142135f) { x *= 0.70710678f; ++code; } probe_scale = 1.0f + (float)code; }
#elif defined(SELFCHECK) || defined(IX_PROBE_FAILS) || defined(IX_STAMP) || defined(IX_PROBE_TYPE)
            const float probe_scale = 1.0f + (float)__hip_atomic_load((unsigned*)(ws + WS_CTL) + CW_ERR, __ATOMIC_RELAXED, __HIP_MEMORY_SCOPE_AGENT);
#endif
            const float* gn = lastl ? g_fin : g_mix + (size_t)(l + 1) * DM;
#ifdef CB_REP
            for (int m = gw; m < T; m += 2 * NGW) { const int m2 = (m + NGW < T) ? m + NGW : m;
                const int s0 = SLOT[2 * m], s1 = SLOT[2 * m + 1], s2 = SLOT[2 * m2], s3 = SLOT[2 * m2 + 1];
                RmsRow ra, rb; rms_load(ra, XA + (size_t)m * DM, XS + (size_t)s0 * DM, XS + (size_t)s1 * DM, lane); rms_load(rb, XA + (size_t)m2 * DM, XS + (size_t)s2 * DM, XS + (size_t)s3 * DM, lane);
                rms_finish(ra, true, gn, nullptr, nullptr, nullptr, lane); rms_finish(rb, true, gn, nullptr, nullptr, nullptr, lane);
                asm volatile("" :: "v"(ra.v[0][0]), "v"(rb.v[0][0]), "v"(ra.v[3][3]), "v"(rb.v[3][3])); }
#endif
            for (int m = gw; m < T; m += 2 * NGW) { const int m2 = (m + NGW < T) ? m + NGW : m;
                const int s0 = SLOT[2 * m], s1 = SLOT[2 * m + 1], s2 = SLOT[2 * m2], s3 = SLOT[2 * m2 + 1];
                RmsRow ra, rb; rms_load(ra, XA + (size_t)m * DM, XS + (size_t)s0 * DM, XS + (size_t)s1 * DM, lane); rms_load(rb, XA + (size_t)m2 * DM, XS + (size_t)s2 * DM, XS + (size_t)s3 * DM, lane);
                rms_finish(ra, true, gn, lastl ? nullptr : XA + (size_t)m * DM, lastl ? nullptr : HB + (size_t)m * DM, lastl ? XA + (size_t)m * DM : nullptr, lane);
                rms_finish(rb, true, gn, lastl ? nullptr : XA + (size_t)m2 * DM, lastl ? nullptr : HB + (size_t)m2 * DM, lastl ? XA + (size_t)m2 * DM : nullptr, lane); }
#if defined(SELFCHECK) || defined(IX_PROBE_FAILS) || defined(IX_STAMP) || defined(IX_PROBE_TYPE) || defined(PH_STAMP)
            if (lastl) for (int m = gw; m < T; m += NGW) { f32x4* o4 = (f32x4*)(XA + (size_t)m * DM) + lane;
#pragma unroll
                for (int j = 0; j < 4; ++j) o4[64 * j] = o4[64 * j] * probe_scale; }
#endif
        }
        SEAM(pb + 12);
    }
#undef IN
#undef SEAM
#undef x_in
#undef positions
#undef g_mix
#undef g_ffn
#undef g_fin
#undef XA
#undef cosq
#undef sinq
#undef cosi
#undef sini
#undef WIN
#undef WP
#undef WO
#undef WR
#undef R
#undef HB
#undef VA
#undef CC
#undef CX
#undef YB
#undef UA
#undef Qm
#undef Km
#undef VB
#undef CB
#undef QI
#undef KI
#undef WI
#undef G8
#undef MASK
#undef MG
#undef WGU
#undef WD
#undef HB2
#undef LOG
#undef XS
#undef HID
#undef CNT
#undef TE
#undef TW
#undef SLOT
#undef WSLOT
#undef TILETAB
}

#ifndef N_LAUNCH_MODE
#define N_LAUNCH_MODE 1
#endif
extern "C" void kernel_launch(void* const* d_in, const int* in_sizes, int n_in, void* d_out, int out_size, void* d_ws, size_t ws_size, hipStream_t stream) {
    static int grid = 0;
    if (grid == 0) {
        if (n_in != 20 || in_sizes[0] != T * DM || out_size != T * DM || ws_size < WS_END) { fprintf(stderr, "kernel_launch: unexpected shapes (n_in %d, in0 %d, out %d, ws %zu < %zu)\n", n_in, n_in > 0 ? in_sizes[0] : -1, out_size, ws_size, (size_t)WS_END); grid = -1; return; }
        int dev = 0, cus = 0, per_cu = 0;
        if (hipGetDevice(&dev) != hipSuccess || hipDeviceGetAttribute(&cus, hipDeviceAttributeMultiprocessorCount, dev) != hipSuccess) { grid = -1; return; }
        if (hipFuncSetAttribute((const void*)fwd_kernel, hipFuncAttributeMaxDynamicSharedMemorySize, LDS_BYTES) != hipSuccess) { fprintf(stderr, "kernel_launch: hipFuncSetAttribute failed\n"); grid = -1; return; }
        if (hipOccupancyMaxActiveBlocksPerMultiprocessor(&per_cu, (const void*)fwd_kernel, NTHREADS, LDS_BYTES) != hipSuccess || per_cu < 1) { fprintf(stderr, "kernel_launch: occupancy query says %d\n", per_cu); }
        (void)hipGetLastError();
        grid = cus;
    }
    if (grid < 0) return;
    if (hipMemsetAsync((char*)d_ws + WS_CTL, 0, CTL_ZERO_BYTES, stream) != hipSuccess) return;
    Args a{};
    for (int i = 0; i < 20; ++i) a.in[i] = (const float*)d_in[i];
    a.out = (float*)d_out; a.ws = (unsigned char*)d_ws;
    for (int j = 0; j < 16; ++j) a.invq[j] = powf(500000.0f, -(float)j * 2.0f / 32.0f);
    for (int j = 0; j < 8; ++j) a.invi[j] = powf(500000.0f, -(float)j * 2.0f / 16.0f);
#if N_LAUNCH_MODE == 1
    a.ph_lo = 0; a.ph_hi = NPHASES; a.li = 0;
    hipLaunchKernelGGL(fwd_kernel, dim3(grid), dim3(NTHREADS), LDS_BYTES, stream, a);
#else
    for (int p = 0; p < NPHASES; ++p) { a.ph_lo = p; a.ph_hi = p + 1; a.li = p; hipLaunchKernelGGL(fwd_kernel, dim3(grid), dim3(NTHREADS), LDS_BYTES, stream, a); }
#endif
}
```

```cpp
#include <hip/hip_runtime.h>
#include <cstdio>
#include <cstdint>
#include <cmath>

#define LAS __attribute__((address_space(3)))
#define GAS __attribute__((address_space(1)))
typedef unsigned short bf16_t;
typedef short bf16x8 __attribute__((ext_vector_type(8)));
typedef short s16x4 __attribute__((ext_vector_type(4)));
typedef float f32x4 __attribute__((ext_vector_type(4)));
typedef float f32x16 __attribute__((ext_vector_type(16)));
typedef unsigned u32x4 __attribute__((ext_vector_type(4)));
typedef unsigned u32x2 __attribute__((ext_vector_type(2)));

constexpr int DM = 1024, NB = 2, SEQ = 16384, T = NB * SEQ, DEPTH = 2;
constexpr int D_IN = 7492, NPROJ = 7680;
constexpr int NEXP = 32, DFF = 512;
constexpr int MAXROWS = 2 * T + NEXP * 256;
constexpr float EPS = 1e-6f;
constexpr int NWAVES = 8, NTHREADS = 512;

constexpr size_t MiB = 1u << 20;
constexpr size_t WS_CTL = 0, CTL_ZERO_BYTES = 1 * MiB;
constexpr size_t WS_COSQ = 1 * MiB, WS_SINQ = 3 * MiB, WS_COSI = 5 * MiB, WS_SINI = 6 * MiB;
constexpr size_t WS_WIN = 8 * MiB;
constexpr size_t WS_WP = 38 * MiB;
constexpr size_t WS_WO = 44 * MiB;
constexpr size_t WS_WR = 48 * MiB;
constexpr size_t WS_MISC = 49 * MiB;
constexpr size_t MS_CNT = 0;
constexpr size_t MS_TE = 64 * 1024;
constexpr size_t MS_TW = MS_TE + 256 * 1024;
constexpr size_t MS_SLOT = MS_TW + 256 * 1024;
constexpr size_t MS_WSLOT = MS_SLOT + 256 * 1024;
constexpr size_t MS_TILE = MS_WSLOT + 320 * 1024;
constexpr size_t WS_R = 52 * MiB;
constexpr size_t R_HB = 0, R_VA = 64 * MiB, R_CC = 96 * MiB, R_CX = 128 * MiB, R_SCR = 0  , R_YB = 128 * MiB  , R_UA = 160 * MiB, R_Q = 192 * MiB,
                 R_K = 224 * MiB, R_VB = 256 * MiB, R_CB = 288 * MiB, R_QI = 320 * MiB, R_KI = 336 * MiB, R_WI = 340 * MiB, R_G8 = 342 * MiB, R_MASK = 438 * MiB,
                 R_MERGED = 224 * MiB  , R_MIX_END = 502 * MiB;
constexpr size_t R_WGU = 0, R_WD = 64 * MiB, R_HB2 = 96 * MiB, R_LOG = 160 * MiB, R_XS = 168 * MiB, R_HID = 312 * MiB, R_MOE_END = 384 * MiB;
constexpr size_t WS_END = WS_R + R_MIX_END;
static_assert((size_t)MAXROWS * 2048 <= 144 * MiB && (size_t)MAXROWS * 1024 <= 72 * MiB, "moe buffers");
constexpr size_t SCR_PER_WG = 512 * 1024;

constexpr int CW_ERR = 0;
constexpr int CW_WQ = 1024;
constexpr int CW_BAR = 4096;

constexpr int RING_BYTES = 131072;
constexpr float QK_PRESCALE = 1.4426950408889634f * 0.08838834764831845f;
constexpr int LDS_BYTES = 163840;
constexpr int MISC_OFF = LDS_BYTES - 256;

__host__ __device__ __forceinline__ size_t ki_chunk(int b, int s, int chunk  ) {
    const int st = s >> 7, ko = s & 127, a = ko >> 5, j = (ko >> 2) & 7, c = ko & 3, m = 4 * a + c, half = chunk >> 2, g4 = chunk & 3;
    return ((((size_t)(b * 128 + st) * 8 + j) * 2 + half) * 64 + g4 * 16 + m) * 8;
}
#define LDS_WAIT() asm volatile("s_waitcnt lgkmcnt(0)" ::: "memory")
#define VM_WAIT() asm volatile("s_waitcnt vmcnt(0)" ::: "memory")
#define SBAR() __builtin_amdgcn_sched_barrier(0)
__device__ __forceinline__ unsigned cvtpk(float lo, float hi) { unsigned r; asm volatile("v_cvt_pk_bf16_f32 %0, %1, %2" : "=v"(r) : "v"(lo), "v"(hi)); return r; }
__device__ __forceinline__ float bf_lo(unsigned w) { return __uint_as_float(w << 16); }
__device__ __forceinline__ float bf_hi(unsigned w) { return __uint_as_float(w & 0xffff0000u); }
__device__ __forceinline__ unsigned wave_sum_u(unsigned v) {
    v += (unsigned)__builtin_amdgcn_update_dpp(0, (int)v, 0xB1, 0xF, 0xF, true);
    v += (unsigned)__builtin_amdgcn_update_dpp(0, (int)v, 0x4E, 0xF, 0xF, true);
    v += (unsigned)__builtin_amdgcn_update_dpp(0, (int)v, 0x141, 0xF, 0xF, true);
    v += (unsigned)__builtin_amdgcn_update_dpp(0, (int)v, 0x140, 0xF, 0xF, true);
    return (unsigned)__builtin_amdgcn_readlane((int)v, 0) + (unsigned)__builtin_amdgcn_readlane((int)v, 16) + (unsigned)__builtin_amdgcn_readlane((int)v, 32) + (unsigned)__builtin_amdgcn_readlane((int)v, 48);
}
__device__ __forceinline__ float wave_sum(float v) {
    v += __int_as_float(__builtin_amdgcn_update_dpp(0, __float_as_int(v), 0xB1, 0xF, 0xF, true));
    v += __int_as_float(__builtin_amdgcn_update_dpp(0, __float_as_int(v), 0x4E, 0xF, 0xF, true));
    v += __int_as_float(__builtin_amdgcn_update_dpp(0, __float_as_int(v), 0x141, 0xF, 0xF, true));
    v += __int_as_float(__builtin_amdgcn_update_dpp(0, __float_as_int(v), 0x140, 0xF, 0xF, true));
    return (__int_as_float(__builtin_amdgcn_readlane(__float_as_int(v), 0)) + __int_as_float(__builtin_amdgcn_readlane(__float_as_int(v), 16))) +
           (__int_as_float(__builtin_amdgcn_readlane(__float_as_int(v), 32)) + __int_as_float(__builtin_amdgcn_readlane(__float_as_int(v), 48)));
}
__device__ __forceinline__ float relu_f(float x) { const int xi = __float_as_int(x); return __int_as_float(xi > 0 ? xi : 0); }
__device__ __forceinline__ float fast_sigmoid(float x) { return __builtin_amdgcn_rcpf(1.0f + __builtin_amdgcn_exp2f(-1.4426950408889634f * x)); }
__device__ __forceinline__ float gelu_tanh(float x) { const float z = 0.7978845608028654f * (x + 0.044715f * x * x * x); return x * fast_sigmoid(2.0f * z); }

#define XB_TMO      128
#define XB_XCNT(j)  (256  + 64 * (j))
#define XB_XSUB(j)  (1280 + 64 * (j))
#define XB_XGEN(j)  (2304 + 64 * (j))
#define XB_TOP      3328
#define XB_TOPGEN   3392
#define XCD_BAR_WORDS 3456
#define XB_SPIN_CAP (1u << 18)

__device__ __forceinline__ unsigned xb_ld(unsigned* p)              { return __hip_atomic_load(p, __ATOMIC_RELAXED, __HIP_MEMORY_SCOPE_AGENT); }
__device__ __forceinline__ unsigned xb_add(unsigned* p, unsigned v) { return __hip_atomic_fetch_add(p, v, __ATOMIC_RELAXED, __HIP_MEMORY_SCOPE_AGENT); }
__device__ __forceinline__ unsigned xb_xcc_id() { return (unsigned)__builtin_amdgcn_s_getreg((3 << 11) | 20) & 0xFu; }
#define XB_SPIN(cond, bar) do { unsigned _sp = 0; while (cond) { __builtin_amdgcn_s_sleep(1); \
    if ((++_sp & 255u) == 0u) { if (xb_ld(&(bar)[XB_TMO])) break; if (_sp > XB_SPIN_CAP) { atomicAdd(&(bar)[XB_TMO], 1u); break; } } } } while (0)

struct XcdBarrier {
    unsigned* bar; unsigned x;
    volatile LAS unsigned* st;
};

__device__ __forceinline__ XcdBarrier xcd_barrier_post(unsigned* bar, volatile LAS unsigned* st) {
    XcdBarrier b; b.bar = bar; b.x = xb_xcc_id(); b.st = st;
    if (threadIdx.x == 0) (void)xb_add(&bar[XB_XCNT(b.x)], 1u);
    return b;
}
__device__ __forceinline__ void xcd_barrier_complete(unsigned* bar, unsigned x, unsigned& nloc, unsigned& nx) {
    const unsigned G = gridDim.x * gridDim.y * gridDim.z;
    unsigned sum, cnt, mine, sp = 0u;
    for (;;) {
        sum = 0u; cnt = 0u; mine = 0u;
#pragma unroll
        for (unsigned j = 0; j < 16; ++j) { const unsigned c = xb_ld(&bar[XB_XCNT(j)]); sum += c; cnt += (c > 0u) ? 1u : 0u; mine = (j == x) ? c : mine; }
        if (sum == G) break;
        __builtin_amdgcn_s_sleep(1);
        if ((++sp & 255u) == 0u) { if (xb_ld(&bar[XB_TMO])) break; if (sp > XB_SPIN_CAP) { atomicAdd(&bar[XB_TMO], 1u); break; } }
    }
    nloc = mine > 0u ? mine : 1u; nx = cnt > 0u ? cnt : 1u;
}

__device__ __forceinline__ void xcd_barrier(const XcdBarrier& b) {
    asm volatile("s_waitcnt vmcnt(0)" ::: "memory");
    __syncthreads();
    unsigned xb_t = threadIdx.x; asm volatile("" : "+v"(xb_t));
    if (xb_t == 0) {
        unsigned* bar = b.bar;
        __builtin_amdgcn_s_waitcnt(0);
        unsigned nloc = b.st[0], nx = b.st[1];
        if (nloc == 0u) { xcd_barrier_complete(bar, b.x, nloc, nx); b.st[0] = nloc; b.st[1] = nx; }
        const unsigned old = xb_add(&bar[XB_XSUB(b.x)], 1u);
        const unsigned gen = old / nloc;
        if (old + 1u == (gen + 1u) * nloc) {
            __builtin_amdgcn_fence(__ATOMIC_RELEASE, "agent");
            asm volatile("s_waitcnt vmcnt(0)" ::: "memory");
            const unsigned og = xb_add(&bar[XB_TOP], 1u);
            const unsigned tg = og / nx;
            if (og + 1u == (tg + 1u) * nx) xb_add(&bar[XB_TOPGEN], 1u);
            else XB_SPIN(xb_ld(&bar[XB_TOPGEN]) == tg, bar);
            __builtin_amdgcn_fence(__ATOMIC_ACQUIRE, "agent");
            xb_add(&bar[XB_XGEN(b.x)], 1u);
            asm volatile("s_waitcnt vmcnt(0)" ::: "memory");
        } else {
            XB_SPIN(xb_ld(&bar[XB_XGEN(b.x)]) == gen, bar);
            __builtin_amdgcn_fence(__ATOMIC_ACQUIRE, "agent");
            asm volatile("s_waitcnt vmcnt(0)" ::: "memory");
        }
    }
    __syncthreads();
}
namespace pg8 {
#ifndef PG8_WGM
#define PG8_WGM 8
#endif
constexpr int BM = 256, BK = 64, HALF = 128, HTB = HALF * BK * 2, STAGE_BYTES = 8 * HTB, NXCD = 8, WGM = PG8_WGM;
__host__ __device__ __forceinline__ int lds_byte(int r, int c) { const int st = (r >> 4) * 2 + (c >> 5), rr = r & 15, cc = c & 31, ob = rr * 64 + cc * 2; return st * 1024 + (ob ^ (((ob >> 9) & 1) << 5)); }
__host__ __device__ __forceinline__ void stage_rc(int b, int& R, int& C) { const int st = b / 1024, sb = b % 1024, swz = sb ^ (((sb >> 9) & 1) << 5); R = (st >> 1) * 16 + swz / 64; C = (st & 1) * 32 + (swz % 64) / 2; }
__host__ __device__ __forceinline__ int perm32(int rho) { const int n = rho >> 4, i = rho & 15; return 8 * (i >> 2) + 4 * n + (i & 3); }

struct Unit { const char* a; const char* b; int pm, pn, z; };

struct DenseOrder {
    const char* A; const char* Bt; int K; int nM, nN, nwg, G, c;
    __device__ void init(const void* A_, const void* Bt_, int M, int N, int K_, int G_, int c_) { A = (const char*)A_; Bt = (const char*)Bt_; K = K_; nM = M / BM; nN = N / BM; nwg = nM * nN; G = G_; c = c_; }
    __device__ bool next(int i, Unit& u) const {
        const long L = (long)i * G + c; if (L >= nwg) return false;
        int wgid = (int)L; { const int q = nwg / NXCD, r = nwg % NXCD, xcd = wgid % NXCD, off = wgid / NXCD; wgid = (xcd < r ? xcd * (q + 1) : r * (q + 1) + (xcd - r) * q) + off; }
        const int nig = WGM * nN, gid = wgid / nig, fm = gid * WGM, gsz = (nM - fm) < WGM ? (nM - fm) : WGM;
        u.pm = fm + ((wgid % nig) % gsz); u.pn = (wgid % nig) / gsz; u.z = 0;
        u.a = A + (size_t)u.pm * BM * K * 2; u.b = Bt + (size_t)u.pn * BM * K * 2; return true;
    }
};

template <class Epi, class Sched>
__device__ __forceinline__ void gemm_phase(LAS unsigned char* lds, const int K, const Sched& S, const Epi& E, const int stag = 0  ) {
    int tid_ = threadIdx.x; asm volatile("" : "+v"(tid_));
    const int tid = tid_, wid = __builtin_amdgcn_readfirstlane(tid >> 6), lane = tid & 63, wr = wid >> 2, wc = wid & 3, fr = lane & 15, fq = lane >> 4;
    const int nt = K / BK;
    unsigned voffA[2], voffB[2];
#pragma unroll
    for (int i = 0; i < 2; ++i) { int R, C; stage_rc(tid * 16 + i * 8192, R, C); const int Rb = Epi::PERM ? ((R & ~31) + perm32(R & 31)) : R;
        voffA[i] = (unsigned)(R * K + C) * 2u; voffB[i] = (unsigned)(Rb * K + C) * 2u; }
    const size_t kstep = (size_t)(BK * 2);
    const size_t hstep = (size_t)HALF * K * 2;
    const unsigned ldsw = (unsigned)wid * 1024u;
    const int aoff = lds_byte(wr * 64 + fr, fq * 8), boff = lds_byte(wc * 32 + fr, fq * 8);
#define PG8_SA(b, h) (((b) * 2 + (h)) * HTB)
#define PG8_SB(b, h) ((4 + (b) * 2 + (h)) * HTB)
#define PG8_STAGE(bufoff, gbase, voff) do { _Pragma("unroll") for (int _i = 0; _i < 2; ++_i) \
        __builtin_amdgcn_global_load_lds((const unsigned*)((const char*)(gbase) + (voff)[_i]), (LAS unsigned*)(lds + (bufoff) + ldsw + _i * 8192), 16, 0, 0); } while (0)
#define PG8_LDA(dst, b, h) do { _Pragma("unroll") for (int m = 0; m < 4; ++m) _Pragma("unroll") for (int k = 0; k < 2; ++k) dst[m][k] = *(const LAS bf16x8*)(lds + PG8_SA(b, h) + aoff + m * 2048 + k * 1024); } while (0)
#define PG8_LDB(dst, b, h) do { _Pragma("unroll") for (int n = 0; n < 2; ++n) _Pragma("unroll") for (int k = 0; k < 2; ++k) dst[n][k] = *(const LAS bf16x8*)(lds + PG8_SB(b, h) + boff + n * 2048 + k * 1024); } while (0)
#define PG8_MMA(ai, bj, At, Bt) do { __builtin_amdgcn_s_setprio(1); _Pragma("unroll") for (int m = 0; m < 4; ++m) _Pragma("unroll") for (int n = 0; n < 2; ++n) _Pragma("unroll") for (int k = 0; k < 2; ++k) \
        acc[ai][bj][m][n] = __builtin_amdgcn_mfma_f32_16x16x32_bf16(Bt[n][k], At[m][k], acc[ai][bj][m][n], 0, 0, 0); __builtin_amdgcn_s_setprio(0); } while (0)
#define PG8_WAIT_V(n) asm volatile("s_waitcnt vmcnt(" #n ")" ::: "memory")
#define PG8_WAIT_L(n) asm volatile("s_waitcnt lgkmcnt(" #n ")" ::: "memory")
#define PG8_BAR __builtin_amdgcn_s_barrier()
#define PG8_SCHED __builtin_amdgcn_sched_barrier(0)
    Unit cur, nxt; int ui = 0;
    if (!S.next(0, cur)) return;
    for (int i_ = 0; i_ < stag; ++i_) __builtin_amdgcn_s_sleep(127);
    f32x4 acc[2][2][4][2];
#pragma unroll
    for (int a = 0; a < 2; ++a)
#pragma unroll
        for (int b = 0; b < 2; ++b)
#pragma unroll
            for (int m = 0; m < 4; ++m)
#pragma unroll
                for (int n = 0; n < 2; ++n) acc[a][b][m][n] = (f32x4){0.f, 0.f, 0.f, 0.f};
    bf16x8 At[4][2], B0[2][2], B1[2][2];
    const char* cA = cur.a; const char* cB = cur.b;
    PG8_STAGE(PG8_SB(0, 0), cB, voffB); PG8_STAGE(PG8_SA(0, 0), cA, voffA); PG8_STAGE(PG8_SB(0, 1), cB + hstep, voffB); PG8_STAGE(PG8_SA(0, 1), cA + hstep, voffA);
    if (wr == 1) PG8_BAR;
    PG8_WAIT_V(4); PG8_BAR;
    PG8_STAGE(PG8_SB(1, 0), cB + kstep, voffB); PG8_STAGE(PG8_SA(1, 0), cA + kstep, voffA); PG8_STAGE(PG8_SB(1, 1), cB + hstep + kstep, voffB);
    PG8_WAIT_V(6); PG8_BAR;
    for (;;) {
        const bool has_next = S.next(ui + 1, nxt);
        const char* nA = has_next ? nxt.a : cA; const char* nB = has_next ? nxt.b : cB;
        for (int t = 0; t < nt; t += 2) {
            const bool last = (t == nt - 2);
            const char* a1 = cA + (size_t)(t + 1) * kstep;
            const char* a2 = last ? nA : cA + (size_t)(t + 2) * kstep; const char* b2 = last ? nB : cB + (size_t)(t + 2) * kstep;
            const char* a3 = a2 + kstep; const char* b3 = b2 + kstep;
            PG8_LDB(B0, 0, 0); PG8_SCHED; PG8_LDA(At, 0, 0); PG8_STAGE(PG8_SA(1, 1), a1 + hstep, voffA);
            PG8_WAIT_L(8); PG8_BAR; PG8_WAIT_L(0); PG8_MMA(0, 0, At, B0); PG8_BAR; PG8_SCHED;
            PG8_LDB(B1, 0, 1); PG8_STAGE(PG8_SB(0, 0), b2, voffB);
            PG8_BAR; PG8_WAIT_L(0); PG8_MMA(0, 1, At, B1); PG8_BAR;
            PG8_LDA(At, 0, 1); PG8_STAGE(PG8_SA(0, 0), a2, voffA);
            PG8_BAR; PG8_WAIT_L(0); PG8_MMA(1, 0, At, B0); PG8_BAR; PG8_SCHED;
            PG8_STAGE(PG8_SB(0, 1), b2 + hstep, voffB);
            PG8_WAIT_V(6); PG8_BAR; PG8_MMA(1, 1, At, B1); PG8_BAR;
            PG8_LDB(B0, 1, 0); PG8_SCHED; PG8_LDA(At, 1, 0); PG8_STAGE(PG8_SA(0, 1), a2 + hstep, voffA);
            PG8_WAIT_L(8); PG8_BAR; PG8_WAIT_L(0); PG8_MMA(0, 0, At, B0); PG8_BAR; PG8_SCHED;
            PG8_LDB(B1, 1, 1); PG8_STAGE(PG8_SB(1, 0), b3, voffB);
            PG8_BAR; PG8_WAIT_L(0); PG8_MMA(0, 1, At, B1); PG8_BAR;
            PG8_LDA(At, 1, 1); PG8_STAGE(PG8_SA(1, 0), a3, voffA);
            PG8_BAR; PG8_WAIT_L(0); PG8_MMA(1, 0, At, B0); PG8_BAR; PG8_SCHED;
            PG8_STAGE(PG8_SB(1, 1), b3 + hstep, voffB);
            PG8_WAIT_V(6); PG8_BAR; PG8_MMA(1, 1, At, B1); PG8_BAR;
        }
        E(acc, cur, wr, wc, fr, fq);
        if (!has_next) break;
        if (!Epi::KEEP || cur.z >= Epi::KEEP)
#pragma unroll
        for (int a = 0; a < 2; ++a)
#pragma unroll
            for (int b = 0; b < 2; ++b)
#pragma unroll
                for (int m = 0; m < 4; ++m)
#pragma unroll
                    for (int n = 0; n < 2; ++n) acc[a][b][m][n] = (f32x4){0.f, 0.f, 0.f, 0.f};
        cur = nxt; cA = nA; cB = nB; ++ui;
    }
    PG8_WAIT_V(0);
    if (wr == 0) PG8_BAR;
    PG8_BAR;
#undef PG8_SA
#undef PG8_SB
#undef PG8_STAGE
#undef PG8_LDA
#undef PG8_LDB
#undef PG8_MMA
#undef PG8_WAIT_V
#undef PG8_WAIT_L
#undef PG8_BAR
#undef PG8_SCHED
}
}
__host__ __device__ __forceinline__ int ropemap128(int o) { if (o >= 32) return o; const int a = o >> 3, b = o & 7; return b < 4 ? 4 * a + b : 16 + 4 * a + (b - 4); }
__host__ __device__ __forceinline__ int ropemap64(int o) { if (o >= 16) return o; const int a = o >> 3, b = o & 7; return b < 4 ? 4 * a + b : 8 + 4 * a + (b - 4); }
__host__ __device__ __forceinline__ int colmap_proj(int s) {
    if (s < 1024) return s;
    if (s < 2048) { const int base = s < 1536 ? 1024 : 1536, o = s - base; return base + (o & ~127) + ropemap128(o & 127); }
    if (s < 2560) return s;
    if (s < 2816) { const int o = s - 2560; return 2560 + (o & ~63) + ropemap64(o & 63); }
    if (s < 3072) { const int o = s - 2816; if (o < 64) return 2816 + ropemap64(o); if (o < 68) return 2880 + (o - 64); return -1; }
    if (s < 4608) return 2884 + (s - 3072);
    return 4420 + (s - 4608);
}

struct EpiProj {
    static constexpr bool PERM = true; static constexpr int KEEP = 0;
    unsigned char* wsb;
    __device__ __forceinline__ void operator()(const f32x4 (&acc)[2][2][4][2], const pg8::Unit& u, int wr, int wc, int fr, int fq) const {
        asm volatile("" : "+v"(fr), "+v"(fq));
        unsigned char* const Rr = wsb + WS_R;
        bf16_t* const UA = (bf16_t*)(Rr + R_UA); bf16_t* const VA = (bf16_t*)(Rr + R_VA); bf16_t* const Q = (bf16_t*)(Rr + R_Q); bf16_t* const Kk = (bf16_t*)(Rr + R_K); bf16_t* const VB = (bf16_t*)(Rr + R_VB);
        bf16_t* const QI = (bf16_t*)(Rr + R_QI); bf16_t* const KI = (bf16_t*)(Rr + R_KI); bf16_t* const CB = (bf16_t*)(Rr + R_CB); bf16_t* const CC = (bf16_t*)(Rr + R_CC); bf16_t* const CX = (bf16_t*)(Rr + R_CX);
        float* const WI = (float*)(Rr + R_WI); unsigned char* const G8 = Rr + R_G8;
        const float* const cosq = (const float*)(wsb + WS_COSQ); const float* const sinq = (const float*)(wsb + WS_SINQ); const float* const cosi = (const float*)(wsb + WS_COSI); const float* const sini = (const float*)(wsb + WS_SINI);
        const int pn = u.pn;
        const int row0 = u.pm * 256 + wr * 64 + fr;
        const int cw = wc * 32 + 8 * fq;
        if (pn < 4 || (pn >= 8 && pn < 10) || (pn >= 12 && pn < 18)) {
            bf16_t* base; int ld = 512, c0 = (pn & 1) * 256;
            if (pn < 2) base = UA; else if (pn < 4) base = VA; else if (pn < 10) base = VB; else if (pn < 14) base = CB; else if (pn < 16) base = CC; else base = CX;
            const bool act = pn < 4;
#pragma unroll
            for (int ai = 0; ai < 2; ++ai)
#pragma unroll
                for (int m = 0; m < 4; ++m) { bf16_t* rowp = base + (size_t)(row0 + ai * 128 + m * 16) * ld + c0 + cw;
#pragma unroll
                    for (int bj = 0; bj < 2; ++bj) { f32x4 v0 = acc[ai][bj][m][0], v1 = acc[ai][bj][m][1];
                        if (act) {
#pragma unroll
                            for (int j = 0; j < 4; ++j) { v0[j] = gelu_tanh(v0[j]); v1[j] = gelu_tanh(v1[j]); } }
                        u32x4 w; w.x = cvtpk(v0[0], v0[1]); w.y = cvtpk(v0[2], v0[3]); w.z = cvtpk(v1[0], v1[1]); w.w = cvtpk(v1[2], v1[3]);
                        *(u32x4*)(rowp + bj * 128) = w; } }
        } else if (pn < 8) {
            bf16_t* base = pn < 6 ? Q : Kk; const int c0 = (pn & 1) * 256;
            f32x4 cs[2][4], sn[2][4];
#pragma unroll
            for (int ai = 0; ai < 2; ++ai)
#pragma unroll
                for (int m = 0; m < 4; ++m) { const int row = row0 + ai * 128 + m * 16; cs[ai][m] = (f32x4){1.f, 1.f, 1.f, 1.f}; sn[ai][m] = (f32x4){0.f, 0.f, 0.f, 0.f};
                    if (wc == 0) { cs[ai][m] = *(const f32x4*)(cosq + (size_t)row * 16 + 4 * fq); sn[ai][m] = *(const f32x4*)(sinq + (size_t)row * 16 + 4 * fq); } }
#pragma unroll
            for (int ai = 0; ai < 2; ++ai)
#pragma unroll
                for (int m = 0; m < 4; ++m) { const int row = row0 + ai * 128 + m * 16; bf16_t* rowp = base + (size_t)row * 512 + c0 + cw;
#pragma unroll
                    for (int bj = 0; bj < 2; ++bj) { const f32x4 x1 = acc[ai][bj][m][0], x2 = acc[ai][bj][m][1];
                        f32x4 v0 = x1, v1 = x2;
                        if (wc == 0) { v0 = x1 * cs[ai][m] - x2 * sn[ai][m]; v1 = x1 * sn[ai][m] + x2 * cs[ai][m]; }
                        u32x4 w; w.x = cvtpk(v0[0], v0[1]); w.y = cvtpk(v0[2], v0[3]); w.z = cvtpk(v1[0], v1[1]); w.w = cvtpk(v1[2], v1[3]);
                        *(u32x4*)(rowp + bj * 128) = w; } }
        } else if (pn == 10) {
            const bool rot = ((wc & 1) == 0) && fq < 2;
            f32x4 cs[2][4], sn[2][4];
#pragma unroll
            for (int ai = 0; ai < 2; ++ai)
#pragma unroll
                for (int m = 0; m < 4; ++m) { const int row = row0 + ai * 128 + m * 16; cs[ai][m] = (f32x4){1.f, 1.f, 1.f, 1.f}; sn[ai][m] = (f32x4){0.f, 0.f, 0.f, 0.f};
                    if (rot) { cs[ai][m] = *(const f32x4*)(cosi + (size_t)row * 8 + 4 * fq); sn[ai][m] = *(const f32x4*)(sini + (size_t)row * 8 + 4 * fq); } }
#pragma unroll
            for (int ai = 0; ai < 2; ++ai)
#pragma unroll
                for (int m = 0; m < 4; ++m) { const int row = row0 + ai * 128 + m * 16; bf16_t* rowp = QI + (size_t)row * 256 + cw;
#pragma unroll
                    for (int bj = 0; bj < 2; ++bj) { const f32x4 x1 = acc[ai][bj][m][0], x2 = acc[ai][bj][m][1];
                        const f32x4 v0 = x1 * cs[ai][m] - x2 * sn[ai][m], v1 = x1 * sn[ai][m] + x2 * cs[ai][m];
                        u32x4 w; w.x = cvtpk(v0[0], v0[1]); w.y = cvtpk(v0[2], v0[3]); w.z = cvtpk(v1[0], v1[1]); w.w = cvtpk(v1[2], v1[3]);
                        *(u32x4*)(rowp + bj * 128) = w; } }
        } else if (pn == 11) {
            const bool rot = (wc == 0) && fq < 2;
            f32x4 cs[2][4], sn[2][4];
#pragma unroll
            for (int ai = 0; ai < 2; ++ai)
#pragma unroll
                for (int m = 0; m < 4; ++m) { const int row = row0 + ai * 128 + m * 16; cs[ai][m] = (f32x4){1.f, 1.f, 1.f, 1.f}; sn[ai][m] = (f32x4){0.f, 0.f, 0.f, 0.f};
                    if (rot) { cs[ai][m] = *(const f32x4*)(cosi + (size_t)row * 8 + 4 * fq); sn[ai][m] = *(const f32x4*)(sini + (size_t)row * 8 + 4 * fq); } }
#pragma unroll
            for (int ai = 0; ai < 2; ++ai)
#pragma unroll
                for (int m = 0; m < 4; ++m) { const int row = row0 + ai * 128 + m * 16;
                    if (wc < 2) {
                        const f32x4 x1 = acc[ai][0][m][0], x2 = acc[ai][0][m][1];
                        const f32x4 v0 = x1 * cs[ai][m] - x2 * sn[ai][m], v1 = x1 * sn[ai][m] + x2 * cs[ai][m];
                        u32x4 w; w.x = cvtpk(v0[0], v0[1]); w.y = cvtpk(v0[2], v0[3]); w.z = cvtpk(v1[0], v1[1]); w.w = cvtpk(v1[2], v1[3]);
                        *(u32x4*)(KI + ki_chunk(row >> 14, row & (SEQ - 1), cw >> 3)) = w;
                    } else if (wc == 2 && fq == 0) {
                        *(f32x4*)(WI + (size_t)row * 4) = acc[ai][0][m][0] * 0.0625f;
                    } }
        } else {
            unsigned char* base = G8 + (size_t)(pn - 18) * 256 + wc * 64 + 8 * fq;
#pragma unroll
            for (int ai = 0; ai < 2; ++ai)
#pragma unroll
                for (int m = 0; m < 4; ++m) { unsigned char* rowp = base + (size_t)(row0 + ai * 128 + m * 16) * 3072;
#pragma unroll
                    for (int bj = 0; bj < 2; ++bj) { const f32x4 v0 = acc[ai][bj][m][0], v1 = acc[ai][bj][m][1];
                        unsigned q[8];
#pragma unroll
                        for (int j = 0; j < 4; ++j) { q[j] = (unsigned)(fast_sigmoid(v0[j]) * 255.0f + 0.5f); q[4 + j] = (unsigned)(fast_sigmoid(v1[j]) * 255.0f + 0.5f); }
                        u32x2 w; w.x = q[0] | (q[1] << 8) | (q[2] << 16) | (q[3] << 24); w.y = q[4] | (q[5] << 8) | (q[6] << 16) | (q[7] << 24);
                        *(u32x2*)(rowp + bj * 32) = w; } }
        }
    }
};

struct EpiMerge {
    static constexpr bool PERM = true; static constexpr int KEEP = 2;
    bf16_t* MG; const unsigned char* G8;
    __device__ __forceinline__ void operator()(f32x4 (&acc)[2][2][4][2], const pg8::Unit& u, int wr, int wc, int fr, int fq) const {
        asm volatile("" : "+v"(fr), "+v"(fq));
        const int row0 = u.pm * 256 + wr * 64 + fr, col0 = u.pn * 256 + wc * 32 + 8 * fq, z = u.z;
        const int gcol = u.pn * 256 + wc * 64 + 8 * fq;
#define G8F(w, k) fmaxf((float)(((w) >> (8 * (k))) & 255u), 1.0f)
        if (z < 2) {
#pragma unroll
            for (int ai = 0; ai < 2; ++ai) {
                u32x2 ga[4][2], gb[4][2];
#pragma unroll
                for (int m = 0; m < 4; ++m)
#pragma unroll
                    for (int bj = 0; bj < 2; ++bj) { const unsigned char* gp = G8 + (size_t)(row0 + ai * 128 + m * 16) * 3072 + z * 1024 + gcol + bj * 32;
                        ga[m][bj] = *(const u32x2*)gp; gb[m][bj] = *(const u32x2*)(gp + 1024); }
#pragma unroll
                for (int m = 0; m < 4; ++m)
#pragma unroll
                    for (int bj = 0; bj < 2; ++bj) { const u32x2 a = ga[m][bj], b = gb[m][bj];
#pragma unroll
                        for (int k = 0; k < 4; ++k) { acc[ai][bj][m][0][k] *= G8F(a.x, k) * __builtin_amdgcn_rcpf(G8F(b.x, k)); acc[ai][bj][m][1][k] *= G8F(a.y, k) * __builtin_amdgcn_rcpf(G8F(b.y, k)); } }
                SBAR(); }
        } else {
            const float s = 1.0f / 255.0f;
#pragma unroll
            for (int ai = 0; ai < 2; ++ai) {
                u32x2 g[4][2];
#pragma unroll
                for (int m = 0; m < 4; ++m)
#pragma unroll
                    for (int bj = 0; bj < 2; ++bj) g[m][bj] = *(const u32x2*)(G8 + (size_t)(row0 + ai * 128 + m * 16) * 3072 + 2 * 1024 + gcol + bj * 32);
#pragma unroll
                for (int m = 0; m < 4; ++m)
#pragma unroll
                    for (int bj = 0; bj < 2; ++bj) { const int row = row0 + ai * 128 + m * 16; const u32x2 gg = g[m][bj]; const f32x4 a0 = acc[ai][bj][m][0], a1 = acc[ai][bj][m][1];
                        u32x4 w;
                        w.x = cvtpk(a0[0] * (G8F(gg.x, 0) * s), a0[1] * (G8F(gg.x, 1) * s)); w.y = cvtpk(a0[2] * (G8F(gg.x, 2) * s), a0[3] * (G8F(gg.x, 3) * s));
                        w.z = cvtpk(a1[0] * (G8F(gg.y, 0) * s), a1[1] * (G8F(gg.y, 1) * s)); w.w = cvtpk(a1[2] * (G8F(gg.y, 2) * s), a1[3] * (G8F(gg.y, 3) * s));
                        *(u32x4*)(MG + (size_t)row * 1024 + col0 + bj * 128) = w; }
                SBAR(); }
        }
#undef G8F
    }
};
struct MergeOrder {
    const char* Rb; const char* Wb; int G, c;
    __device__ bool next(int i, pg8::Unit& u) const {
        const int tile = (i / 3) * G + (((G & 7) == 0) ? (c & 7) * (G >> 3) + (c >> 3) : c);
        if (tile >= 512) return false;
        const int z = i % 3; u.pm = tile >> 2; u.pn = tile & 3; u.z = z;
        const char* a = Rb + (z == 0 ? R_UA : (z == 1 ? R_YB : R_CB)); const char* b = Wb + (size_t)z * DM * 512 * 2;
        u.a = a + (size_t)u.pm * 256 * 512 * 2; u.b = b + (size_t)u.pn * 256 * 512 * 2; return true;
    }
};

struct EpiWoutDelta {
    static constexpr bool PERM = true; static constexpr int KEEP = 0;
    bf16_t* DLp;
    __device__ __forceinline__ void operator()(const f32x4 (&acc)[2][2][4][2], const pg8::Unit& u, int wr, int wc, int fr, int fq) const {
        asm volatile("" : "+v"(fr), "+v"(fq));
        const int row0 = u.pm * 256 + wr * 64 + fr, col0 = u.pn * 256 + wc * 32 + 8 * fq;
#pragma unroll
        for (int ai = 0; ai < 2; ++ai)
#pragma unroll
            for (int m = 0; m < 4; ++m) { bf16_t* rowp = DLp + (size_t)(row0 + ai * 128 + m * 16) * 1024 + col0;
#pragma unroll
                for (int bj = 0; bj < 2; ++bj) { const f32x4 v0 = acc[ai][bj][m][0], v1 = acc[ai][bj][m][1];
                    u32x4 w; w.x = cvtpk(v0[0], v0[1]); w.y = cvtpk(v0[2], v0[3]); w.z = cvtpk(v1[0], v1[1]); w.w = cvtpk(v1[2], v1[3]);
                    *(u32x4*)(rowp + bj * 128) = w; } }
    }
};
struct EpiWout {
    static constexpr bool PERM = false; static constexpr int KEEP = 0;
    const float* xin; float* xout;
    __device__ __forceinline__ void operator()(const f32x4 (&acc)[2][2][4][2], const pg8::Unit& u, int wr, int wc, int fr, int fq) const {
        asm volatile("" : "+v"(fr), "+v"(fq));
        const int row0 = u.pm * 256 + wr * 64 + fr, col0 = u.pn * 256 + wc * 32 + 4 * fq;
#ifndef WOUT_BATCH
#define WOUT_BATCH 4
#endif
        constexpr int NB = WOUT_BATCH;
#pragma unroll
        for (int ai = 0; ai < 2; ++ai)
#pragma unroll
            for (int mh = 0; mh < 4 / NB; ++mh) {
                f32x4 b[NB][2][2];
#pragma unroll
                for (int m2 = 0; m2 < NB; ++m2) { const size_t off = (size_t)(row0 + ai * 128 + (NB * mh + m2) * 16) * 1024 + col0;
#pragma unroll
                    for (int bj = 0; bj < 2; ++bj)
#pragma unroll
                        for (int n = 0; n < 2; ++n) b[m2][bj][n] = *(const f32x4*)(xin + off + bj * 128 + n * 16); }
#pragma unroll
                for (int m2 = 0; m2 < NB; ++m2) { const size_t off = (size_t)(row0 + ai * 128 + (NB * mh + m2) * 16) * 1024 + col0;
#pragma unroll
                    for (int bj = 0; bj < 2; ++bj)
#pragma unroll
                        for (int n = 0; n < 2; ++n) *(f32x4*)(xout + off + bj * 128 + n * 16) = b[m2][bj][n] + acc[ai][bj][NB * mh + m2][n]; }
                SBAR(); }
    }
};
struct EpiRouter {
    static constexpr bool PERM = false; static constexpr int KEEP = 0;
    float* LOG;
    __device__ __forceinline__ void operator()(const f32x4 (&acc)[2][2][4][2], const pg8::Unit& u, int wr, int wc, int fr, int fq) const {
        asm volatile("" : "+v"(fr), "+v"(fq));
        if (wc >= 2) return;
        const int row0 = u.pm * 256 + wr * 64 + fr, col0 = wc * 32 + 4 * fq;
#pragma unroll
        for (int ai = 0; ai < 2; ++ai)
#pragma unroll
            for (int m = 0; m < 4; ++m)
#pragma unroll
                for (int n = 0; n < 2; ++n) *(f32x4*)(LOG + (size_t)(row0 + ai * 128 + m * 16) * 64 + col0 + n * 16) = acc[ai][0][m][n];
    }
};
struct EpiGateUp {
    static constexpr bool PERM = true; static constexpr int KEEP = 0;
    bf16_t* HID;
    __device__ __forceinline__ void operator()(const f32x4 (&acc)[2][2][4][2], const pg8::Unit& u, int wr, int wc, int fr, int fq) const {
        asm volatile("" : "+v"(fr), "+v"(fq));
        const int row0 = u.pm * 256 + wr * 64 + fr, col0 = u.pn * 128 + wc * 16 + 4 * fq;
#pragma unroll
        for (int ai = 0; ai < 2; ++ai)
#pragma unroll
            for (int m = 0; m < 4; ++m) { bf16_t* rowp = HID + (size_t)(row0 + ai * 128 + m * 16) * 512 + col0;
#pragma unroll
                for (int bj = 0; bj < 2; ++bj) { const f32x4 g = acc[ai][bj][m][0], up = acc[ai][bj][m][1]; float h[4];
#pragma unroll
                    for (int j = 0; j < 4; ++j) h[j] = g[j] * fast_sigmoid(g[j]) * up[j];
                    u32x2 w; w.x = cvtpk(h[0], h[1]); w.y = cvtpk(h[2], h[3]); *(u32x2*)(rowp + bj * 64) = w; } }
    }
};
struct EpiDown {
    static constexpr bool PERM = true; static constexpr int KEEP = 0;
    bf16_t* CT; const float* wslot;
    __device__ __forceinline__ void operator()(const f32x4 (&acc)[2][2][4][2], const pg8::Unit& u, int wr, int wc, int fr, int fq) const {
        asm volatile("" : "+v"(fr), "+v"(fq));
        const int row0 = u.pm * 256 + wr * 64 + fr, col0 = u.pn * 256 + wc * 32 + 8 * fq;
        float wsl[2][4];
#pragma unroll
        for (int ai = 0; ai < 2; ++ai)
#pragma unroll
            for (int m = 0; m < 4; ++m) wsl[ai][m] = wslot[row0 + ai * 128 + m * 16];
#pragma unroll
        for (int ai = 0; ai < 2; ++ai)
#pragma unroll
            for (int m = 0; m < 4; ++m) { const int row = row0 + ai * 128 + m * 16; const float ws = wsl[ai][m]; bf16_t* rowp = CT + (size_t)row * 1024 + col0;
#pragma unroll
                for (int bj = 0; bj < 2; ++bj) { const f32x4 v0 = acc[ai][bj][m][0] * ws, v1 = acc[ai][bj][m][1] * ws;
                    u32x4 w; w.x = cvtpk(v0[0], v0[1]); w.y = cvtpk(v0[2], v0[3]); w.z = cvtpk(v1[0], v1[1]); w.w = cvtpk(v1[2], v1[3]);
                    *(u32x4*)(rowp + bj * 128) = w; } }
    }
};
struct MoeOrder {
    const char* A; const char* Bt; const int* tiletab; size_t a_tile_bytes, b_exp_bytes, b_tile_bytes; int G, c;
    __device__ bool next(int i, pg8::Unit& u) const {
        const int L = i * G + c; const int ntile = tiletab[0]; if (L >= ntile * 4) return false;
        const int rt = L >> 2, pn = L & 3, e = tiletab[1 + rt];
        u.pm = rt; u.pn = pn; u.z = e; u.a = A + (size_t)rt * a_tile_bytes; u.b = Bt + (size_t)e * b_exp_bytes + (size_t)pn * b_tile_bytes; return true;
    }
};
struct SrcCol { const float* p; int ld; };
struct CvtRegs { f32x4 va[8], vb[8]; };
template <class SrcFn>
__device__ __forceinline__ void cvt_load(CvtRegs& Rg, const SrcFn& src, int k0, int n0, int lane) {
    const int g = lane >> 4, c4 = 4 * (lane & 15);
    const SrcCol sc = src(n0 + c4);
#pragma unroll
    for (int i = 0; i < 8; ++i) { const int k = k0 + 8 * i + 2 * g;
        Rg.va[i] = (f32x4){0.f, 0.f, 0.f, 0.f}; Rg.vb[i] = Rg.va[i];
        if (sc.p) { Rg.va[i] = *(const f32x4*)(sc.p + (size_t)k * sc.ld); Rg.vb[i] = *(const f32x4*)(sc.p + (size_t)(k + 1) * sc.ld); } }
}
__device__ __forceinline__ void cvt_store(const CvtRegs& Rg, bf16_t* dst, int K, int k0, int n0, LAS float* scr_, int lane) {
    LAS unsigned* Tt = (LAS unsigned*)scr_;
    const int g = lane >> 4, c4 = 4 * (lane & 15);
#pragma unroll
    for (int i = 0; i < 8; ++i) {
#pragma unroll
        for (int j = 0; j < 4; ++j) Tt[(c4 + j) * 33 + 4 * i + g] = cvtpk(Rg.va[i][j], Rg.vb[i][j]); }
    LDS_WAIT(); asm volatile("" ::: "memory");
#pragma unroll
    for (int r = 0; r < 8; ++r) { const int n = (lane >> 3) + 8 * r, q = lane & 7; const LAS unsigned* t = Tt + n * 33 + 4 * q;
        u32x4 o; o.x = t[0]; o.y = t[1]; o.z = t[2]; o.w = t[3];
        *(u32x4*)(dst + (size_t)(n0 + n) * K + k0 + 8 * q) = o; }
    LDS_WAIT(); asm volatile("" ::: "memory");
}
template <class SrcFn>
__device__ __forceinline__ void cvt_item(const SrcFn& src, bf16_t* dst, int K, int k0, int n0, LAS float* scr_, int lane, const float scale = 1.0f  ) {
    CvtRegs Rg; cvt_load(Rg, src, k0, n0, lane);
    if (scale != 1.0f) {
#pragma unroll
        for (int i = 0; i < 8; ++i) { Rg.va[i] = Rg.va[i] * scale; Rg.vb[i] = Rg.vb[i] * scale; } }
    cvt_store(Rg, dst, K, k0, n0, scr_, lane);
}
struct SrcWin { const float* w; __device__ SrcCol operator()(int n) const { const int c = colmap_proj(n); return SrcCol{c >= 0 ? w + c : nullptr, D_IN}; } };
struct SrcPlain { const float* w; int ld; __device__ SrcCol operator()(int n) const { return SrcCol{w + n, ld}; } };
struct SrcRouter { const float* wg; const float* we; __device__ SrcCol operator()(int n) const { if (n < 4) return SrcCol{wg + n, 4}; if (n < 36) return SrcCol{we + (n - 4), 32}; return SrcCol{nullptr, 1}; } };
struct SrcGateUp { const float* g; const float* u; __device__ SrcCol operator()(int n) const { const int a = n >> 3, b = n & 7; return b < 4 ? SrcCol{g + 4 * a + b, DFF} : SrcCol{u + 4 * a + (b - 4), DFF}; } };

__device__ __forceinline__ void sincos_f32(float xf, float& s, float& c) {
    const double x = (double)xf;
    const double kd = __builtin_rint(x * 0.63661977236758134308);
    double r = __builtin_fma(-kd, 1.57079632679489655800e+00, x); r = __builtin_fma(-kd, 6.12323399573676603587e-17, r);
    const double r2 = r * r;
    double sp = -2.5052108385441718775e-08; sp = sp * r2 + 2.7557319223985890653e-06; sp = sp * r2 - 1.9841269841269841270e-04; sp = sp * r2 + 8.3333333333333332177e-03; sp = sp * r2 - 1.6666666666666665741e-01;
    const double sr = r + r * r2 * sp;
    double cp = 2.0876756987868098979e-09; cp = cp * r2 - 2.7557319223985888e-07; cp = cp * r2 + 2.4801587301587301566e-05; cp = cp * r2 - 1.3888888888888889419e-03; cp = cp * r2 + 4.1666666666666664354e-02; cp = cp * r2 - 0.5;
    const double cr = 1.0 + r2 * cp;
    const int q = ((int)kd) & 3;
    const double ss = (q & 1) ? cr : sr, cc = (q & 1) ? sr : cr;
    s = (float)((q & 2) ? -ss : ss); c = (float)(((q + 1) & 2) ? -cc : cc);
}

struct RmsRow { f32x4 v[4]; u32x2 a[4], b[4], d[4]; };
__device__ __forceinline__ void rms_load(RmsRow& R_, const float* xrow, const bf16_t* c0, const bf16_t* c1, int lane, const bf16_t* c2 = nullptr) {
    const f32x4* xr = (const f32x4*)xrow + lane;
#pragma unroll
    for (int j = 0; j < 4; ++j) R_.v[j] = xr[64 * j];
    if (c0) {
#pragma unroll
        for (int j = 0; j < 4; ++j) R_.a[j] = *((const u32x2*)c0 + lane + 64 * j); }
    if (c1) {
#pragma unroll
        for (int j = 0; j < 4; ++j) R_.b[j] = *((const u32x2*)c1 + lane + 64 * j); }
    if (c2) {
#pragma unroll
        for (int j = 0; j < 4; ++j) R_.d[j] = *((const u32x2*)c2 + lane + 64 * j); }
}
__device__ __forceinline__ void rms_finish(RmsRow& R_, const int cmask, const float* g, float* xsum_out, bf16_t* hb_out, float* f_out, int lane) {
    float s = 0.f;
#define RMS_ADD(F) do { _Pragma("unroll") for (int j = 0; j < 4; ++j) { const u32x2 a = R_.F[j]; \
            R_.v[j][0] += bf_lo(a.x); R_.v[j][1] += bf_hi(a.x); R_.v[j][2] += bf_lo(a.y); R_.v[j][3] += bf_hi(a.y); } } while (0)
    if (cmask & 4) RMS_ADD(d);
    if (cmask & 1) RMS_ADD(a);
    if (cmask & 2) RMS_ADD(b);
#undef RMS_ADD
#pragma unroll
    for (int j = 0; j < 4; ++j) s += (R_.v[j][0] * R_.v[j][0] + R_.v[j][1] * R_.v[j][1]) + (R_.v[j][2] * R_.v[j][2] + R_.v[j][3] * R_.v[j][3]);
    const float rstd = 1.0f / sqrtf(wave_sum(s) * (1.0f / DM) + EPS);
    if (xsum_out) {
#pragma unroll
        for (int j = 0; j < 4; ++j) *((f32x4*)xsum_out + lane + 64 * j) = R_.v[j]; }
#pragma unroll
    for (int j = 0; j < 4; ++j) { const f32x4 gg = *((const f32x4*)g + lane + 64 * j); const f32x4 o = R_.v[j] * rstd * gg;
        if (hb_out) { u32x2 w; w.x = cvtpk(o[0], o[1]); w.y = cvtpk(o[2], o[3]); *((u32x2*)hb_out + lane + 64 * j) = w; }
        if (f_out) *((f32x4*)f_out + lane + 64 * j) = o; }
}
__device__ __forceinline__ void rms_row(const float* xrow, const bf16_t* c0, const bf16_t* c1, const float* g, float* xsum_out, bf16_t* hb_out, float* f_out, int lane) {
    RmsRow R_; rms_load(R_, xrow, c0, c1, lane); rms_finish(R_, c0 != nullptr ? 3 : 0, g, xsum_out, hb_out, f_out, lane);
}

constexpr int VN_PITCH = 1040;
#define TRRD(dst, addr, off) asm volatile("ds_read_b64_tr_b16 %0, %1 offset:%2" : "=&v"(dst) : "v"(addr), "i"(off) : "memory")
__device__ __forceinline__ void gmlp_conv_item(LAS unsigned char* lds, int item, bf16_t* UA, const bf16_t* VA, bf16_t* CB, const bf16_t* CC, const bf16_t* CX,
                                               const float* ws  , const float* bs  , const float* cw  , int wid, int lane, const bool dry = false  ) {
    const int t0 = item * 128;
#ifndef GM_ABATCH
#define GM_ABATCH 4
#endif
#pragma unroll 1
    for (int p4 = 0; p4 < 16 / GM_ABATCH; ++p4) {
        u32x4 raw[GM_ABATCH];
#pragma unroll
        for (int q = 0; q < GM_ABATCH; ++q) raw[q] = *((const u32x4*)(VA + (size_t)(t0 + wid * 16 + GM_ABATCH * p4 + q) * 512) + lane);
#pragma unroll
        for (int q = 0; q < GM_ABATCH; ++q) { const int p = wid * 16 + GM_ABATCH * p4 + q;
            float x[8] = {bf_lo(raw[q].x), bf_hi(raw[q].x), bf_lo(raw[q].y), bf_hi(raw[q].y), bf_lo(raw[q].z), bf_hi(raw[q].z), bf_lo(raw[q].w), bf_hi(raw[q].w)};
            float s = 0.f;
#pragma unroll
            for (int j = 0; j < 8; ++j) s += x[j];
            const float mean = wave_sum(s) * (1.0f / 512.0f); float qq = 0.f;
#pragma unroll
            for (int j = 0; j < 8; ++j) { x[j] -= mean; qq += x[j] * x[j]; }
            const float rstd = 1.0f / sqrtf(wave_sum(qq) * (1.0f / 512.0f) + EPS);
            u32x4 o; o.x = cvtpk(x[0] * rstd, x[1] * rstd); o.y = cvtpk(x[2] * rstd, x[3] * rstd); o.z = cvtpk(x[4] * rstd, x[5] * rstd); o.w = cvtpk(x[6] * rstd, x[7] * rstd);
            *(LAS u32x4*)(lds + p * VN_PITCH + lane * 16) = o; } }
    LDS_WAIT(); __syncthreads();
    {
        const int g = wid >> 1, i16 = lane & 15, g4 = lane >> 4;
        const float* Wg = ws + (size_t)g * 128 * 128;
        const unsigned trbase = (unsigned)(uintptr_t)lds + (unsigned)((8 * g4 + ((lane >> 2) & 3)) * VN_PITCH + (64 * wid + 4 * (lane & 3)) * 2);
#pragma unroll
        for (int th = 0; th < 2; ++th) {
            f32x4 acc[4][4];
#pragma unroll
            for (int ct = 0; ct < 4; ++ct)
#pragma unroll
                for (int tt = 0; tt < 4; ++tt) acc[ct][tt] = (f32x4){0.f, 0.f, 0.f, 0.f};
#pragma unroll
            for (int ks = 0; ks < 4; ++ks) {
                if (32 * ks > 16 * (4 * th + 3) + 15) continue;
                bf16x8 vf[4];
                const unsigned trk = trbase + (unsigned)(ks * 32 * VN_PITCH);
#pragma unroll
                for (int ct = 0; ct < 4; ++ct) { s16x4 lo, hi;
                    TRRD(lo, trk, ct * 32); TRRD(hi, trk, 4 * VN_PITCH + ct * 32);
                    asm volatile("s_waitcnt lgkmcnt(0)" ::: "memory");
                    vf[ct] = (bf16x8){lo[0], lo[1], lo[2], lo[3], hi[0], hi[1], hi[2], hi[3]}; }
                SBAR();
                f32x4 w0a[4], w1a[4];
#pragma unroll
                for (int t4 = 0; t4 < 4; ++t4) { const int tt = 4 * th + t4; const int tl = 16 * tt + i16, s0 = 32 * ks + 8 * g4;
                    w0a[t4] = *(const f32x4*)(Wg + (size_t)tl * 128 + s0); w1a[t4] = *(const f32x4*)(Wg + (size_t)tl * 128 + s0 + 4); }
#pragma unroll
                for (int t4 = 0; t4 < 4; ++t4) { const int tt = 4 * th + t4;
                    if (32 * ks > 16 * tt + 15) continue;
                    const int tl = 16 * tt + i16, s0 = 32 * ks + 8 * g4;
                    const f32x4 w0 = w0a[t4], w1 = w1a[t4];
                    float wv[8] = {w0[0], w0[1], w0[2], w0[3], w1[0], w1[1], w1[2], w1[3]};
#pragma unroll
                    for (int j = 0; j < 8; ++j) wv[j] = (s0 + j <= tl) ? wv[j] : 0.f;
                    u32x4 wp; wp.x = cvtpk(wv[0], wv[1]); wp.y = cvtpk(wv[2], wv[3]); wp.z = cvtpk(wv[4], wv[5]); wp.w = cvtpk(wv[6], wv[7]);
                    const bf16x8 wf = *reinterpret_cast<const bf16x8*>(&wp);
#pragma unroll
                    for (int ct = 0; ct < 4; ++ct) acc[ct][t4] = __builtin_amdgcn_mfma_f32_16x16x32_bf16(vf[ct], wf, acc[ct][t4], 0, 0, 0);
                }
                SBAR();
            }
            u32x2 uu[4][4]; float bb[4];
#pragma unroll
            for (int t4 = 0; t4 < 4; ++t4) { const int tl = 16 * (4 * th + t4) + i16; bb[t4] = bs[g * 128 + tl];
#pragma unroll
                for (int ct = 0; ct < 4; ++ct) uu[t4][ct] = *(const u32x2*)(UA + (size_t)(t0 + tl) * 512 + 64 * wid + 16 * ct + 4 * g4); }
#pragma unroll
            for (int t4 = 0; t4 < 4; ++t4) { const int tl = 16 * (4 * th + t4) + i16; const float b = bb[t4];
#pragma unroll
                for (int ct = 0; ct < 4; ++ct) { bf16_t* up = UA + (size_t)(t0 + tl) * 512 + 64 * wid + 16 * ct + 4 * g4; const f32x4 a = acc[ct][t4]; const u32x2 u2 = uu[t4][ct];
                    u32x2 o; o.x = cvtpk(bf_lo(u2.x) * (a[0] + b), bf_hi(u2.x) * (a[1] + b)); o.y = cvtpk(bf_lo(u2.y) * (a[2] + b), bf_hi(u2.y) * (a[3] + b));
                    if (!dry) *(u32x2*)up = o; else asm volatile("" :: "v"(o.x), "v"(o.y)); } }
        }
    }
    {
        const int c8 = lane * 8;
        float w0[8], w1[8], w2[8], z1[8], z2[8];
#pragma unroll
        for (int j = 0; j < 8; ++j) { w0[j] = cw[c8 + j]; w1[j] = cw[512 + c8 + j]; w2[j] = cw[1024 + c8 + j]; z1[j] = 0.f; z2[j] = 0.f; }
        const int r0 = t0 + wid * 16, sq0 = r0 & (SEQ - 1);
#pragma unroll
        for (int back = 2; back >= 1; --back) {
            if (sq0 - back >= 0) { const u32x4 a = *((const u32x4*)(CC + (size_t)(r0 - back) * 512) + lane), b = *((const u32x4*)(CX + (size_t)(r0 - back) * 512) + lane);
                float z[8] = {bf_lo(a.x) * bf_lo(b.x), bf_hi(a.x) * bf_hi(b.x), bf_lo(a.y) * bf_lo(b.y), bf_hi(a.y) * bf_hi(b.y), bf_lo(a.z) * bf_lo(b.z), bf_hi(a.z) * bf_hi(b.z), bf_lo(a.w) * bf_lo(b.w), bf_hi(a.w) * bf_hi(b.w)};
#pragma unroll
                for (int j = 0; j < 8; ++j) { if (back == 2) z2[j] = z[j]; else z1[j] = z[j]; } } }
#ifndef GM_CBATCH
#define GM_CBATCH 2
#endif
#pragma unroll 1
        for (int r4 = 0; r4 < 16 / GM_CBATCH; ++r4) {
            u32x4 av[GM_CBATCH], bv[GM_CBATCH], cv[GM_CBATCH];
#pragma unroll
            for (int q = 0; q < GM_CBATCH; ++q) { const size_t ro = (size_t)(r0 + GM_CBATCH * r4 + q) * 512; av[q] = *((const u32x4*)(CC + ro) + lane); bv[q] = *((const u32x4*)(CX + ro) + lane); cv[q] = *((const u32x4*)(CB + ro) + lane); }
#pragma unroll
            for (int q = 0; q < GM_CBATCH; ++q) { const size_t ro = (size_t)(r0 + GM_CBATCH * r4 + q) * 512; const u32x4 a = av[q], b = bv[q], cbv = cv[q];
                float z[8] = {bf_lo(a.x) * bf_lo(b.x), bf_hi(a.x) * bf_hi(b.x), bf_lo(a.y) * bf_lo(b.y), bf_hi(a.y) * bf_hi(b.y), bf_lo(a.z) * bf_lo(b.z), bf_hi(a.z) * bf_hi(b.z), bf_lo(a.w) * bf_lo(b.w), bf_hi(a.w) * bf_hi(b.w)};
                const float cbf[8] = {bf_lo(cbv.x), bf_hi(cbv.x), bf_lo(cbv.y), bf_hi(cbv.y), bf_lo(cbv.z), bf_hi(cbv.z), bf_lo(cbv.w), bf_hi(cbv.w)};
                float y[8];
#pragma unroll
                for (int j = 0; j < 8; ++j) { y[j] = cbf[j] * (w0[j] * z2[j] + w1[j] * z1[j] + w2[j] * z[j]); z2[j] = z1[j]; z1[j] = z[j]; }
                u32x4 o; o.x = cvtpk(y[0], y[1]); o.y = cvtpk(y[2], y[3]); o.z = cvtpk(y[4], y[5]); o.w = cvtpk(y[6], y[7]);
                if (!dry) *((u32x4*)(CB + ro) + lane) = o; else asm volatile("" :: "v"(o.x), "v"(o.y), "v"(o.z), "v"(o.w)); } }
    }
    __syncthreads();
}
typedef unsigned short u16x2 __attribute__((ext_vector_type(2)));
__device__ __forceinline__ unsigned key15(float sc) { float f = (sc + 8.0f) * 1024.0f + 0.5f; f = fminf(fmaxf(f, 1.0f), 32767.0f); return (unsigned)f; }
__device__ __forceinline__ unsigned long long lowest_k_bits(unsigned long long e, unsigned k) {
    unsigned long long r = 0ull;
    for (unsigned i = 0; i < k; ++i) { const unsigned long long bb = e & (0ull - e); r |= bb; e ^= bb; }
    return r;
}

__device__ __forceinline__ void select_row(const unsigned char* rowp, int ntile128, int t_seq, unsigned long long* mrow, int ntile_out, int lane, LAS unsigned long long* wl  ) {
    const int n = t_seq + 1;
    if (n <= 256) {
        const int T = lane;
        if (T < ntile_out) { const int lo = 64 * T; unsigned long long w;
            if (lo + 63 <= t_seq) w = ~0ull; else if (lo > t_seq) w = 0ull; else w = (1ull << (t_seq - lo + 1)) - 1ull;
            mrow[(size_t)T * 256] = w; }
        for (int T2 = 64 + lane; T2 < ntile_out; T2 += 64) mrow[(size_t)T2 * 256] = 0ull;
        return;
    }
    unsigned kq[4][32];
    const unsigned* rp = (const unsigned*)rowp + lane;
    const int nq = (ntile128 + 31) >> 5;
#pragma unroll
    for (int q = 0; q < 4; ++q) {
        if (q < nq) {
            const unsigned* rq = rp + 64 * (32 * q + 16); asm volatile("" : "+v"(rq));
#pragma unroll
            for (int m = 0; m < 32; ++m) kq[q][m] = rq[64 * (m - 16)];
        } else {
#pragma unroll
            for (int m = 0; m < 32; ++m) kq[q][m] = 0u;
        }
    }
#define COUNT_GE(cand, out) do { const unsigned Kc_ = (0x8000u - (cand)) * 0x10001u; const u16x2 Kv_ = __builtin_bit_cast(u16x2, Kc_); u16x2 a_ = (u16x2){0, 0}; \
        _Pragma("unroll") for (int q = 0; q < 4; ++q) { if (q < nq) { _Pragma("unroll") for (int m = 0; m < 32; ++m) { u16x2 t_ = __builtin_bit_cast(u16x2, kq[q][m]) + Kv_; t_ = t_ >> 15; a_ += t_; } } } \
        out = wave_sum_u((unsigned)a_.x + (unsigned)a_.y); } while (0)
    unsigned prefix = 0u;
    for (int bit = 14; bit >= 0; --bit) { const unsigned cand = prefix | (1u << bit); unsigned c; COUNT_GE(cand, c); if (c >= 256u) prefix = cand; }
    const unsigned tau = prefix;
    unsigned c_ge, c_gt; COUNT_GE(tau, c_ge); COUNT_GE(tau + 1u, c_gt);
#undef COUNT_GE
    unsigned rem = 256u - c_gt;
#pragma unroll
    for (int q = 0; q < 4; ++q) {
        if (q < nq) {
#pragma unroll
            for (int m = 0; m < 32; ++m) {
#pragma unroll
                for (int h = 0; h < 2; ++h) { const unsigned kv = h ? (kq[q][m] >> 16) : (kq[q][m] & 0xffffu);
                    const unsigned long long gt = __ballot(kv > tau); unsigned long long e = __ballot(kv == tau);
                    const unsigned pe = (unsigned)__popcll(e);
                    if (pe <= rem) rem -= pe; else { e = lowest_k_bits(e, rem); rem = 0u; }
                    const unsigned long long w = gt | e;
                    wl[64 * q + 2 * m + h] = w; SBAR(); }
            }
        } else {
            wl[64 * q + lane] = 0ull;
        }
    }
    LDS_WAIT();
#pragma unroll
    for (int g = 0; g < 4; ++g) { const int T = 64 * g + lane; if (T < ntile_out) mrow[(size_t)T * 256] = wl[T]; }
    LDS_WAIT();
}

__device__ __forceinline__ void indexer_item(LAS unsigned char* lds, unsigned char* scr, int b, int qt, const bf16_t* QI, const bf16_t* KI, const float* WI, unsigned long long* MASK, int wid, int lane) {
    asm volatile("" : "+v"(lane));
    const int s0 = qt * 16, t0 = b * SEQ + s0, i16 = lane & 15, g4 = lane >> 4;
    const int nk128 = (s0 + 16 + 127) & ~127, nsteps = nk128 >> 7;
    {
        bf16x8 bq[4][2];
#pragma unroll
        for (int hh = 0; hh < 4; ++hh)
#pragma unroll
            for (int kk = 0; kk < 2; ++kk) bq[hh][kk] = *(const bf16x8*)(QI + (size_t)(t0 + i16) * 256 + hh * 64 + kk * 32 + 8 * g4);
        const f32x4 w = *(const f32x4*)(WI + (size_t)(t0 + i16) * 4);
        const int qpos = s0 + i16;
        const int nsteps_pad = (nsteps + 31) & ~31;
        for (int st = wid; st < nsteps_pad; st += 8) {
            if (st >= nsteps) {
#pragma unroll
                for (int jp = 0; jp < 4; ++jp) *(u32x4*)(scr + (size_t)i16 * 32768 + (size_t)(64 * st + 16 * jp + 4 * g4) * 4) = (u32x4){0u, 0u, 0u, 0u};
                continue; }
#pragma unroll
            for (int jp = 0; jp < 4; ++jp) {
                unsigned kk2[2][4];
#pragma unroll
                for (int par = 0; par < 2; ++par) { const int keybase = 128 * st + 64 * par + 16 * jp;
                    const bf16x8 a0 = *(const bf16x8*)(KI + ki_chunk(b, keybase + i16, g4)), a1 = *(const bf16x8*)(KI + ki_chunk(b, keybase + i16, 4 + g4));
                    float sc[4] = {0.f, 0.f, 0.f, 0.f};
#pragma unroll
                    for (int hh = 0; hh < 4; ++hh) { f32x4 d = {0.f, 0.f, 0.f, 0.f};
                        d = __builtin_amdgcn_mfma_f32_16x16x32_bf16(a0, bq[hh][0], d, 0, 0, 0); d = __builtin_amdgcn_mfma_f32_16x16x32_bf16(a1, bq[hh][1], d, 0, 0, 0);
#pragma unroll
                        for (int r = 0; r < 4; ++r) sc[r] = fmaf(relu_f(d[r]), w[hh], sc[r]); }
#pragma unroll
                    for (int r = 0; r < 4; ++r) { const int kidx = keybase + 4 * g4 + r; kk2[par][r] = (kidx <= qpos) ? key15(sc[r]) : 0u; } }
                u32x4 o; o.x = kk2[0][0] | (kk2[1][0] << 16); o.y = kk2[0][1] | (kk2[1][1] << 16); o.z = kk2[0][2] | (kk2[1][2] << 16); o.w = kk2[0][3] | (kk2[1][3] << 16);
                *(u32x4*)(scr + (size_t)i16 * 32768 + (size_t)(64 * st + 16 * jp + 4 * g4) * 4) = o;
            }
        }
    }
    VM_WAIT(); __syncthreads();
    __builtin_amdgcn_fence(__ATOMIC_ACQUIRE, "agent");
    VM_WAIT();
    const int qblk = s0 >> 8, ntile_out = ((s0 & ~255) + 256) >> 6;
#pragma unroll 1
    for (int rr = 0; rr < 2; ++rr) { const int i = wid * 2 + rr, tq = s0 + i;
        unsigned long long* mrow = MASK + ((size_t)(b * 64 + qblk) * 256 * 256 + (size_t)(tq & 255));
        select_row(scr + (size_t)i * 32768, nk128 >> 7, tq, mrow, ntile_out, lane, (LAS unsigned long long*)(lds + wid * 2048)); }
    VM_WAIT(); __syncthreads();
}
#ifndef IX_CAP_N
#define IX_CAP_N 1472
#endif
constexpr int IX_CAP = IX_CAP_N, IX_B = 59;
constexpr int IX_GCAP = 8192;
#ifndef IX_REP
#define IX_REP 0
#endif
#ifndef IX_SKIP
#define IX_SKIP 0
#endif
#ifdef IX_STAMP
#define IXT(k) do { if (tid == 0) { const unsigned long long t_ = __builtin_amdgcn_s_memrealtime(); ((LAS unsigned*)(lds + IXL_ROW))[96 + (k)] += (unsigned)(t_ - t_prev); t_prev = t_; } } while (0)
#else
#define IXT(k) do {} while (0)
#endif
constexpr int IXL_SK = 0, IXL_MI = 16 * IX_CAP * 4, IXL_ROW = IXL_MI + 32768, IXL_STG = IXL_ROW + 512;
static_assert(IXL_SK + 16 * 2048 * 2 <= IXL_MI && IXL_STG + 8 * 4096 <= MISC_OFF, "indexer LDS map");
constexpr float KMAGIC = 8388608.0f;
__device__ __forceinline__ float key15f(float sc) { return __builtin_amdgcn_fmed3f(fmaf(sc, 1024.0f, KMAGIC + 8192.0f), KMAGIC + 1.0f, KMAGIC + 32767.0f); }

template <int NR>
__device__ __forceinline__ unsigned kth_largest15(const unsigned (&kr)[NR], unsigned rank) {
    unsigned prefix = 0u;
    for (int bit = 14; bit >= 0; --bit) { const unsigned cand = prefix | (1u << bit);
        const unsigned Kc = (0x8000u - cand) * 0x10001u; const u16x2 Kv = __builtin_bit_cast(u16x2, Kc); u16x2 a = (u16x2){0, 0};
#pragma unroll
        for (int r = 0; r < NR; ++r) { u16x2 t = __builtin_bit_cast(u16x2, kr[r]) + Kv; t = t >> 15; a += t; }
        const unsigned c = wave_sum_u((unsigned)a.x + (unsigned)a.y);
        if (c >= rank) prefix = cand; }
    return prefix;
}

__device__ __forceinline__ bool indexer_item_fast(LAS unsigned char* lds, int b, int qt, const bf16_t* QI, const bf16_t* KI, const float* WI, unsigned long long* MASK, int wid, int lane_, int tid, unsigned* probe_ctr, unsigned* clg  ) {
    (void)probe_ctr;
    asm volatile("" : "+v"(tid));
    const int lane = tid & 63; (void)lane_;
    const int s0 = qt * 16, t0 = b * SEQ + s0, i16 = lane & 15, g4 = lane >> 4;
    const int nk128 = (s0 + 16 + 127) & ~127, nsteps = nk128 >> 7;
    LAS unsigned short* SK = (LAS unsigned short*)(lds + IXL_SK); LAS unsigned* CL = (LAS unsigned*)(lds + IXL_SK);
    LAS unsigned* MI = (LAS unsigned*)(lds + IXL_MI);
    LAS float* U1F = (LAS float*)(lds + IXL_ROW); LAS float* LF = U1F + 16; LAS unsigned* NCAND = (LAS unsigned*)(LF + 16); LAS unsigned* FAIL = NCAND + 32;
#ifdef IX_STAMP
    unsigned long long t_prev = __builtin_amdgcn_s_memrealtime();
#endif
#pragma unroll
    for (int k = 0; k < 4; ++k) *(LAS u32x4*)(lds + IXL_MI + (tid + 512 * k) * 16) = (u32x4){0u, 0u, 0u, 0u};
    if (tid < 80) ((LAS unsigned*)(lds + IXL_ROW))[tid] = 0u;
    bf16x8 bq[4][2];
#pragma unroll
    for (int hh = 0; hh < 4; ++hh)
#pragma unroll
        for (int kk = 0; kk < 2; ++kk) bq[hh][kk] = *(const bf16x8*)(QI + (size_t)(t0 + i16) * 256 + hh * 64 + kk * 32 + 8 * g4);
    const f32x4 w = *(const f32x4*)(WI + (size_t)(t0 + i16) * 4);
    const int qpos = s0 + i16;
    const int m = nk128 >> 3;
    for (int repA = 0; repA < ((IX_REP & 1) ? 2 : 1); ++repA) {
#define IX_ALOAD(A0, A1, tau_) do { A0 = *(const bf16x8*)(KI + ki_chunk(b, 8 * (16 * (tau_) + i16), g4)); A1 = *(const bf16x8*)(KI + ki_chunk(b, 8 * (16 * (tau_) + i16), 4 + g4)); } while (0)
#define IX_ATILE(A0, A1, tau_) do { float sc[4] = {0.f, 0.f, 0.f, 0.f}; \
            _Pragma("unroll") for (int hh = 0; hh < 4; ++hh) { f32x4 d = {0.f, 0.f, 0.f, 0.f}; \
                d = __builtin_amdgcn_mfma_f32_16x16x32_bf16(A0, bq[hh][0], d, 0, 0, 0); d = __builtin_amdgcn_mfma_f32_16x16x32_bf16(A1, bq[hh][1], d, 0, 0, 0); \
                _Pragma("unroll") for (int r = 0; r < 4; ++r) sc[r] = fmaf(relu_f(d[r]), w[hh], sc[r]); } \
            unsigned k4[4]; \
            _Pragma("unroll") for (int r = 0; r < 4; ++r) { const int ks = 8 * (16 * (tau_) + 4 * g4 + r); k4[r] = (ks <= qpos) ? (__float_as_uint(key15f(sc[r])) & 0xffffu) : 0u; } \
            u32x2 o; o.x = k4[0] | (k4[1] << 16); o.y = k4[2] | (k4[3] << 16); \
            *(LAS u32x2*)(lds + IXL_SK + ((size_t)i16 * 2048 + 16 * (tau_) + 4 * g4) * 2) = o; } while (0)
        const int ntau = m >> 4;
        for (int tau = wid; tau < ntau; tau += 16) {
            bf16x8 a0, a1, c0, c1; const bool two = tau + 8 < ntau;
            IX_ALOAD(a0, a1, tau); if (two) IX_ALOAD(c0, c1, tau + 8);
            IX_ATILE(a0, a1, tau); if (two) IX_ATILE(c0, c1, tau + 8); }
#undef IX_ATILE
#undef IX_ALOAD
    }
    LDS_WAIT(); __syncthreads(); IXT(0);
    for (int repK = 0; repK < ((IX_REP & 2) ? 2 : 1); ++repK) {
        const int nd = m >> 1;
        unsigned pb0 = 0u, pb1 = 0u;
#define IX_BRACKET(NR) do { \
        unsigned kr0[NR], kr1[NR]; \
        { const LAS unsigned* sp0 = (const LAS unsigned*)(lds + IXL_SK + (size_t)(wid * 2) * 4096) + lane; const LAS unsigned* sp1 = sp0 + 1024; \
            _Pragma("unroll") for (int r = 0; r < NR; ++r) { const unsigned v0 = sp0[64 * r], v1 = sp1[64 * r]; const bool in = (64 * r + lane < nd); kr0[r] = in ? v0 : 0u; kr1[r] = in ? v1 : 0u; } } \
        for (int bit = 14; bit >= 0; --bit) { \
            const unsigned cb0 = pb0 | (1u << bit), cb1 = pb1 | (1u << bit); \
            const u16x2 Kb0 = __builtin_bit_cast(u16x2, (0x8000u - cb0) * 0x10001u), Kb1 = __builtin_bit_cast(u16x2, (0x8000u - cb1) * 0x10001u); \
            u16x2 ab0 = (u16x2){0, 0}, ab1 = ab0; \
            _Pragma("unroll") for (int r = 0; r < NR; ++r) { const u16x2 x0 = __builtin_bit_cast(u16x2, kr0[r]), x1 = __builtin_bit_cast(u16x2, kr1[r]); \
                ab0 += (x0 + Kb0) >> 15; ab1 += (x1 + Kb1) >> 15; } \
            const unsigned s01 = ((unsigned)ab0.x + (unsigned)ab0.y) | (((unsigned)ab1.x + (unsigned)ab1.y) << 16); \
            const unsigned t01 = wave_sum_u(s01);                            \
            if ((t01 & 0xffffu) >= (unsigned)IX_B) pb0 = cb0; if ((t01 >> 16) >= (unsigned)IX_B) pb1 = cb1; } } while (0)
        if (nd <= 512) IX_BRACKET(8); else IX_BRACKET(16);
#undef IX_BRACKET
        if (lane == 0) { LF[wid * 2] = KMAGIC + (float)(pb0 > 0u ? pb0 : 1u); LF[wid * 2 + 1] = KMAGIC + (float)(pb1 > 0u ? pb1 : 1u); }
    }
    LDS_WAIT(); __syncthreads(); IXT(1);
    for (int repB = 0; repB < ((IX_REP & 4) ? 2 : 1); ++repB) {
        if (repB) { __syncthreads(); if (tid < 32) NCAND[tid] = 0u; __syncthreads(); }
        const float lf = LF[i16];
        const bf16_t* kbase = KI + (size_t)b * 128 * 8192 + (size_t)lane * 8;
        LAS unsigned char* stg_ = lds + IXL_STG + wid * 4096 + lane * 16;
        bf16x8 fa0[8], fa1[8], fb0[8], fb1[8];
#define IX_LOADSTEP(A0, A1, st_) do { const bf16_t* kp_ = kbase + (size_t)(st_) * 8192; _Pragma("unroll") for (int j = 0; j < 8; ++j) { A0[j] = *(const bf16x8*)(kp_ + j * 1024); A1[j] = *(const bf16x8*)(kp_ + j * 1024 + 512); } } while (0)
#define IX_STEP(A0, A1, N0, N1, st_) do { \
            if ((st_) + 8 < nsteps) IX_LOADSTEP(N0, N1, (st_) + 8);                           \
            float fv[32]; unsigned nge = 0u;                                                 \
            for (int rep2_ = 0; rep2_ < ((IX_REP & 32) ? 2 : 1); ++rep2_) { if (rep2_) { asm volatile("" :: "v"(nge)); nge = 0u; } \
            _Pragma("unroll") for (int j = 0; j < 8; ++j) { \
                float sc[4] = {0.f, 0.f, 0.f, 0.f}; \
                _Pragma("unroll") for (int hh = 0; hh < 4; ++hh) { f32x4 d = {0.f, 0.f, 0.f, 0.f}; \
                    d = __builtin_amdgcn_mfma_f32_16x16x32_bf16(A0[j], bq[hh][0], d, 0, 0, 0); d = __builtin_amdgcn_mfma_f32_16x16x32_bf16(A1[j], bq[hh][1], d, 0, 0, 0); \
                    _Pragma("unroll") for (int r = 0; r < 4; ++r) sc[r] = fmaf(relu_f(d[r]), w[hh], sc[r]); } \
                _Pragma("unroll") for (int r = 0; r < 4; ++r) { float f = key15f(sc[r]); \
                    fv[4 * j + r] = f; \
                    nge = __builtin_amdgcn_alignbit(nge, __float_as_uint(f - lf), 31); } } } \
            const int lim_ = qpos - (128 * (st_) + 32 * g4);                                \
            const unsigned cmask_ = lim_ >= 31 ? 0xffffffffu : (lim_ < 0 ? 0u : ((2u << lim_) - 1u)); \
            unsigned cm = ~__brev(nge) & cmask_;                                             \
            if (!(IX_SKIP & 32) && __any(cm != 0u)) { \
                  \
                _Pragma("unroll") for (int q = 0; q < 4; ++q) { u32x4 pk_; \
                    pk_.x = __builtin_amdgcn_perm(__float_as_uint(fv[8 * q + 1]), __float_as_uint(fv[8 * q + 0]), 0x05040100u); pk_.y = __builtin_amdgcn_perm(__float_as_uint(fv[8 * q + 3]), __float_as_uint(fv[8 * q + 2]), 0x05040100u); \
                    pk_.z = __builtin_amdgcn_perm(__float_as_uint(fv[8 * q + 5]), __float_as_uint(fv[8 * q + 4]), 0x05040100u); pk_.w = __builtin_amdgcn_perm(__float_as_uint(fv[8 * q + 7]), __float_as_uint(fv[8 * q + 6]), 0x05040100u); \
                    *(LAS u32x4*)(stg_ + q * 1024) = pk_; } \
                unsigned pos = 0u; \
                if (cm) pos = __hip_atomic_fetch_add(&NCAND[i16], (unsigned)__popc(cm), __ATOMIC_RELAXED, __HIP_MEMORY_SCOPE_WORKGROUP); \
                const unsigned idxb = 16383u - (unsigned)(128 * (st_) + 32 * g4); \
                while (__any(cm != 0u)) {                                                     \
                    const unsigned p = cm ? (unsigned)__builtin_ctz(cm) : 0u; \
                    const unsigned k_ = *(const LAS unsigned short*)(stg_ + ((p & 24u) << 7) + ((p & 7u) << 1)); \
                    if (cm) { const unsigned comp_ = (k_ << 14) | (idxb - p); \
                        if (pos < (unsigned)IX_CAP) CL[i16 * IX_CAP + pos] = comp_; else if (pos < (unsigned)(IX_CAP + IX_GCAP)) __hip_atomic_store(clg + i16 * IX_GCAP + (pos - IX_CAP), comp_, __ATOMIC_RELAXED, __HIP_MEMORY_SCOPE_AGENT); \
                        ++pos; cm &= cm - 1u; } } } \
        } while (0)
#if (IX_SKIP & 4)
        for (int st = wid; st < nsteps; st += 8) MI[i16 * 512 + 4 * st + g4] = (st == 0 && g4 == 0) ? 1u : 0u;
        (void)lf; (void)kbase; (void)fa0; (void)fa1; (void)fb0; (void)fb1;
#else
        if (wid < nsteps) IX_LOADSTEP(fa0, fa1, wid);
        for (int st = wid; st < nsteps; st += 16) {
            IX_STEP(fa0, fa1, fb0, fb1, st);
            if (st + 8 < nsteps) IX_STEP(fb0, fb1, fa0, fa1, st + 8);
        }
#endif
#undef IX_STEP
#undef IX_LOADSTEP
    }
    VM_WAIT(); LDS_WAIT(); __syncthreads(); IXT(2);
    for (int repC = 0; repC < ((IX_SKIP & (8 | 32)) ? 0 : 1); ++repC) {
        constexpr int NCR = IX_CAP / 64;
        const int row0 = wid * 2, row1 = row0 + 1;
        const unsigned nc0 = NCAND[row0], ca0 = 0u, nc1 = NCAND[row1], ca1 = 0u;
        const bool ok0 = (nc0 <= (unsigned)(IX_CAP + IX_GCAP)) && (ca0 <= 256u) && (ca0 + nc0 >= 256u), ok1 = (nc1 <= (unsigned)(IX_CAP + IX_GCAP)) && (ca1 <= 256u) && (ca1 + nc1 >= 256u);
        if (!(ok0 && ok1)) { if (lane == 0) { FAIL[0] = 1u;
#ifdef IX_PROBE_TYPE
            unsigned cnt_ = 0u; if (IX_PROBE_TYPE == 1) cnt_ = (nc0 > (unsigned)IX_CAP) + (nc1 > (unsigned)IX_CAP); if (IX_PROBE_TYPE == 2) cnt_ = (ca0 > 256u) + (ca1 > 256u); if (IX_PROBE_TYPE == 3) cnt_ = (ca0 + nc0 < 256u) + (ca1 + nc1 < 256u);
            if (cnt_) atomicAdd(probe_ctr, cnt_);
#endif
            } }
        else {
            const unsigned need0 = 256u - ca0, need1 = 256u - ca1;
            const unsigned nl0 = nc0 < (unsigned)IX_CAP ? nc0 : (unsigned)IX_CAP, nl1 = nc1 < (unsigned)IX_CAP ? nc1 : (unsigned)IX_CAP;
            unsigned c0[NCR], c1[NCR]; const LAS unsigned* cp0 = CL + row0 * IX_CAP + lane; const LAS unsigned* cp1 = CL + row1 * IX_CAP + lane;
#pragma unroll
            for (int r = 0; r < NCR; ++r) { const unsigned v0 = cp0[64 * r], v1 = cp1[64 * r]; c0[r] = (64 * r + lane < (int)nl0) ? v0 : 0u; c1[r] = (64 * r + lane < (int)nl1) ? v1 : 0u; }
            unsigned p0 = 0u, p1 = 0u;
            const unsigned nlm = nl0 > nl1 ? nl0 : nl1;
#define IX_CSEARCH(NRC) do { for (int bit = 28; bit >= 0; --bit) { const unsigned d0 = p0 | (1u << bit), d1 = p1 | (1u << bit); unsigned n0 = 0u, n1 = 0u; \
                _Pragma("unroll") for (int r = 0; r < NRC; ++r) { n0 += (c0[r] >= d0) ? 1u : 0u; n1 += (c1[r] >= d1) ? 1u : 0u; } \
                const unsigned t = wave_sum_u(n0 | (n1 << 16));                   \
                if ((t & 0xffffu) >= need0 && need0 > 0u) p0 = d0; if ((t >> 16) >= need1 && need1 > 0u) p1 = d1; } } while (0)
            if (nlm <= 512u) IX_CSEARCH(8); else if (nlm <= 640u) IX_CSEARCH(10); else if (nlm <= 1024u) IX_CSEARCH(16); else IX_CSEARCH(NCR);
#undef IX_CSEARCH
#define IX_OVERFLOW_ROW(CX, PX, NCX, NEEDX, ROWX) do { if ((NCX) > (unsigned)IX_CAP && (NEEDX) > 0u) { \
                unsigned g0 = 0u, g1 = 0u, g2 = 0u, g3 = 0u, ng = 0u; \
                for (unsigned i = lane; i < (NCX) - (unsigned)IX_CAP; i += 256) { unsigned v4[4]; \
                    _Pragma("unroll") for (int u = 0; u < 4; ++u) v4[u] = (i + 64 * u < (NCX) - (unsigned)IX_CAP) ? __hip_atomic_load(clg + (ROWX) * IX_GCAP + i + 64 * u, __ATOMIC_RELAXED, __HIP_MEMORY_SCOPE_AGENT) : 0u; \
                    _Pragma("unroll") for (int u = 0; u < 4; ++u) if (v4[u] >= (PX) && v4[u] != 0u) { g3 = g2; g2 = g1; g1 = g0; g0 = v4[u]; ++ng; } } \
                if (__any(ng > 4u)) { if (lane == 0) FAIL[0] = 1u; } \
                else if (__any(ng > 0u)) { unsigned px = 0u; \
                    for (int bit = 28; bit >= 0; --bit) { const unsigned dx = px | (1u << bit); unsigned nx = (g0 >= dx ? 1u : 0u) + (g1 >= dx ? 1u : 0u) + (g2 >= dx ? 1u : 0u) + (g3 >= dx ? 1u : 0u); \
                        _Pragma("unroll") for (int r = 0; r < NCR; ++r) nx += (CX[r] >= dx) ? 1u : 0u; \
                        nx = wave_sum_u(nx); if (nx >= (NEEDX)) px = dx; } \
                    PX = px; \
                    if (g0 >= px && g0) { const unsigned idx = 16383u - (g0 & 16383u); __hip_atomic_fetch_or(&MI[(ROWX) * 512 + (idx >> 5)], 1u << (idx & 31u), __ATOMIC_RELAXED, __HIP_MEMORY_SCOPE_WORKGROUP); } \
                    if (g1 >= px && g1) { const unsigned idx = 16383u - (g1 & 16383u); __hip_atomic_fetch_or(&MI[(ROWX) * 512 + (idx >> 5)], 1u << (idx & 31u), __ATOMIC_RELAXED, __HIP_MEMORY_SCOPE_WORKGROUP); } \
                    if (g2 >= px && g2) { const unsigned idx = 16383u - (g2 & 16383u); __hip_atomic_fetch_or(&MI[(ROWX) * 512 + (idx >> 5)], 1u << (idx & 31u), __ATOMIC_RELAXED, __HIP_MEMORY_SCOPE_WORKGROUP); } \
                    if (g3 >= px && g3) { const unsigned idx = 16383u - (g3 & 16383u); __hip_atomic_fetch_or(&MI[(ROWX) * 512 + (idx >> 5)], 1u << (idx & 31u), __ATOMIC_RELAXED, __HIP_MEMORY_SCOPE_WORKGROUP); } } } } while (0)
            IX_OVERFLOW_ROW(c0, p0, nc0, need0, row0);
            IX_OVERFLOW_ROW(c1, p1, nc1, need1, row1);
#undef IX_OVERFLOW_ROW
#pragma unroll
            for (int r = 0; r < NCR; ++r) { if (64u * (unsigned)r >= nlm) break;
                if (need0 > 0u && c0[r] >= p0 && c0[r] != 0u) { const unsigned idx = 16383u - (c0[r] & 16383u); __hip_atomic_fetch_or(&MI[row0 * 512 + (idx >> 5)], 1u << (idx & 31u), __ATOMIC_RELAXED, __HIP_MEMORY_SCOPE_WORKGROUP); }
                if (need1 > 0u && c1[r] >= p1 && c1[r] != 0u) { const unsigned idx = 16383u - (c1[r] & 16383u); __hip_atomic_fetch_or(&MI[row1 * 512 + (idx >> 5)], 1u << (idx & 31u), __ATOMIC_RELAXED, __HIP_MEMORY_SCOPE_WORKGROUP); } }
        }
    }
    LDS_WAIT(); __syncthreads(); IXT(3);
    const bool good = (FAIL[0] == 0u) || (IX_SKIP != 0);
    if (good) { const int qblk = s0 >> 8, ntile_out = ((s0 & ~255) + 256) >> 6;
        unsigned long long* mb = MASK + ((size_t)(b * 64 + qblk) * 256 * 256 + (size_t)(s0 & 255));
        for (int idx = tid; idx < 16 * ntile_out; idx += NTHREADS) { const int row = idx & 15, Tt = idx >> 4;
            const u32x2 wv = *(const LAS u32x2*)(MI + row * 512 + 2 * Tt);
            mb[(size_t)Tt * 256 + row] = ((unsigned long long)wv.y << 32) | wv.x; } }
    __syncthreads(); IXT(4);
    return good;
}
namespace att {
constexpr int QBLK = 32, KVBLK = 64, QB = 256, HD = 128, LDQ = 512;
constexpr int SHM_V = KVBLK * HD * 2, SHM_K = KVBLK * HD * 2;
constexpr int LDS_NEED = 2 * SHM_V + 2 * SHM_K + NWAVES * 64 * 4;
#ifndef ATT_THR
#define ATT_THR 8.f
#endif
#ifndef ATT_M0
#define ATT_M0 0.f
#endif
constexpr float THR = ATT_THR;
#define KSWZ(row, colB) ((row) * 256 + ((colB) ^ (((row) & 7) << 4)))
__device__ __forceinline__ int v_st(int k, int c) { const int kk = k; return ((kk >> 3) * 4 + (c >> 5)) * 512 + ((kk & 7) * 32 + (c & 31)) * 2; }
__device__ __forceinline__ int v_rd_base(int lane) { return ((lane & 3) << 3) | (((lane >> 2) & 3) << 6) | (((lane >> 4) & 1) << 5) | (((lane >> 5) & 1) << 8); }
constexpr int v_rd_off(int d0, int ks, int half) { return d0 * 512 + ks * 4096 + half * 2048; }
__device__ __forceinline__ int crow(int r, int hi) { return (r & 3) + 8 * (r >> 2) + 4 * hi; }

__device__ __forceinline__ void partialSM(f32x16& p0, f32x16& p1, float& m_reg, const float l_reg, float& mn, float& alpha) {
    float pmax = p0[0];
#pragma unroll
    for (int r = 1; r < 16; ++r) pmax = fmaxf(pmax, p0[r]);
#pragma unroll
    for (int r = 0; r < 16; ++r) pmax = fmaxf(pmax, p1[r]);
    { auto rr = __builtin_amdgcn_permlane32_swap(__float_as_uint(pmax), __float_as_uint(pmax), false, false);
      pmax = fmaxf(__uint_as_float(rr[0]), __uint_as_float(rr[1])); }
    const bool upd = (pmax > THR) || (pmax < -64.f && l_reg == 0.f && pmax > -1e37f);
    alpha = 1.f;
    if (__builtin_expect(__any(upd), 0)) {
        const float d = upd ? pmax : 0.f;
        alpha = (upd && l_reg != 0.f) ? __builtin_amdgcn_exp2f(-d) : 1.f;
        m_reg += d;
#pragma unroll
        for (int r = 0; r < 16; ++r) { p0[r] -= d; p1[r] -= d; }
    }
    mn = m_reg;
#pragma unroll
    for (int r = 0; r < 16; ++r) p0[r] = __builtin_amdgcn_exp2f(p0[r]);
}
__device__ __forceinline__ void finishSM(f32x16& p0, f32x16& p1, float alpha, float& l_reg, bf16x8& pa0, bf16x8& pa1, bf16x8& pa2, bf16x8& pa3) {
#pragma unroll
    for (int r = 0; r < 16; ++r) p1[r] = __builtin_amdgcn_exp2f(p1[r]);
    float ps = 0;
#pragma unroll
    for (int r = 0; r < 16; ++r) ps += p0[r];
#pragma unroll
    for (int r = 0; r < 16; ++r) ps += p1[r];
    { auto rr = __builtin_amdgcn_permlane32_swap(__float_as_uint(ps), __float_as_uint(ps), false, false);
      ps = __uint_as_float(rr[0]) + __uint_as_float(rr[1]); }
    l_reg = l_reg * alpha + ps;
#define PK4(P, B_, OUT) do { u32x4 w = {cvtpk(P[B_+0], P[B_+1]), cvtpk(P[B_+2], P[B_+3]), cvtpk(P[B_+4], P[B_+5]), cvtpk(P[B_+6], P[B_+7])}; OUT = *reinterpret_cast<bf16x8*>(&w); } while (0)
    PK4(p0, 0, pa0); PK4(p0, 8, pa1); PK4(p1, 0, pa2); PK4(p1, 8, pa3);
#undef PK4
}
template <int KB>
__device__ __forceinline__ void qkt(f32x16& p0, f32x16& p1, const LAS char* K_lds, int r32, int hi, const bf16x8* qr) {
    const LAS char* kb[4];
#pragma unroll
    for (int dd = 0; dd < 4; ++dd) kb[dd] = K_lds + KB * SHM_K + KSWZ(r32, (dd * 16 + hi * 8) * 2);
#pragma unroll
    for (int d0 = 0; d0 < 8; ++d0) { const LAS char* a = kb[d0 & 3] + (d0 >> 2) * 128;
        bf16x8 b0 = *reinterpret_cast<const LAS bf16x8*>(a);
        bf16x8 b1 = *reinterpret_cast<const LAS bf16x8*>(a + 32 * 256);
        p0 = __builtin_amdgcn_mfma_f32_32x32x16_bf16(b0, qr[d0], p0, 0, 0, 0);
        p1 = __builtin_amdgcn_mfma_f32_32x32x16_bf16(b1, qr[d0], p1, 0, 0, 0); }
}
template <int VB>
__device__ __forceinline__ void pv_tile(f32x16* o, int vb0, bf16x8 pa0, bf16x8 pa1, bf16x8 pa2, bf16x8 pa3) {
#define TRRD2(dst, off) asm volatile("ds_read_b64_tr_b16 %0, %1 offset:%2" : "=&v"(dst) : "v"(vb0), "i"(off) : "memory")
#define PV_D0(d0) do { s16x4 l0, l1, l2, l3, h0, h1, h2, h3; constexpr int b_ = VB * SHM_V + v_rd_off(d0, 0, 0); \
        TRRD2(l0, b_); TRRD2(h0, b_ + 2048); TRRD2(l1, b_ + 4096); TRRD2(h1, b_ + 6144); TRRD2(l2, b_ + 8192); TRRD2(h2, b_ + 10240); TRRD2(l3, b_ + 12288); TRRD2(h3, b_ + 14336); \
        asm volatile("s_waitcnt lgkmcnt(0)" ::: "memory"); SBAR();   \
        o[d0] = __builtin_amdgcn_mfma_f32_32x32x16_bf16(pa0, (bf16x8){l0[0], l0[1], l0[2], l0[3], h0[0], h0[1], h0[2], h0[3]}, o[d0], 0, 0, 0);   \
        o[d0] = __builtin_amdgcn_mfma_f32_32x32x16_bf16(pa1, (bf16x8){l1[0], l1[1], l1[2], l1[3], h1[0], h1[1], h1[2], h1[3]}, o[d0], 0, 0, 0);   \
        o[d0] = __builtin_amdgcn_mfma_f32_32x32x16_bf16(pa2, (bf16x8){l2[0], l2[1], l2[2], l2[3], h2[0], h2[1], h2[2], h2[3]}, o[d0], 0, 0, 0);   \
        o[d0] = __builtin_amdgcn_mfma_f32_32x32x16_bf16(pa3, (bf16x8){l3[0], l3[1], l3[2], l3[3], h3[0], h3[1], h3[2], h3[3]}, o[d0], 0, 0, 0); } while (0)
    PV_D0(0); PV_D0(1); PV_D0(2); PV_D0(3);
#undef PV_D0
#undef TRRD2
}
__device__ __forceinline__ void mask_init(f32x16& p0, f32x16& p1, unsigned long long mw, int hi, float negm) {
    const int lo = ~(int)((unsigned)mw >> (4 * hi)), hw = ~(int)((unsigned)(mw >> 32) >> (4 * hi)), nb = __float_as_int(negm);
#pragma unroll
    for (int r = 0; r < 16; ++r) { const int c = (r & 3) + 8 * (r >> 2);
        int e0, e1;
        asm("v_bfe_i32 %0, %1, %2, 1" : "=v"(e0) : "v"(lo), "i"(c)); asm("v_bfe_i32 %0, %1, %2, 1" : "=v"(e1) : "v"(hw), "i"(c));
        p0[r] = __int_as_float((e0 & (int)0xFF800000) | (~e0 & nb)); p1[r] = __int_as_float((e1 & (int)0xFF800000) | (~e1 & nb)); }
}
__device__ __forceinline__ void attn_block(LAS char* lds, const bf16_t* Qb  , const bf16_t* Kh  , const bf16_t* Vh, bf16_t* Ob, const unsigned long long* mblk  , int P0) {
    int tid_ = threadIdx.x; asm volatile("" : "+v"(tid_));
    const int tid = tid_, wid = __builtin_amdgcn_readfirstlane(tid >> 6), lane = tid & 63, r32 = lane & 31, hi = lane >> 5;
    const int NT = (P0 + QB) / KVBLK;
    LAS char* V_lds = lds; LAS char* K_lds = lds + 2 * SHM_V;
    LAS float* ws = (LAS float*)(lds + 2 * SHM_V + 2 * SHM_K) + wid * 64; LAS float* li_l = ws; LAS float* al_l = ws + 32;
    float m_reg = ATT_M0, l_reg = 0; f32x16 o[4] = {};
    const int sr = tid >> 4, sc = (tid & 15) * 8, vst0 = v_st(sr, sc), vst1 = v_st(32 + sr, sc), kws = KSWZ(sr, sc * 2);
    const int vb0 = (int)(uintptr_t)V_lds + v_rd_base(lane);
    bf16x8 qr[8];
#pragma unroll
    for (int d0 = 0; d0 < 8; ++d0) qr[d0] = *(const bf16x8*)(Qb + (size_t)(wid * QBLK + r32) * LDQ + d0 * 16 + hi * 8);
    const unsigned long long* mrow = mblk + (wid * QBLK + r32);
    bf16x8 st_v0, st_v1, st_k0, st_k1;
#define SLOAD(k0) do { st_v0 = *(const bf16x8*)(Vh + (size_t)((k0) + sr) * LDQ + sc); st_v1 = *(const bf16x8*)(Vh + (size_t)((k0) + 32 + sr) * LDQ + sc); \
                       st_k0 = *(const bf16x8*)(Kh + (size_t)((k0) + sr) * LDQ + sc); st_k1 = *(const bf16x8*)(Kh + (size_t)((k0) + 32 + sr) * LDQ + sc); } while (0)
#define SWRITE(bf) do { *(LAS bf16x8*)(V_lds + (bf) * SHM_V + vst0) = st_v0; *(LAS bf16x8*)(V_lds + (bf) * SHM_V + vst1) = st_v1; \
                        *(LAS bf16x8*)(K_lds + (bf) * SHM_K + kws) = st_k0; *(LAS bf16x8*)(K_lds + (bf) * SHM_K + kws + 32 * 256) = st_k1; } while (0)
#define RESC(a) do { if (__any((a) < 1.f)) { if (hi == 0) al_l[r32] = (a); asm volatile("s_waitcnt lgkmcnt(0)" ::: "memory");              \
                     _Pragma("unroll") for (int d_ = 0; d_ < 4; ++d_) _Pragma("unroll") for (int r = 0; r < 16; ++r) o[d_][r] *= al_l[crow(r, hi)]; } } while (0)
    f32x16 pA0, pA1, pB0, pB1; float mnA, mnB, alA, alB; bf16x8 pa0, pa1, pa2, pa3;
    unsigned long long mnext;
#define HALF_STEP(PX0, PX1, mnX, alX, PY0, PY1, alY, t, KB, VB, SB) do {                                                      \
        const unsigned long long mw_ = mnext; if ((t) + 1 < NT) mnext = mrow[(size_t)((t) + 1) * 256];                        \
        SBAR(); mask_init(PX0, PX1, mw_, hi, -m_reg); qkt<KB>(PX0, PX1, K_lds, r32, hi, qr);                                          \
        finishSM(PY0, PY1, alY, l_reg, pa0, pa1, pa2, pa3); SBAR();                                                           \
        if ((t) + 1 < NT) { SLOAD(((t) + 1) * KVBLK); SBAR(); }                                                               \
        pv_tile<VB>(o, vb0, pa0, pa1, pa2, pa3); partialSM(PX0, PX1, m_reg, l_reg, mnX, alX);                                        \
        __syncthreads();                                                                                                      \
        if ((t) + 1 < NT) { VM_WAIT(); SWRITE(SB); }                                                                          \
        RESC(alX); LDS_WAIT(); __syncthreads(); } while (0)
    SLOAD(0); { const unsigned long long mw0 = mrow[0]; mnext = mrow[256];
        VM_WAIT(); SWRITE(0); LDS_WAIT(); __syncthreads();
        SLOAD(KVBLK);
        SBAR(); mask_init(pA0, pA1, mw0, hi, -m_reg); qkt<0>(pA0, pA1, K_lds, r32, hi, qr); }
    partialSM(pA0, pA1, m_reg, l_reg, mnA, alA);
    VM_WAIT(); SWRITE(1); LDS_WAIT();
    __syncthreads();
    for (int t = 1; t + 1 < NT; t += 2) {
        HALF_STEP(pB0, pB1, mnB, alB, pA0, pA1, alA, t, 1, 0, 0);
        HALF_STEP(pA0, pA1, mnA, alA, pB0, pB1, alB, t + 1, 0, 1, 1);
    }
    { const unsigned long long mw_ = mnext;
        SBAR(); mask_init(pB0, pB1, mw_, hi, -m_reg); qkt<1>(pB0, pB1, K_lds, r32, hi, qr); SBAR();
        finishSM(pA0, pA1, alA, l_reg, pa0, pa1, pa2, pa3); SBAR();
        pv_tile<0>(o, vb0, pa0, pa1, pa2, pa3);
        partialSM(pB0, pB1, m_reg, l_reg, mnB, alB); RESC(alB);
        finishSM(pB0, pB1, alB, l_reg, pa0, pa1, pa2, pa3); SBAR();
        pv_tile<1>(o, vb0, pa0, pa1, pa2, pa3); }
#undef HALF_STEP
    if (hi == 0) li_l[r32] = l_reg; asm volatile("s_waitcnt lgkmcnt(0)" ::: "memory");
    float rli[16];
#pragma unroll
    for (int r = 0; r < 16; ++r) rli[r] = __builtin_amdgcn_rcpf(li_l[crow(r, hi)]);
    bf16_t* Ow = Ob + (size_t)(wid * QBLK) * LDQ;
#pragma unroll
    for (int r = 0; r < 16; ++r) { const int orow = crow(r, hi);
#pragma unroll
        for (int d0 = 0; d0 < 4; ++d0) { const float v = o[d0][r] * rli[r]; const float vn = __shfl_xor(v, 1);
            if ((r32 & 1) == 0) *(unsigned*)(Ow + (size_t)orow * LDQ + d0 * 32 + r32) = cvtpk(v, vn); } }
    __syncthreads();
#undef SLOAD
#undef SWRITE
#undef RESC
}
}
#ifdef SELFCHECK
__device__ __forceinline__ float bf2f(bf16_t v) { return __uint_as_float(((unsigned)v) << 16); }
__device__ __forceinline__ void selfcheck_row(LAS unsigned char* lds, int b, int t, const bf16_t* QI, const bf16_t* KI, const float* WI, const unsigned long long* MASK,
                                              const bf16_t* Q, const bf16_t* K, const bf16_t* V, const bf16_t* YBp, unsigned* err, int tid) {
    LAS unsigned short* keys = (LAS unsigned short*)lds;
    LAS float* qv = (LAS float*)(lds + 32768);
    LAS int* sel = (LAS int*)(lds + 32768 + 4096);
    LAS float* lg = (LAS float*)(lds + 32768 + 8192);
    LAS unsigned* cnts = (LAS unsigned*)(lds + 32768 + 16384);
    const int n = t + 1; const size_t row = (size_t)b * SEQ + t;
    if (tid < 256) qv[tid] = bf2f(QI[row * 256 + tid]);
    if (tid < 8) cnts[tid] = 0u;
    __syncthreads();
    const float w0 = WI[row * 4 + 0], w1 = WI[row * 4 + 1], w2 = WI[row * 4 + 2], w3 = WI[row * 4 + 3];
    for (int s = tid; s < SEQ; s += NTHREADS) {
        unsigned k15 = 0u;
        if (s < n) { float d[4] = {0.f, 0.f, 0.f, 0.f};
            for (int k = 0; k < 64; ++k) { const float kv = bf2f(KI[ki_chunk(b, s, k >> 3) + (k & 7)]); d[0] += qv[k] * kv; d[1] += qv[64 + k] * kv; d[2] += qv[128 + k] * kv; d[3] += qv[192 + k] * kv; }
            const float sc = fmaxf(d[0], 0.f) * w0 + fmaxf(d[1], 0.f) * w1 + fmaxf(d[2], 0.f) * w2 + fmaxf(d[3], 0.f) * w3;
            k15 = key15(sc); }
        keys[s] = (unsigned short)k15; }
    __syncthreads();
    const unsigned long long* mrow = MASK + ((size_t)(b * 64 + (t >> 8)) * 256 * 256 + (size_t)(t & 255));
    const int ncheck = ((t & ~255) + 256);
    for (int s = tid; s < ncheck; s += NTHREADS) {
        bool want = false;
        if (s < n) { if (n <= 256) want = true; else { const unsigned k = keys[s]; int rank = 0; for (int s2 = 0; s2 < n; ++s2) { const unsigned k2 = keys[s2]; rank += (k2 > k || (k2 == k && s2 < s)) ? 1 : 0; } want = rank < 256; } }
        const bool got = (mrow[(size_t)(s >> 6) * 256] >> (s & 63)) & 1ull;
        if (want != got) atomicAdd((unsigned*)&cnts[0], 1u);
        if (got) { const unsigned j = atomicAdd((unsigned*)&cnts[1], 1u); if (j < 256u) sel[j] = s; } }
    __syncthreads();
    const int nsel = (int)cnts[1]; const int nexp = n < 256 ? n : 256;
    qv[tid] = bf2f(Q[row * 512 + tid]);
    __syncthreads();
    if (nsel == nexp) {
        if (tid < nsel) { const bf16_t* kp = K + ((size_t)b * SEQ + sel[tid]) * 512;
            for (int h = 0; h < 4; ++h) { float d = 0.f; for (int k = 0; k < 128; ++k) d += qv[h * 128 + k] * bf2f(kp[h * 128 + k]); lg[h * 256 + tid] = d * 0.6931471805599453f; } }
        __syncthreads();
        if (tid < 4) { float mx = -1e30f; for (int j = 0; j < nsel; ++j) mx = fmaxf(mx, lg[tid * 256 + j]); float sm = 0.f; for (int j = 0; j < nsel; ++j) { const float e = expf(lg[tid * 256 + j] - mx); lg[tid * 256 + j] = e; sm += e; }
            const float inv = 1.0f / sm; for (int j = 0; j < nsel; ++j) lg[tid * 256 + j] *= inv; }
        __syncthreads();
        { const int h = tid >> 7; float o = 0.f; for (int j = 0; j < nsel; ++j) o += lg[h * 256 + j] * bf2f(V[((size_t)b * SEQ + sel[j]) * 512 + tid]);
            const float got = bf2f(YBp[row * 512 + tid]); const float dd = o - got;
            atomicAdd((float*)&cnts[2], dd * dd); atomicAdd((float*)&cnts[3], o * o); }
        __syncthreads();
    }
    if (tid == 0) { const float e2 = __uint_as_float(cnts[2]), r2 = __uint_as_float(cnts[3]);
        const bool bad = (cnts[0] > 4u) || (nsel != nexp) || !(e2 <= (SELFCHECK == 2 ? 1e-9f : 0.0009f) * r2 + 1e-12f);
        if (bad) atomicAdd(err, 1u); }
    __syncthreads();
}
#endif
__device__ __forceinline__ void route_a(LAS unsigned char* lds, int blk, const float* LOG, const float* rgb, const float* reb, int* TE, float* TW, unsigned* CNT, const int tid) {
    LAS unsigned* cnt = (LAS unsigned*)lds;
    if (tid < 32) cnt[tid] = 0u;
    __syncthreads();
    if (tid < 128) { const int t = blk * 128 + tid; const float* lg = LOG + (size_t)t * 64;
        float g[4]; int grp = 0;
#pragma unroll
        for (int j = 0; j < 4; ++j) g[j] = lg[j] + rgb[j];
#pragma unroll
        for (int j = 1; j < 4; ++j) if (g[j] > g[grp]) grp = j;
        float den = 0.f;
#pragma unroll
        for (int j = 0; j < 4; ++j) den += expf(g[j] - g[grp]);
        const float gw = 1.0f / den;
        float el[8]; int i0 = 0;
#pragma unroll
        for (int j = 0; j < 8; ++j) el[j] = lg[4 + grp * 8 + j] + reb[grp * 8 + j];
#pragma unroll
        for (int j = 1; j < 8; ++j) if (el[j] > el[i0]) i0 = j;
        int i1 = (i0 == 0) ? 1 : 0;
#pragma unroll
        for (int j = 0; j < 8; ++j) if (j != i0 && j != i1 && el[j] > el[i1]) i1 = j;
        const float e1 = expf(el[i1] - el[i0]); const float w0 = gw / (1.0f + e1), w1 = gw * e1 / (1.0f + e1);
        const int x0 = grp * 8 + i0, x1 = grp * 8 + i1;
        TE[2 * t] = x0; TE[2 * t + 1] = x1; TW[2 * t] = w0; TW[2 * t + 1] = w1;
        __hip_atomic_fetch_add(&cnt[x0], 1u, __ATOMIC_RELAXED, __HIP_MEMORY_SCOPE_WORKGROUP); __hip_atomic_fetch_add(&cnt[x1], 1u, __ATOMIC_RELAXED, __HIP_MEMORY_SCOPE_WORKGROUP); }
    __syncthreads();
    if (tid < 32) CNT[blk * 32 + tid] = cnt[tid];
    __syncthreads();
}
__device__ __forceinline__ void route_b(LAS unsigned char* lds, int blk, const unsigned* CNT, const int* TE, const float* TW, const bf16_t* HB2, bf16_t* XS, float* WSLOT, int* SLOT, int* TILETAB, int wid, int lane, const int tid) {
    LAS unsigned* ptot = (LAS unsigned*)lds;
    LAS unsigned* pbef = ptot + 512;
    LAS unsigned* tot = pbef + 512;
    LAS unsigned* base = tot + 32;
    LAS unsigned* estart = base + 32;
    LAS int* pos = (LAS int*)(estart + 64);
    LAS int* lte = pos + 256;
    { const int e = tid & 31, part = tid >> 5; unsigned s = 0u, bsum = 0u;
        for (int b2 = part * 16; b2 < part * 16 + 16; ++b2) { const unsigned c = CNT[b2 * 32 + e]; s += c; if (b2 < blk) bsum += c; }
        ptot[part * 32 + e] = s; pbef[part * 32 + e] = bsum; }
    if (tid < 256) lte[tid] = TE[blk * 256 + tid];
    __syncthreads();
    if (tid < 32) { unsigned s = 0u, bsum = 0u;
        for (int p = 0; p < 16; ++p) { s += ptot[p * 32 + tid]; bsum += pbef[p * 32 + tid]; }
        tot[tid] = s; base[tid] = bsum; }
    __syncthreads();
    if (tid == 0) { unsigned run = 0u; for (int e = 0; e < 32; ++e) { estart[e] = run; run += (tot[e] + 255u) & ~255u; } estart[32] = run; }
    __syncthreads();
    if (tid < 32) { int k = (int)(estart[tid] + base[tid]);
        for (int a = 0; a < 256; ++a) if (lte[a] == tid) pos[a] = k++; }
    __syncthreads();
    for (int a = wid * 32; a < wid * 32 + 32; ++a) { const int t = blk * 128 + (a >> 1), p = pos[a];
        const u32x4* src = (const u32x4*)(HB2 + (size_t)t * 1024); u32x4* dst = (u32x4*)(XS + (size_t)p * 1024);
        dst[lane] = src[lane]; dst[64 + lane] = src[64 + lane];
        if (lane == 0) { WSLOT[p] = TW[blk * 256 + a]; SLOT[blk * 256 + a] = p; } }
    if (blk < 32) {
        const int r0 = (int)(estart[blk] + tot[blk]), r1 = (int)estart[blk + 1];
        for (int r = r0 + wid; r < r1; r += NWAVES) { u32x4* dst = (u32x4*)(XS + (size_t)r * 1024); dst[lane] = (u32x4){0u, 0u, 0u, 0u}; dst[64 + lane] = (u32x4){0u, 0u, 0u, 0u}; if (lane == 0) WSLOT[r] = 0.f; }
    }
    if (blk == 0) { if (tid == 0) TILETAB[0] = (int)(estart[32] >> 8);
        if (tid < 32) for (unsigned rt = estart[tid] >> 8; rt < (estart[tid + 1] >> 8); ++rt) TILETAB[1 + rt] = tid; }
    __syncthreads();
}

#ifndef PHASE_MASK
#define PHASE_MASK 0x3FFF
#endif
#define PK(i) ((PHASE_MASK >> (i)) & 1)
#ifndef REPEAT_MASK
#define REPEAT_MASK 0
#endif
#ifndef REPEAT_N
#define REPEAT_N 2
#endif
#define REPS(i) (((REPEAT_MASK >> (i)) & 1) ? REPEAT_N : 1)
#ifndef IX_FAST_MIN_QT
#define IX_FAST_MIN_QT 32
#endif
constexpr int NPH_LAYER = 13, NPHASES = 1 + DEPTH * NPH_LAYER;
struct Args {
    const float* in[20]; float* out; unsigned char* ws;
    float invq[16]; float invi[8];
    int ph_lo, ph_hi, li, pad;
};

__global__ void __launch_bounds__(NTHREADS, 2) fwd_kernel(Args args) {
    extern __shared__ __attribute__((aligned(16))) unsigned char lds_raw[];
    LAS unsigned char* lds = (LAS unsigned char*)lds_raw;
    volatile LAS unsigned* MISC = (volatile LAS unsigned*)(lds + MISC_OFF);
    const int tid = threadIdx.x;
    unsigned* ctl = (unsigned*)(args.ws + WS_CTL);
    if (tid < 64) ((LAS unsigned*)(lds + MISC_OFF))[tid] = 0u;
    __syncthreads();
    XcdBarrier bar = xcd_barrier_post(ctl + CW_BAR + args.li * XCD_BAR_WORDS, MISC + 8);
    const int lo = args.ph_lo, hi = args.ph_hi;
#define IN(k) (lo <= (k) && (k) < hi)
#define SEAM(k) do { if (IN(k) && IN((k) + 1)) xcd_barrier(bar); } while (0)
#define CAS __attribute__((address_space(4)))
#ifdef PH_STAMP
#define PHS_BEGIN(k) const unsigned long long phs_t0_ = __builtin_amdgcn_s_memrealtime(); const int phs_k_ = (k);
#define PHS_END() do { if (phs_k_ == PH_STAMP && blockIdx.x == 0 && threadIdx.x == 0) { unsigned* c_ = (unsigned*)(ap->ws + WS_CTL) + CW_ERR; atomicAdd(c_ + 1, (unsigned)(__builtin_amdgcn_s_memrealtime() - phs_t0_) / 100u); } } while (0)
#else
#define PHS_BEGIN(k)
#define PHS_END() do {} while (0)
#endif
#ifndef REPEAT_BAR
#define REPEAT_BAR 0
#endif
#define REPB_ if (REPEAT_BAR && rep_ > 0) xcd_barrier(bar);
#define OPQ() const CAS Args* ap = (const CAS Args*)__builtin_amdgcn_kernarg_segment_ptr(); asm volatile("" : "+s"(ap)); unsigned char* const ws = ap->ws; (void)ws; int bid = blockIdx.x, G = gridDim.x; asm volatile("" : "+s"(bid), "+s"(G)); const int NGW = G * NWAVES; (void)NGW; int tid_o = threadIdx.x; asm volatile("" : "+v"(tid_o)); const int lane = tid_o & 63, wid = __builtin_amdgcn_readfirstlane(tid_o >> 6), gw = bid * NWAVES + wid; (void)lane; (void)gw; REPB_

#define x_in (ap->in[0])
#define positions ((const int*)ap->in[1])
#define g_mix (ap->in[2])
#define g_ffn (ap->in[3])
#define g_fin (ap->in[4])
#define XA (ap->out)
#define cosq ((float*)(ws + WS_COSQ))
#define sinq ((float*)(ws + WS_SINQ))
#define cosi ((float*)(ws + WS_COSI))
#define sini ((float*)(ws + WS_SINI))
#define WIN ((bf16_t*)(ws + WS_WIN))
#define WP ((bf16_t*)(ws + WS_WP))
#define WO ((bf16_t*)(ws + WS_WO))
#define WR ((bf16_t*)(ws + WS_WR))
#define R (ws + WS_R)
#define HB ((bf16_t*)(R + R_HB))
#define VA ((bf16_t*)(R + R_VA))
#define CC ((bf16_t*)(R + R_CC))
#define CX ((bf16_t*)(R + R_CX))
#define YB ((bf16_t*)(R + R_YB))
#define UA ((bf16_t*)(R + R_UA))
#define Qm ((bf16_t*)(R + R_Q))
#define Km ((bf16_t*)(R + R_K))
#define VB ((bf16_t*)(R + R_VB))
#define CB ((bf16_t*)(R + R_CB))
#define QI ((bf16_t*)(R + R_QI))
#define KI ((bf16_t*)(R + R_KI))
#define WI ((float*)(R + R_WI))
#define G8 (R + R_G8)
#define MASK ((unsigned long long*)(R + R_MASK))
#define DL ((bf16_t*)(R + R_MASK))
#define MG ((bf16_t*)(R + R_MERGED))
#define WGU ((bf16_t*)(R + R_WGU))
#define WD ((bf16_t*)(R + R_WD))
#define HB2 ((bf16_t*)(R + R_HB2))
#define LOG ((float*)(R + R_LOG))
#define XS ((bf16_t*)(R + R_XS))
#define HID ((bf16_t*)(R + R_HID))
#define CNT ((unsigned*)(ws + WS_MISC + MS_CNT))
#define TE ((int*)(ws + WS_MISC + MS_TE))
#define TW ((float*)(ws + WS_MISC + MS_TW))
#define SLOT ((int*)(ws + WS_MISC + MS_SLOT))
#define WSLOT ((float*)(ws + WS_MISC + MS_WSLOT))
#define TILETAB ((int*)(ws + WS_MISC + MS_TILE))

    if (PK(0) && IN(0)) for (int rep_ = 0; rep_ < REPS(0); ++rep_) { asm volatile(".p2align 8\n\t; PHASE_MARK 0"); OPQ();
        for (int e = bid * NTHREADS + tid_o; e < T * 24; e += G * NTHREADS) {
            const int t = e / 24, j = e - 24 * t; const float p = (float)positions[t]; float s, c;
            if (j < 16) { sincos_f32(p * ap->invq[j], s, c); cosq[(size_t)t * 16 + j] = c; sinq[(size_t)t * 16 + j] = s; }
            else { sincos_f32(p * ap->invi[j - 16], s, c); cosi[(size_t)t * 8 + (j - 16)] = c; sini[(size_t)t * 8 + (j - 16)] = s; } }
        LAS float* scr = (LAS float*)(lds + wid * 16384);
        constexpr int I_WIN = 16 * 120, I_WP = 8 * 16, I_WO = 16 * 16, I_WR = 16 * 4, I_LAYER = I_WIN + 3 * I_WP + I_WO + I_WR;
        for (int it = gw; it < DEPTH * I_LAYER; it += NGW) { const int l = it / I_LAYER; int r = it % I_LAYER;
            if (r < I_WIN) { const int nb = r % 120;
                cvt_item(SrcWin{ap->in[5] + (size_t)l * DM * D_IN}, WIN + (size_t)l * NPROJ * DM, DM, 64 * (r / 120), 64 * nb, scr, lane, (nb >= 16 && nb < 24) ? QK_PRESCALE : 1.0f); continue; } r -= I_WIN;
            if (r < 3 * I_WP) { const int br = r / I_WP, q = r % I_WP; cvt_item(SrcPlain{ap->in[9 + br] + (size_t)l * 512 * DM, DM}, WP + ((size_t)l * 3 + br) * DM * 512, 512, 64 * (q / 16), 64 * (q % 16), scr, lane); continue; } r -= 3 * I_WP;
            if (r < I_WO) { cvt_item(SrcPlain{ap->in[12] + (size_t)l * DM * DM, DM}, WO + (size_t)l * DM * DM, DM, 64 * (r / 16), 64 * (r % 16), scr, lane); continue; } r -= I_WO;
            cvt_item(SrcRouter{ap->in[13] + (size_t)l * DM * 4, ap->in[15] + (size_t)l * DM * 32}, WR + (size_t)l * 256 * DM, DM, 64 * (r / 4), 64 * (r % 4), scr, lane);
        }
        for (int m = gw; m < T; m += 2 * NGW) { const int m2 = (m + NGW < T) ? m + NGW : m;
            RmsRow ra, rb; rms_load(ra, x_in + (size_t)m * DM, nullptr, nullptr, lane); rms_load(rb, x_in + (size_t)m2 * DM, nullptr, nullptr, lane);
            rms_finish(ra, 0, g_mix, nullptr, HB + (size_t)m * DM, nullptr, lane); rms_finish(rb, 0, g_mix, nullptr, HB + (size_t)m2 * DM, nullptr, lane); }
    }
    SEAM(0);

#pragma unroll 1
    for (int l = 0; l < DEPTH; ++l) {
        const int pb = 1 + l * NPH_LAYER;
        if (PK(1) && IN(pb + 0)) for (int rep_ = 0; rep_ < REPS(1); ++rep_) { asm volatile(".p2align 8\n\t; PHASE_MARK 1"); OPQ();
            pg8::DenseOrder S; S.init(HB, WIN + (size_t)l * NPROJ * DM, T, NPROJ, DM, G, bid);
            EpiProj E{ws};
            pg8::gemm_phase(lds, DM, S, E);
        }
        SEAM(pb + 0);
        if (PK(2) && IN(pb + 1)) for (int rep_ = 0; rep_ < REPS(2); ++rep_) { asm volatile(".p2align 8\n\t; PHASE_MARK 2"); OPQ();
            PHS_BEGIN(2)
#ifdef GM_REP
            for (int gr_ = 0; gr_ < GM_REP; ++gr_) for (int item = bid; item < T / 128; item += G)
                gmlp_conv_item(lds, item, UA, VA, CB, CC, CX, ap->in[6] + (size_t)l * 4 * 128 * 128, ap->in[7] + (size_t)l * 4 * 128, ap->in[8] + (size_t)l * 3 * 512, wid, lane, true);
#endif
            for (int item = bid; item < T / 128; item += G)
                gmlp_conv_item(lds, item, UA, VA, CB, CC, CX, ap->in[6] + (size_t)l * 4 * 128 * 128, ap->in[7] + (size_t)l * 4 * 128, ap->in[8] + (size_t)l * 3 * 512, wid, lane);
            PHS_END();
        }
        SEAM(pb + 1);
        if (PK(3) && IN(pb + 2)) for (int rep_ = 0; rep_ < REPS(3); ++rep_) { asm volatile(".p2align 8\n\t; PHASE_MARK 3"); OPQ();
            unsigned char* scr = (unsigned char*)(R + R_SCR + (size_t)bid * SCR_PER_WG);
#ifdef IX_STAMP
            if (tid_o < 8) ((LAS unsigned*)(lds + IXL_ROW))[96 + tid_o] = 0u;
            __syncthreads();
            const unsigned long long tph0 = __builtin_amdgcn_s_memrealtime();
#endif
#if defined(IX_SKIP) && (IX_SKIP & 16)
            for (int row = bid * NTHREADS + tid_o; row < T; row += G * NTHREADS) { const int bb = row >> 14, tq = row & (SEQ - 1), qb = tq >> 8, nto = ((tq & ~255) + 256) >> 6;
                unsigned long long* mrow = MASK + ((size_t)(bb * 64 + qb) * 256 * 256 + (size_t)(tq & 255));
                for (int Tt = 0; Tt < nto; ++Tt) { unsigned long long w = 0ull; if (Tt < 4) { const int lo_ = 64 * Tt; w = (lo_ + 63 <= tq) ? ~0ull : (lo_ > tq ? 0ull : ((1ull << (tq - lo_ + 1)) - 1ull)); } mrow[(size_t)Tt * 256] = w; } }
#else
            int nslow = 0;
            constexpr int NFAST = 2 * (1024 - IX_FAST_MIN_QT);
            unsigned* wq = (unsigned*)(ws + WS_CTL) + CW_WQ + 64 * l + 16 * rep_;
            if (tid_o == 0) MISC[14] = __hip_atomic_fetch_add(wq, 1u, __ATOMIC_RELAXED, __HIP_MEMORY_SCOPE_AGENT);
            __syncthreads();
            for (int qi_ = 0;; ++qi_) {
                const int k = (int)MISC[14 + (qi_ & 1)];
                if (k >= NFAST) break;
                if (tid_o == 0) MISC[14 + ((qi_ + 1) & 1)] = __hip_atomic_fetch_add(wq, 1u, __ATOMIC_RELAXED, __HIP_MEMORY_SCOPE_AGENT);
                const int ib = k & 1, iq = 1023 - (k >> 1);
                const bool done = indexer_item_fast(lds, ib, iq, QI, KI, WI, MASK, wid, lane, tid_o, (unsigned*)(ws + WS_CTL) + CW_ERR, (unsigned*)scr);
                if (!done) { if (tid_o == 0 && nslow < 44) MISC[16 + nslow] = (unsigned)(ib * 1024 + iq); ++nslow;
#ifdef IX_PROBE_FAILS
                    if (tid_o == 0) atomicAdd((unsigned*)(ws + WS_CTL) + CW_ERR, 1u);
#endif
                } }
            if (nslow > 44) nslow = 44;
            __syncthreads();
#ifdef IX_STAMP
            const unsigned long long tp2 = __builtin_amdgcn_s_memrealtime();
#endif
            for (int kf = 0;;) { int idx;
                if (kf < nslow) { idx = (int)MISC[16 + kf]; ++kf; }
                else { if (tid_o == 0) MISC[13] = __hip_atomic_fetch_add(wq + 1, 1u, __ATOMIC_RELAXED, __HIP_MEMORY_SCOPE_AGENT);
                    __syncthreads(); const int k = (int)MISC[13]; __syncthreads();
                    if (k >= 2 * IX_FAST_MIN_QT) break;
                    idx = (k & 1) * 1024 + (IX_FAST_MIN_QT - 1 - (k >> 1)); }
                indexer_item(lds, scr, idx >> 10, idx & 1023, QI, KI, WI, MASK, wid, lane); }
#endif
#ifdef IX_STAMP
            if (bid == 0 && tid_o == 0) { const unsigned v = (IX_STAMP < 5) ? ((LAS unsigned*)(lds + IXL_ROW))[96 + IX_STAMP] : (IX_STAMP == 6 ? (unsigned)(__builtin_amdgcn_s_memrealtime() - tp2) : (unsigned)(__builtin_amdgcn_s_memrealtime() - tph0));
                atomicAdd((unsigned*)(ws + WS_CTL) + CW_ERR + 1, v / 100u);
                if (l == DEPTH - 1) { const unsigned us = __hip_atomic_load((unsigned*)(ws + WS_CTL) + CW_ERR + 1, __ATOMIC_RELAXED, __HIP_MEMORY_SCOPE_AGENT); unsigned code = 0u; float x = (float)us; while (x >= 1.4142135f) { x *= 0.70710678f; ++code; }
                    atomicAdd((unsigned*)(ws + WS_CTL) + CW_ERR, code); } }
#endif
        }
        SEAM(pb + 2);
        if (PK(4) && IN(pb + 3)) for (int rep_ = 0; rep_ < REPS(4); ++rep_) { asm volatile(".p2align 8\n\t; PHASE_MARK 4"); OPQ();
            for (int it = bid; it < 256; it += G) { const int bh = it & 7, y = it >> 3, b = bh >> 2, h = bh & 3;
#pragma unroll 1
                for (int half = 0; half < 2; ++half) { const int qb = half ? y : 63 - y, P0 = qb * 256;
                    const size_t hoff = (size_t)b * SEQ * 512 + h * 128;
                    att::attn_block((LAS char*)lds, Qm + hoff + (size_t)P0 * 512, Km + hoff, VB + hoff, YB + hoff + (size_t)P0 * 512, MASK + (size_t)(b * 64 + qb) * 256 * 256, P0); } }
#ifdef SELFCHECK
            xcd_barrier(bar);
            if (bid < 64) { const int tl[32] = {0, 1, 63, 64, 255, 256, 257, 300, 383, 511, 512, 600, 1023, 2047, 2048, 2049, 2063, 2064, 3333, 4095, 4096, 5000, 7000, 8191, 8192, 11111, 12287, 12288, 15000, 16368, 16382, 16383};
                int tsel = 0;
#pragma unroll
                for (int q = 0; q < 32; ++q) tsel = ((bid & 31) == q) ? tl[q] : tsel;
                selfcheck_row(lds, bid >> 5, tsel, QI, KI, WI, MASK, Qm, Km, VB, YB, (unsigned*)(ws + WS_CTL) + CW_ERR, tid_o); }
#endif
        }
        SEAM(pb + 3);
        if (PK(5) && IN(pb + 4)) for (int rep_ = 0; rep_ < REPS(5); ++rep_) { asm volatile(".p2align 8\n\t; PHASE_MARK 5"); OPQ();
            MergeOrder S{(const char*)R, (const char*)(WP + (size_t)l * 3 * DM * 512), G, bid};
            EpiMerge E{MG, G8};
            pg8::gemm_phase(lds, 512, S, E);
        }
        SEAM(pb + 4);
        if (PK(6) && IN(pb + 5)) for (int rep_ = 0; rep_ < (l == 0 ? REPS(6) : 1); ++rep_) {         asm volatile(".p2align 8\n\t; PHASE_MARK 6"); OPQ();
            pg8::DenseOrder S; S.init(MG, WO + (size_t)l * DM * DM, T, DM, DM, G, bid);
            EpiWoutDelta E{DL};
            pg8::gemm_phase(lds, DM, S, E);
        }
        SEAM(pb + 5);
        if (PK(7) && IN(pb + 6)) for (int rep_ = 0; rep_ < REPS(7); ++rep_) { asm volatile(".p2align 8\n\t; PHASE_MARK 7"); OPQ();
            const float* xres = (l == 0) ? x_in : (const float*)XA;
            for (int m = gw; m < T; m += 2 * NGW) { const int m2 = (m + NGW < T) ? m + NGW : m;
                RmsRow ra, rb; rms_load(ra, xres + (size_t)m * DM, DL + (size_t)m * DM, nullptr, lane); rms_load(rb, xres + (size_t)m2 * DM, DL + (size_t)m2 * DM, nullptr, lane);
                rms_finish(ra, 1, g_ffn + (size_t)l * DM, nullptr, HB2 + (size_t)m * DM, nullptr, lane); rms_finish(rb, 1, g_ffn + (size_t)l * DM, nullptr, HB2 + (size_t)m2 * DM, nullptr, lane); }
            LAS float* scr = (LAS float*)(lds + wid * 16384);
            constexpr int I_GU = 16 * 16, I_D = 8 * 16, I_E = I_GU + I_D;
#define EXP_LOAD(Rg, it_) do { const int e_ = (it_) / I_E, r_ = (it_) % I_E; const size_t eo_ = ((size_t)l * NEXP + e_) * DM * DFF; \
                if (r_ < I_GU) cvt_load(Rg, SrcGateUp{ap->in[17] + eo_, ap->in[18] + eo_}, 64 * (r_ / 16), 64 * (r_ % 16), lane); \
                else { const int q_ = r_ - I_GU; cvt_load(Rg, SrcPlain{ap->in[19] + eo_, DM}, 64 * (q_ / 16), 64 * (q_ % 16), lane); } } while (0)
#define EXP_STORE(Rg, it_) do { const int e_ = (it_) / I_E, r_ = (it_) % I_E; \
                if (r_ < I_GU) cvt_store(Rg, WGU + (size_t)e_ * DM * DM, DM, 64 * (r_ / 16), 64 * (r_ % 16), scr, lane); \
                else { const int q_ = r_ - I_GU; cvt_store(Rg, WD + (size_t)e_ * DM * DFF, DFF, 64 * (q_ / 16), 64 * (q_ % 16), scr, lane); } } while (0)
            const int n6 = (G == 256) ? NEXP * I_E - 2048 : NEXP * I_E;
            for (int it = gw; it < n6; it += NGW) { CvtRegs ra; EXP_LOAD(ra, it); EXP_STORE(ra, it); }
        }
        SEAM(pb + 6);
        if (PK(8) && IN(pb + 7)) for (int rep_ = 0; rep_ < REPS(8); ++rep_) { asm volatile(".p2align 8\n\t; PHASE_MARK 8"); OPQ();
            if (G == 256 && bid >= 128) {
                LAS float* scr = (LAS float*)(lds + wid * 16384);
                constexpr int I_GU = 16 * 16, I_D = 8 * 16, I_E = I_GU + I_D;
                for (int it = NEXP * I_E - 2048 + (bid - 128) * NWAVES + wid; it < NEXP * I_E; it += 128 * NWAVES) { CvtRegs ra; EXP_LOAD(ra, it); EXP_STORE(ra, it); }
            } else {
                pg8::DenseOrder S; S.init(HB2, WR + (size_t)l * 256 * DM, T, 256, DM, G, bid);
                EpiRouter E{LOG};
                pg8::gemm_phase(lds, DM, S, E);
            }
        }
#undef EXP_LOAD
#undef EXP_STORE
        SEAM(pb + 7);
        if (PK(9) && IN(pb + 8)) for (int rep_ = 0; rep_ < REPS(9); ++rep_) { asm volatile(".p2align 8\n\t; PHASE_MARK 9"); OPQ(); for (int blk = bid; blk < 256; blk += G) route_a(lds, blk, LOG, ap->in[14] + l * 4, ap->in[16] + l * 32, TE, TW, CNT, tid_o); }
        SEAM(pb + 8);
        if (PK(10) && IN(pb + 9)) for (int rep_ = 0; rep_ < REPS(10); ++rep_) { asm volatile(".p2align 8\n\t; PHASE_MARK 10"); OPQ(); for (int blk = bid; blk < 256; blk += G) route_b(lds, blk, CNT, TE, TW, HB2, XS, WSLOT, SLOT, TILETAB, wid, lane, tid_o); }
        SEAM(pb + 9);
        if (PK(11) && IN(pb + 10)) for (int rep_ = 0; rep_ < REPS(11); ++rep_) { asm volatile(".p2align 8\n\t; PHASE_MARK 11"); OPQ();
            MoeOrder S{(const char*)XS, (const char*)WGU, TILETAB, (size_t)256 * DM * 2, (size_t)DM * DM * 2, (size_t)256 * DM * 2, G, bid};
            EpiGateUp E{HID};
            pg8::gemm_phase(lds, DM, S, E);
        }
        SEAM(pb + 10);
        if (PK(12) && IN(pb + 11)) for (int rep_ = 0; rep_ < REPS(12); ++rep_) { asm volatile(".p2align 8\n\t; PHASE_MARK 12"); OPQ();
            MoeOrder S{(const char*)HID, (const char*)WD, TILETAB, (size_t)256 * DFF * 2, (size_t)DM * DFF * 2, (size_t)256 * DFF * 2, G, bid};
            EpiDown E{XS, WSLOT};
            pg8::gemm_phase(lds, DFF, S, E);
        }
        SEAM(pb + 11);
        if (PK(13) && IN(pb + 12)) for (int rep_ = 0; rep_ < REPS(13); ++rep_) { asm volatile(".p2align 8\n\t; PHASE_MARK 13"); OPQ();
            PHS_BEGIN(13)
            const bool lastl = (l == DEPTH - 1);
#ifdef PH_STAMP
            float probe_scale = 1.0f;
            if (l == DEPTH - 1 && PH_STAMP != 13) { const unsigned us = __hip_atomic_load((unsigned*)(ws + WS_CTL) + CW_ERR + 1, __ATOMIC_RELAXED, __HIP_MEMORY_SCOPE_AGENT); unsigned code = 0u; float x = (float)us; while (x >= 1.4142135f) { x *= 0.70710678f; ++code; } probe_scale = 1.0f + (float)code; }
#elif defined(SELFCHECK) || defined(IX_PROBE_FAILS) || defined(IX_STAMP) || defined(IX_PROBE_TYPE)
            const float probe_scale = 1.0f + (float)__hip_atomic_load((unsigned*)(ws + WS_CTL) + CW_ERR, __ATOMIC_RELAXED, __HIP_MEMORY_SCOPE_AGENT);
#endif
            const float* gn = lastl ? g_fin : g_mix + (size_t)(l + 1) * DM;
#ifdef CB_REP
            for (int m = gw; m < T; m += 2 * NGW) { const int m2 = (m + NGW < T) ? m + NGW : m;
                const int s0 = SLOT[2 * m], s1 = SLOT[2 * m + 1], s2 = SLOT[2 * m2], s3 = SLOT[2 * m2 + 1];
                RmsRow ra, rb; rms_load(ra, XA + (size_t)m * DM, XS + (size_t)s0 * DM, XS + (size_t)s1 * DM, lane); rms_load(rb, XA + (size_t)m2 * DM, XS + (size_t)s2 * DM, XS + (size_t)s3 * DM, lane);
                rms_finish(ra, 3, gn, nullptr, nullptr, nullptr, lane); rms_finish(rb, 3, gn, nullptr, nullptr, nullptr, lane);
                asm volatile("" :: "v"(ra.v[0][0]), "v"(rb.v[0][0]), "v"(ra.v[3][3]), "v"(rb.v[3][3])); }
#endif
            const float* xres = (l == 0) ? x_in : (const float*)XA;
            for (int m = gw; m < T; m += 2 * NGW) { const int m2 = (m + NGW < T) ? m + NGW : m;
                const int s0 = SLOT[2 * m], s1 = SLOT[2 * m + 1], s2 = SLOT[2 * m2], s3 = SLOT[2 * m2 + 1];
                RmsRow ra, rb; rms_load(ra, xres + (size_t)m * DM, XS + (size_t)s0 * DM, XS + (size_t)s1 * DM, lane, DL + (size_t)m * DM); rms_load(rb, xres + (size_t)m2 * DM, XS + (size_t)s2 * DM, XS + (size_t)s3 * DM, lane, DL + (size_t)m2 * DM);
                rms_finish(ra, 7, gn, lastl ? nullptr : XA + (size_t)m * DM, lastl ? nullptr : HB + (size_t)m * DM, lastl ? XA + (size_t)m * DM : nullptr, lane);
                rms_finish(rb, 7, gn, lastl ? nullptr : XA + (size_t)m2 * DM, lastl ? nullptr : HB + (size_t)m2 * DM, lastl ? XA + (size_t)m2 * DM : nullptr, lane); }
#if defined(SELFCHECK) || defined(IX_PROBE_FAILS) || defined(IX_STAMP) || defined(IX_PROBE_TYPE) || defined(PH_STAMP)
            if (lastl) for (int m = gw; m < T; m += NGW) { f32x4* o4 = (f32x4*)(XA + (size_t)m * DM) + lane;
#pragma unroll
                for (int j = 0; j < 4; ++j) o4[64 * j] = o4[64 * j] * probe_scale; }
#endif
        }
        SEAM(pb + 12);
    }
#undef IN
#undef SEAM
#undef x_in
#undef positions
#undef g_mix
#undef g_ffn
#undef g_fin
#undef XA
#undef cosq
#undef sinq
#undef cosi
#undef sini
#undef WIN
#undef WP
#undef WO
#undef WR
#undef R
#undef HB
#undef VA
#undef CC
#undef CX
#undef YB
#undef UA
#undef Qm
#undef Km
#undef VB
#undef CB
#undef QI
#undef KI
#undef WI
#undef G8
#undef MASK
#undef MG
#undef WGU
#undef WD
#undef HB2
#undef LOG
#undef XS
#undef HID
#undef CNT
#undef TE
#undef TW
#undef SLOT
#undef WSLOT
#undef TILETAB
}

#ifndef N_LAUNCH_MODE
#define N_LAUNCH_MODE 1
#endif
extern "C" void kernel_launch(void* const* d_in, const int* in_sizes, int n_in, void* d_out, int out_size, void* d_ws, size_t ws_size, hipStream_t stream) {
    static int grid = 0;
    if (grid == 0) {
        if (n_in != 20 || in_sizes[0] != T * DM || out_size != T * DM || ws_size < WS_END) { fprintf(stderr, "kernel_launch: unexpected shapes (n_in %d, in0 %d, out %d, ws %zu < %zu)\n", n_in, n_in > 0 ? in_sizes[0] : -1, out_size, ws_size, (size_t)WS_END); grid = -1; return; }
        int dev = 0, cus = 0, per_cu = 0;
        if (hipGetDevice(&dev) != hipSuccess || hipDeviceGetAttribute(&cus, hipDeviceAttributeMultiprocessorCount, dev) != hipSuccess) { grid = -1; return; }
        if (hipFuncSetAttribute((const void*)fwd_kernel, hipFuncAttributeMaxDynamicSharedMemorySize, LDS_BYTES) != hipSuccess) { fprintf(stderr, "kernel_launch: hipFuncSetAttribute failed\n"); grid = -1; return; }
        if (hipOccupancyMaxActiveBlocksPerMultiprocessor(&per_cu, (const void*)fwd_kernel, NTHREADS, LDS_BYTES) != hipSuccess || per_cu < 1) { fprintf(stderr, "kernel_launch: occupancy query says %d\n", per_cu); }
        (void)hipGetLastError();
        grid = cus;
    }
    if (grid < 0) return;
    if (hipMemsetAsync((char*)d_ws + WS_CTL, 0, CTL_ZERO_BYTES, stream) != hipSuccess) return;
    Args a{};
    for (int i = 0; i < 20; ++i) a.in[i] = (const float*)d_in[i];
    a.out = (float*)d_out; a.ws = (unsigned char*)d_ws;
    for (int j = 0; j < 16; ++j) a.invq[j] = powf(500000.0f, -(float)j * 2.0f / 32.0f);
    for (int j = 0; j < 8; ++j) a.invi[j] = powf(500000.0f, -(float)j * 2.0f / 16.0f);
#if N_LAUNCH_MODE == 1
    a.ph_lo = 0; a.ph_hi = NPHASES; a.li = 0;
    hipLaunchKernelGGL(fwd_kernel, dim3(grid), dim3(NTHREADS), LDS_BYTES, stream, a);
#else
    for (int p = 0; p < NPHASES; ++p) { a.ph_lo = p; a.ph_hi = p + 1; a.li = p; hipLaunchKernelGGL(fwd_kernel, dim3(grid), dim3(NTHREADS), LDS_BYTES, stream, a); }
#endif
}
```
